# Optimizing an MI355X kernel written in HIP

```python
import math
import jax, jax.numpy as jnp
from jax import lax
import numpy as np

D_MODEL = 2048
BATCH = 4
SEQ = 4096
DEPTH = 2

A_HEADS = 16
A_HEAD_DIM = 64
A_WIDTH = A_HEADS * A_HEAD_DIM
DECAY_LORA = 64
ICLR_LORA = 64
GATE_LORA = 128
DECAY_SCALE = math.exp(-0.5)
GN_EPS = 64e-5
B_WIDTH = D_MODEL // 2
B_GROUPS = 8
B_GROUP_DIM = B_WIDTH // B_GROUPS
CHUNK = 128
A_COLS = 3 * A_WIDTH + DECAY_LORA + ICLR_LORA + GATE_LORA
AB_COLS = A_COLS + 2 * B_WIDTH
C_HEADS = 16
C_HEAD_DIM = 64
C_V_DIM = 2 * C_HEAD_DIM
C_QK_COLS = C_HEADS * 2 * C_HEAD_DIM
C_COLS = 2 * C_QK_COLS + C_HEADS * C_V_DIM
ROPE_DIM = C_HEAD_DIM // 4
ROPE_THETA = 500000.0
Q_BLOCK = 128
PEER_HEADS = 8
N_KEYS = 128
N_EXPERTS = N_KEYS * N_KEYS
PEER_TOPK = 16
PEER_QDIM = 256
PEER_HALF = PEER_QDIM // 2
PEER_TOKEN_BLOCK = 128
N_EVEN = (DEPTH + 1) // 2
N_ODD = DEPTH // 2

kernel_name = "rwkv7_sgu_diffattn_peer_hybrid"

F32 = jnp.float32


def rms_norm(x, w, eps=1e-6):
    xf = x.astype(F32)
    y = xf * lax.rsqrt(jnp.mean(xf * xf, axis=-1, keepdims=True) + eps)
    return (y * w.astype(F32)).astype(x.dtype)


def layer_norm_f32(xf, w, b, eps):
    xc = xf - jnp.mean(xf, axis=-1, keepdims=True)
    var = jnp.mean(xc * xc, axis=-1, keepdims=True)
    return xc * lax.rsqrt(var + eps) * w.astype(F32) + b.astype(F32)


def rwkv7_heads(pa, shift_mu, decay_bias, decay_up, iclr_bias, iclr_up, gate_up,
                k_k, k_a, r_k, gn_w, gn_b):
    bsz, seq, _ = pa.shape
    prev = jnp.concatenate([jnp.zeros_like(pa[:, :1]), pa[:, :-1]], axis=1)
    pa = pa + (prev - pa) * shift_mu
    o1, o2, o3 = A_WIDTH, 2 * A_WIDTH, 3 * A_WIDTH
    o4 = o3 + DECAY_LORA
    o5 = o4 + ICLR_LORA
    r, k, v = pa[..., :o1], pa[..., o1:o2], pa[..., o2:o3]
    wd, ad, gd = pa[..., o3:o4], pa[..., o4:o5], pa[..., o5:]
    log_w = -DECAY_SCALE * jax.nn.sigmoid((decay_bias + jnp.tanh(wd) @ decay_up).astype(F32))
    iclr = jax.nn.sigmoid((iclr_bias + ad @ iclr_up).astype(F32))
    gate = jax.nn.sigmoid(gd) @ gate_up

    def heads(t):
        return t.astype(F32).reshape(bsz, seq, A_HEADS, A_HEAD_DIM)

    rf, kf, vf, iclr, decay = heads(r), heads(k), heads(v), heads(iclr), jnp.exp(heads(log_w))
    kk = kf * k_k.astype(F32).reshape(A_HEADS, A_HEAD_DIM)
    kk = kk * lax.rsqrt(jnp.maximum(jnp.sum(kk * kk, axis=-1, keepdims=True), 1e-12))
    kf = kf * (1.0 + (iclr - 1.0) * k_a.astype(F32).reshape(A_HEADS, A_HEAD_DIM))

    def step(state, inp):
        rt, wt, kt, vt, kkt, at = inp
        sk = jnp.einsum('bhij,bhj->bhi', state, kkt)
        state = (state * wt[:, :, None, :]
                 - sk[..., None] * (kkt * at)[:, :, None, :]
                 + vt[..., None] * kt[:, :, None, :])
        return state, jnp.einsum('bhij,bhj->bhi', state, rt)

    time_major = lambda t: jnp.swapaxes(t, 0, 1)
    s0 = jnp.zeros((bsz, A_HEADS, A_HEAD_DIM, A_HEAD_DIM), F32)
    _, y = lax.scan(step, s0, tuple(time_major(t) for t in (rf, decay, kf, vf, kk, iclr)))
    y = time_major(y)
    y = layer_norm_f32(y, gn_w.reshape(A_HEADS, A_HEAD_DIM), gn_b.reshape(A_HEADS, A_HEAD_DIM), GN_EPS)
    y = y + jnp.sum(rf * kf * r_k.astype(F32), axis=-1, keepdims=True) * vf
    return y.reshape(bsz, seq, A_WIDTH).astype(pa.dtype) * gate


def chunked_sgu(pb, ln_w, ln_b, w_s, b_s):
    bsz, seq, _ = pb.shape
    z = jax.nn.gelu(pb, approximate=False)
    u, v = z[..., :B_WIDTH], z[..., B_WIDTH:]
    v = layer_norm_f32(v.astype(F32), ln_w, ln_b, 1e-5).astype(pb.dtype)
    v = v.reshape(bsz, seq // CHUNK, CHUNK, B_GROUPS, B_GROUP_DIM)
    causal = jnp.tril(jnp.ones((CHUNK, CHUNK), dtype=bool))
    w = jnp.where(causal[None], w_s, 0.0)
    s = jnp.einsum('gts,bcsgd->bctgd', w, v) + b_s.T[:, :, None]
    return u * s.reshape(bsz, seq, B_WIDTH)


def rwkv_sgu_mixer(h, w_in, shift_mu, decay_bias, decay_up, iclr_bias, iclr_up, gate_up,
                   k_k, k_a, r_k, gn_w, gn_b, sgu_ln_w, sgu_ln_b, sgu_w, sgu_b, w_out):
    p = h @ w_in
    ya = rwkv7_heads(p[..., :A_COLS], shift_mu, decay_bias, decay_up, iclr_bias, iclr_up,
                     gate_up, k_k, k_a, r_k, gn_w, gn_b)
    yb = chunked_sgu(p[..., A_COLS:], sgu_ln_w, sgu_ln_b, sgu_w, sgu_b)
    return jnp.concatenate([ya, yb], axis=-1) @ w_out


def partial_rotary(x, pos):
    half = ROPE_DIM // 2
    inv = jnp.power(ROPE_THETA, -jnp.arange(half, dtype=F32) * (2.0 / ROPE_DIM))
    ang = pos.astype(F32)[:, None] * inv[None, :]
    cos = jnp.cos(ang)[None, :, None, None, :]
    sin = jnp.sin(ang)[None, :, None, None, :]
    xf = x.astype(F32)
    x1, x2 = xf[..., :half], xf[..., half:ROPE_DIM]
    out = jnp.concatenate([x1 * cos - x2 * sin, x2 * cos + x1 * sin, xf[..., ROPE_DIM:]], axis=-1)
    return out.astype(x.dtype)


def causal_diff_attention(q, k, v, lam):
    bsz, seq = q.shape[0], q.shape[1]
    nb = seq // Q_BLOCK
    scale = C_HEAD_DIM ** -0.5
    qb = jnp.moveaxis(q.reshape(bsz, nb, Q_BLOCK, C_HEADS, 2, C_HEAD_DIM), 1, 0)
    kpos = jnp.arange(seq)

    def one_block(args):
        qblk, blk = args
        s = jnp.einsum('bqhmd,bkhmd->bhmqk', qblk, k).astype(F32) * scale
        qpos = blk * Q_BLOCK + jnp.arange(Q_BLOCK)
        mask = kpos[None, :] <= qpos[:, None]
        s = jnp.where(mask, s, jnp.finfo(F32).min)
        p = jax.nn.softmax(s, axis=-1)
        attn = p[:, :, 0] - lam * p[:, :, 1]
        return jnp.einsum('bhqk,bkhe->bqhe', attn.astype(v.dtype), v)

    o = lax.map(one_block, (qb, jnp.arange(nb)))
    return jnp.moveaxis(o, 0, 1).reshape(bsz, seq, C_HEADS, C_V_DIM)


def diff_attn_mixer(h, w_in, q_norm, k_norm, lq1, lk1, lq2, lk2, subln, w_out, lambda_init):
    bsz, seq, _ = h.shape
    p = h @ w_in
    q = p[..., :C_QK_COLS].reshape(bsz, seq, C_HEADS, 2, C_HEAD_DIM)
    k = p[..., C_QK_COLS:2 * C_QK_COLS].reshape(bsz, seq, C_HEADS, 2, C_HEAD_DIM)
    v = p[..., 2 * C_QK_COLS:].reshape(bsz, seq, C_HEADS, C_V_DIM)
    pos = jnp.arange(seq)
    q = partial_rotary(rms_norm(q, q_norm), pos)
    k = partial_rotary(rms_norm(k, k_norm), pos)
    lam = (jnp.exp(jnp.sum(lq1.astype(F32) * lk1.astype(F32)))
           - jnp.exp(jnp.sum(lq2.astype(F32) * lk2.astype(F32))) + lambda_init)
    o = causal_diff_attention(q, k, v, lam)
    o = rms_norm(o, subln, 1e-5) * (1.0 - lambda_init)
    return o.reshape(bsz, seq, C_HEADS * C_V_DIM) @ w_out


def peer(h, w_q, keys, u_tab, v_tab):
    bsz, seq, dim = h.shape
    ntok = bsz * seq
    xt = h.reshape(ntok, dim)
    q = (xt @ w_q).reshape(ntok, PEER_HEADS, 2, PEER_HALF)
    s = jnp.einsum('thpc,hpnc->thpn', q, keys).astype(F32)
    sv, si = lax.top_k(s, PEER_TOPK)
    cand = (sv[:, :, 0, :, None] + sv[:, :, 1, None, :]).reshape(ntok, PEER_HEADS, PEER_TOPK * PEER_TOPK)
    cidx = (si[:, :, 0, :, None] * N_KEYS + si[:, :, 1, None, :]).reshape(ntok, PEER_HEADS, PEER_TOPK * PEER_TOPK)
    fv, fi = lax.top_k(cand, PEER_TOPK)
    eidx = jnp.take_along_axis(cidx, fi, axis=-1)
    gate = jax.nn.softmax(fv, axis=-1).astype(h.dtype)
    nblk = ntok // PEER_TOKEN_BLOCK

    def token_block(args):
        xc, ec, gc = args
        u = jnp.take(u_tab, ec, axis=0)
        act = gc * jax.nn.gelu(jnp.einsum('chkd,cd->chk', u, xc), approximate=False)
        return jnp.einsum('chk,chkd->cd', act, jnp.take(v_tab, ec, axis=0))

    out = lax.map(token_block, (xt.reshape(nblk, PEER_TOKEN_BLOCK, dim),
                                eidx.reshape(nblk, PEER_TOKEN_BLOCK, PEER_HEADS, PEER_TOPK),
                                gate.reshape(nblk, PEER_TOKEN_BLOCK, PEER_HEADS, PEER_TOPK)))
    return out.reshape(bsz, seq, dim)


def setup_inputs(seed: int = 0) -> dict:
    key = jax.random.key(seed)
    ks = iter(jax.random.split(key, 40))
    nrm = lambda shape, scale: jax.random.normal(next(ks), shape, jnp.float32) * scale
    gain = lambda shape: 1.0 + nrm(shape, 0.05)
    D = D_MODEL
    return {
        "x": nrm((BATCH, SEQ, D), 1.0),
        "norm_mix": gain((DEPTH, D)),
        "norm_ffn": gain((DEPTH, D)),
        "ab_w_in": nrm((N_EVEN, D, AB_COLS), D ** -0.5),
        "ab_shift_mu": jax.random.uniform(next(ks), (N_EVEN, A_COLS), jnp.float32),
        "ab_decay_bias": nrm((N_EVEN, A_WIDTH), 1.0),
        "ab_decay_up": nrm((N_EVEN, DECAY_LORA, A_WIDTH), DECAY_LORA ** -0.5),
        "ab_iclr_bias": nrm((N_EVEN, A_WIDTH), 0.5),
        "ab_iclr_up": nrm((N_EVEN, ICLR_LORA, A_WIDTH), ICLR_LORA ** -0.5),
        "ab_gate_up": nrm((N_EVEN, GATE_LORA, A_WIDTH), GATE_LORA ** -0.5),
        "ab_k_k": gain((N_EVEN, A_WIDTH)),
        "ab_k_a": gain((N_EVEN, A_WIDTH)),
        "ab_r_k": nrm((N_EVEN, A_HEADS, A_HEAD_DIM), 0.1),
        "ab_gn_w": gain((N_EVEN, A_WIDTH)),
        "ab_gn_b": nrm((N_EVEN, A_WIDTH), 0.02),
        "ab_sgu_ln_w": gain((N_EVEN, B_WIDTH)),
        "ab_sgu_ln_b": nrm((N_EVEN, B_WIDTH), 0.02),
        "ab_sgu_w": nrm((N_EVEN, B_GROUPS, CHUNK, CHUNK), CHUNK ** -0.5),
        "ab_sgu_b": 1.0 + nrm((N_EVEN, B_GROUPS, CHUNK), 0.05),
        "ab_w_out": nrm((N_EVEN, A_WIDTH + B_WIDTH, D), (A_WIDTH + B_WIDTH) ** -0.5),
        "c_w_in": nrm((N_ODD, D, C_COLS), D ** -0.5),
        "c_q_norm": gain((N_ODD, C_HEAD_DIM)),
        "c_k_norm": gain((N_ODD, C_HEAD_DIM)),
        "c_lambda_q1": nrm((N_ODD, C_HEAD_DIM), 0.1),
        "c_lambda_k1": nrm((N_ODD, C_HEAD_DIM), 0.1),
        "c_lambda_q2": nrm((N_ODD, C_HEAD_DIM), 0.1),
        "c_lambda_k2": nrm((N_ODD, C_HEAD_DIM), 0.1),
        "c_subln": gain((N_ODD, C_V_DIM)),
        "c_w_out": nrm((N_ODD, C_HEADS * C_V_DIM, D), (C_HEADS * C_V_DIM) ** -0.5),
        "peer_w_q": nrm((DEPTH, D, PEER_HEADS * PEER_QDIM), D ** -0.5),
        "peer_keys": nrm((DEPTH, PEER_HEADS, 2, N_KEYS, PEER_HALF), PEER_HALF ** -0.5),
        "peer_u": nrm((DEPTH, N_EXPERTS, D), D ** -0.5),
        "peer_v": nrm((DEPTH, N_EXPERTS, D), PEER_HEADS ** -0.5),
    }


def reference(x, norm_mix, norm_ffn,
              ab_w_in, ab_shift_mu, ab_decay_bias, ab_decay_up, ab_iclr_bias, ab_iclr_up,
              ab_gate_up, ab_k_k, ab_k_a, ab_r_k, ab_gn_w, ab_gn_b, ab_sgu_ln_w, ab_sgu_ln_b,
              ab_sgu_w, ab_sgu_b, ab_w_out,
              c_w_in, c_q_norm, c_k_norm, c_lambda_q1, c_lambda_k1, c_lambda_q2, c_lambda_k2,
              c_subln, c_w_out,
              peer_w_q, peer_keys, peer_u, peer_v):
    for layer in range(DEPTH):
        i = layer // 2
        h = rms_norm(x, norm_mix[layer])
        if layer % 2 == 0:
            x = x + rwkv_sgu_mixer(h, ab_w_in[i], ab_shift_mu[i], ab_decay_bias[i], ab_decay_up[i],
                                   ab_iclr_bias[i], ab_iclr_up[i], ab_gate_up[i], ab_k_k[i], ab_k_a[i],
                                   ab_r_k[i], ab_gn_w[i], ab_gn_b[i], ab_sgu_ln_w[i], ab_sgu_ln_b[i],
                                   ab_sgu_w[i], ab_sgu_b[i], ab_w_out[i])
        else:
            lambda_init = 0.8 - 0.6 * math.exp(-0.3 * layer)
            x = x + diff_attn_mixer(h, c_w_in[i], c_q_norm[i], c_k_norm[i], c_lambda_q1[i],
                                    c_lambda_k1[i], c_lambda_q2[i], c_lambda_k2[i], c_subln[i],
                                    c_w_out[i], lambda_init)
        x = x + peer(rms_norm(x, norm_ffn[layer]), peer_w_q[layer], peer_keys[layer],
                     peer_u[layer], peer_v[layer])
    return x
```

```cpp
#include <hip/hip_runtime.h>
#include <hip/hip_cooperative_groups.h>
#include <cstdio>
#include <cstdint>
namespace cg = cooperative_groups;
namespace pg8 {
#define PG8_LAS __attribute__((address_space(3)))
typedef unsigned short bf16_t;
typedef short bf16x8 __attribute__((ext_vector_type(8)));
typedef float f32x4 __attribute__((ext_vector_type(4)));
typedef unsigned u32x4 __attribute__((ext_vector_type(4)));
constexpr int BM = 256, BK = 64, HALF = 128, HTB = HALF * BK * 2  , STAGE_BYTES = 8 * HTB, NXCD = 8, WGM = 8;

__host__ __device__ __forceinline__ int lds_byte(int r, int c) { const int st = (r >> 4) * 2 + (c >> 5), rr = r & 15, cc = c & 31, ob = rr * 64 + cc * 2; return st * 1024 + (ob ^ (((ob >> 9) & 1) << 5)); }
__host__ __device__ __forceinline__ void stage_rc(int b, int& R, int& C) { const int st = b / 1024, sb = b % 1024, swz = sb ^ (((sb >> 9) & 1) << 5); R = (st >> 1) * 16 + swz / 64; C = (st & 1) * 32 + (swz % 64) / 2; }
__host__ __device__ __forceinline__ int perm32(int rho) { const int n = rho >> 4, i = rho & 15; return 8 * (i >> 2) + 4 * n + (i & 3); }

struct Unit { int pm, pn; };
struct Gemm { const bf16_t* A; const bf16_t* Bt; int M, N, K; };

struct StaticOrder {
    int nM, nN, nwg, G, c;
    __host__ __device__ void init(int M, int N, int G_, int c_) { nM = M / BM; nN = N / BM; nwg = nM * nN; G = G_; c = c_; }
    __host__ __device__ bool next(int i, Unit& u) const {
        const long L = (long)i * G + c; if (L >= nwg) return false;
        int wgid = (int)L; { const int q = nwg / NXCD, r = nwg % NXCD, xcd = wgid % NXCD, off = wgid / NXCD; wgid = (xcd < r ? xcd * (q + 1) : r * (q + 1) + (xcd - r) * q) + off; }
        const int nig = WGM * nN, gid = wgid / nig, fm = gid * WGM, gsz = (nM - fm) < WGM ? (nM - fm) : WGM;
        u.pm = fm + ((wgid % nig) % gsz); u.pn = (wgid % nig) / gsz; return true;
    }
    __device__ __forceinline__ void a_ready(const Unit&) const {}
    __device__ __forceinline__ void done(const Unit&) const {}
};

__device__ __forceinline__ unsigned cvt_pk_bf16(float lo, float hi) { unsigned r; asm volatile("v_cvt_pk_bf16_f32 %0, %1, %2" : "=v"(r) : "v"(lo), "v"(hi)); return r; }
typedef float f32x2 __attribute__((ext_vector_type(2)));
__device__ __forceinline__ f32x2 gelu_pk(f32x2 v) {
    const f32x2 av = __builtin_elementwise_abs(v), d = av * 0.2316418882f + 1.0f;
    f32x2 t; t.x = __builtin_amdgcn_rcpf(d.x); t.y = __builtin_amdgcn_rcpf(d.y);
    f32x2 q = t * 0.5307027145f + (-0.7265760135f); q = q * t + 0.7107068705f; q = q * t + (-0.142248368f); q = q * t + 0.127414796f; q = q * t;
    const f32x2 s = (v * v) * (-0.72134752044f);
    f32x2 e; e.x = __builtin_amdgcn_exp2f(s.x); e.y = __builtin_amdgcn_exp2f(s.y);
    const f32x2 m = v * (q * e), r = v - m;
    f32x2 o; o.x = v.x < 0.f ? m.x : r.x; o.y = v.y < 0.f ? m.y : r.y; return o;
}

template <int ACT  > struct EpiBf16 {
    static constexpr bool PERM = true, AFTER_DRAIN = false; static_assert(ACT == 0 || ACT == 1, "EpiBf16: ACT is 0 (none) or 1 (gelu_pk)");
    bf16_t* O; int ldc; const float* bias; int split_cols; size_t split_stride; float scale0;
    __device__ __forceinline__ void operator()(const f32x4 (&acc)[2][2][4][2], const Unit& u, int wr, int wc, int fr, int fq) const {
        const int row0 = u.pm * BM + wr * 64 + fr; int colt = u.pn * BM; bf16_t* base = O;
        float sc = 1.f; if (split_cols) { const int t = colt / split_cols; base += (size_t)t * split_stride; colt -= t * split_cols; if (t == 0) sc = scale0; }
        const int col0 = colt + wc * 32 + 8 * fq, bcol0 = u.pn * BM + wc * 32 + 8 * fq;
        f32x4 bv[2][2];
#pragma unroll
        for (int bj = 0; bj < 2; ++bj)
#pragma unroll
            for (int n = 0; n < 2; ++n) bv[bj][n] = bias ? *(const f32x4*)(bias + bcol0 + bj * HALF + 4 * n) : (f32x4){0.f, 0.f, 0.f, 0.f};
#pragma unroll
        for (int ai = 0; ai < 2; ++ai)
#pragma unroll
            for (int m = 0; m < 4; ++m) { bf16_t* rowp = base + (size_t)(row0 + ai * HALF + m * 16) * ldc + col0;
#pragma unroll
                for (int bj = 0; bj < 2; ++bj) { f32x4 v0 = acc[ai][bj][m][0] + bv[bj][0], v1 = acc[ai][bj][m][1] + bv[bj][1];
                    if (ACT == 1) { f32x2 a = gelu_pk((f32x2){v0[0], v0[1]}), b = gelu_pk((f32x2){v0[2], v0[3]}), c = gelu_pk((f32x2){v1[0], v1[1]}), d = gelu_pk((f32x2){v1[2], v1[3]});
                        v0 = (f32x4){a.x, a.y, b.x, b.y}; v1 = (f32x4){c.x, c.y, d.x, d.y}; }
                    v0 = v0 * sc; v1 = v1 * sc; u32x4 w; w.x = cvt_pk_bf16(v0[0], v0[1]); w.y = cvt_pk_bf16(v0[2], v0[3]); w.z = cvt_pk_bf16(v1[0], v1[1]); w.w = cvt_pk_bf16(v1[2], v1[3]);
                    *(u32x4*)(rowp + bj * HALF) = w; } }
    }
};
template <class Epi, class Sched, bool ALIGN_EPI = false, bool SP2 = false>
__device__ __forceinline__ void gemm_phase(PG8_LAS unsigned char* lds, const Gemm g, const Sched& S, const Epi& E) {
    const int tid = threadIdx.x, wid = __builtin_amdgcn_readfirstlane(tid >> 6), lane = tid & 63, wr = wid >> 2, wc = wid & 3, fr = lane & 15, fq = lane >> 4;
    const int K = g.K, nt = K / BK;
    unsigned voffA[2], voffB[2];
#pragma unroll
    for (int i = 0; i < 2; ++i) { int R, C; stage_rc(tid * 16 + i * 8192, R, C); const int Rb = Epi::PERM ? ((R & ~31) + perm32(R & 31)) : R;
        voffA[i] = (unsigned)(R * K + C) * 2u; voffB[i] = (unsigned)(Rb * K + C) * 2u; }
    const size_t kstep = (size_t)(BK * 2);
    const size_t hstep = (size_t)HALF * K * 2;
    const size_t tstep = 2 * hstep;
    const unsigned ldsw = (unsigned)wid * 1024u;
    const int aoff = lds_byte(wr * 64 + fr, fq * 8), boff = lds_byte(wc * 32 + fr, fq * 8);
#define PG8_SA(b, h) (((b) * 2 + (h)) * HTB)
#define PG8_SB(b, h) ((4 + (b) * 2 + (h)) * HTB)
#define PG8_STAGE(bufoff, gbase, voff) do { _Pragma("unroll") for (int _i = 0; _i < 2; ++_i) \
        __builtin_amdgcn_global_load_lds((const unsigned*)((const char*)(gbase) + (voff)[_i]), (PG8_LAS unsigned*)(lds + (bufoff) + ldsw + _i * 8192), 16, 0, 0); } while (0)
#define PG8_LDA(dst, b, h) do { _Pragma("unroll") for (int m = 0; m < 4; ++m) _Pragma("unroll") for (int k = 0; k < 2; ++k) dst[m][k] = *(const PG8_LAS bf16x8*)(lds + PG8_SA(b, h) + aoff + m * 2048 + k * 1024); } while (0)
#define PG8_LDB(dst, b, h) do { _Pragma("unroll") for (int n = 0; n < 2; ++n) _Pragma("unroll") for (int k = 0; k < 2; ++k) dst[n][k] = *(const PG8_LAS bf16x8*)(lds + PG8_SB(b, h) + boff + n * 2048 + k * 1024); } while (0)
#define PG8_MMA(ai, bj, At, Bt) do { __builtin_amdgcn_s_setprio(1); _Pragma("unroll") for (int m = 0; m < 4; ++m) _Pragma("unroll") for (int n = 0; n < 2; ++n) _Pragma("unroll") for (int k = 0; k < 2; ++k) \
        acc[ai][bj][m][n] = __builtin_amdgcn_mfma_f32_16x16x32_bf16(Bt[n][k], At[m][k], acc[ai][bj][m][n], 0, 0, 0); __builtin_amdgcn_s_setprio(0); } while (0)
#define PG8_WAIT_V(n) asm volatile("s_waitcnt vmcnt(" #n ")" ::: "memory")
#define PG8_WAIT_L(n) asm volatile("s_waitcnt lgkmcnt(" #n ")" ::: "memory")
#define PG8_BAR __builtin_amdgcn_s_barrier()
#define PG8_SCHED __builtin_amdgcn_sched_barrier(0)
    Unit cur, nxt; int ui = 0;
    if (!S.next(0, cur)) return;
    f32x4 acc[2][2][4][2];
#pragma unroll
    for (int a = 0; a < 2; ++a)
#pragma unroll
        for (int b = 0; b < 2; ++b)
#pragma unroll
            for (int m = 0; m < 4; ++m)
#pragma unroll
                for (int n = 0; n < 2; ++n) acc[a][b][m][n] = (f32x4){0.f, 0.f, 0.f, 0.f};
    bf16x8 At[4][2], B0[2][2], B1[2][2];
    const char* cA = (const char*)g.A + (size_t)cur.pm * tstep; const char* cB = (const char*)g.Bt + (size_t)cur.pn * tstep;
    S.a_ready(cur);
    if constexpr (SP2) {
        PG8_STAGE(PG8_SB(0, 0), cB, voffB); PG8_STAGE(PG8_SB(0, 1), cB + hstep, voffB); PG8_STAGE(PG8_SA(0, 0), cA, voffA); PG8_STAGE(PG8_SA(0, 1), cA + hstep, voffA);
        if (wr == 1) PG8_BAR;
        PG8_WAIT_V(2); PG8_BAR;
        PG8_STAGE(PG8_SB(1, 0), cB + kstep, voffB); PG8_STAGE(PG8_SA(1, 0), cA + kstep, voffA); PG8_STAGE(PG8_SB(1, 1), cB + hstep + kstep, voffB);
        PG8_WAIT_V(6); PG8_BAR;
    } else {
        PG8_STAGE(PG8_SB(0, 0), cB, voffB); PG8_STAGE(PG8_SA(0, 0), cA, voffA); PG8_STAGE(PG8_SB(0, 1), cB + hstep, voffB); PG8_STAGE(PG8_SA(0, 1), cA + hstep, voffA);
        if (wr == 1) PG8_BAR;
        PG8_WAIT_V(4); PG8_BAR;
        PG8_STAGE(PG8_SB(1, 0), cB + kstep, voffB); PG8_STAGE(PG8_SA(1, 0), cA + kstep, voffA); PG8_STAGE(PG8_SB(1, 1), cB + hstep + kstep, voffB);
        PG8_WAIT_V(6); PG8_BAR;
    }
    for (;;) {
        const bool has_next = S.next(ui + 1, nxt);
        const char* nA = has_next ? (const char*)g.A + (size_t)nxt.pm * tstep : cA; const char* nB = has_next ? (const char*)g.Bt + (size_t)nxt.pn * tstep : cB;
        for (int t = 0; t < nt; t += 2) {
            const bool last = (t == nt - 2);
            const char* a1 = cA + (size_t)(t + 1) * kstep;
            const char* a2 = last ? nA : cA + (size_t)(t + 2) * kstep; const char* b2 = last ? nB : cB + (size_t)(t + 2) * kstep;
            const char* a3 = a2 + kstep; const char* b3 = b2 + kstep;
            if (last && has_next) S.a_ready(nxt);
            if constexpr (SP2) {
            PG8_LDB(B0, 0, 0); PG8_LDB(B1, 0, 1); PG8_SCHED; PG8_LDA(At, 0, 0); PG8_STAGE(PG8_SA(1, 1), a1 + hstep, voffA);
            PG8_WAIT_V(8); PG8_WAIT_L(0); PG8_BAR; PG8_MMA(0, 0, At, B0); PG8_MMA(0, 1, At, B1); PG8_BAR; PG8_SCHED;
            PG8_LDA(At, 0, 1); PG8_STAGE(PG8_SB(0, 0), b2, voffB); PG8_STAGE(PG8_SB(0, 1), b2 + hstep, voffB); PG8_STAGE(PG8_SA(0, 0), a2, voffA);
            PG8_WAIT_V(8); PG8_WAIT_L(0); PG8_BAR; PG8_MMA(1, 0, At, B0); PG8_MMA(1, 1, At, B1); PG8_BAR; PG8_SCHED;
            PG8_LDB(B0, 1, 0); PG8_LDB(B1, 1, 1); PG8_SCHED; PG8_LDA(At, 1, 0); PG8_STAGE(PG8_SA(0, 1), a2 + hstep, voffA);
            PG8_WAIT_V(8); PG8_WAIT_L(0); PG8_BAR; PG8_MMA(0, 0, At, B0); PG8_MMA(0, 1, At, B1); PG8_BAR; PG8_SCHED;
            PG8_LDA(At, 1, 1); PG8_STAGE(PG8_SB(1, 0), b3, voffB); PG8_STAGE(PG8_SB(1, 1), b3 + hstep, voffB); PG8_STAGE(PG8_SA(1, 0), a3, voffA);
            PG8_WAIT_V(8); PG8_WAIT_L(0); PG8_BAR; PG8_MMA(1, 0, At, B0); PG8_MMA(1, 1, At, B1); PG8_BAR; PG8_SCHED;
            } else {
            PG8_LDB(B0, 0, 0); PG8_SCHED; PG8_LDA(At, 0, 0); PG8_STAGE(PG8_SA(1, 1), a1 + hstep, voffA);
            PG8_WAIT_L(8); PG8_BAR; PG8_WAIT_L(0); PG8_MMA(0, 0, At, B0); PG8_BAR; PG8_SCHED;
            PG8_LDB(B1, 0, 1); PG8_STAGE(PG8_SB(0, 0), b2, voffB);
            PG8_BAR; PG8_WAIT_L(0); PG8_MMA(0, 1, At, B1); PG8_BAR;
            PG8_LDA(At, 0, 1); PG8_STAGE(PG8_SA(0, 0), a2, voffA);
            PG8_BAR; PG8_WAIT_L(0); PG8_MMA(1, 0, At, B0); PG8_BAR; PG8_SCHED;
            PG8_STAGE(PG8_SB(0, 1), b2 + hstep, voffB);
            PG8_WAIT_V(6); PG8_BAR; PG8_MMA(1, 1, At, B1); PG8_BAR;
            PG8_LDB(B0, 1, 0); PG8_SCHED; PG8_LDA(At, 1, 0); PG8_STAGE(PG8_SA(0, 1), a2 + hstep, voffA);
            PG8_WAIT_L(8); PG8_BAR; PG8_WAIT_L(0); PG8_MMA(0, 0, At, B0); PG8_BAR; PG8_SCHED;
            PG8_LDB(B1, 1, 1); PG8_STAGE(PG8_SB(1, 0), b3, voffB);
            PG8_BAR; PG8_WAIT_L(0); PG8_MMA(0, 1, At, B1); PG8_BAR;
            PG8_LDA(At, 1, 1); PG8_STAGE(PG8_SA(1, 0), a3, voffA);
            PG8_BAR; PG8_WAIT_L(0); PG8_MMA(1, 0, At, B0); PG8_BAR; PG8_SCHED;
            PG8_STAGE(PG8_SB(1, 1), b3 + hstep, voffB);
            PG8_WAIT_V(6); PG8_BAR; PG8_MMA(1, 1, At, B1); PG8_BAR;
            }
        }
        if constexpr (ALIGN_EPI) { if (wr == 0) PG8_BAR; }
        if constexpr (!Epi::AFTER_DRAIN) { E(acc, cur, wr, wc, fr, fq); S.done(cur); }
        if (!has_next) break;
#pragma unroll
        for (int a = 0; a < 2; ++a)
#pragma unroll
            for (int b = 0; b < 2; ++b)
#pragma unroll
                for (int m = 0; m < 4; ++m)
#pragma unroll
                    for (int n = 0; n < 2; ++n) acc[a][b][m][n] = (f32x4){0.f, 0.f, 0.f, 0.f};
        cur = nxt; cA = nA; cB = nB; ++ui;
        if constexpr (ALIGN_EPI) { if (wr == 1) PG8_BAR; }
    }
    PG8_WAIT_V(0);
    if constexpr (!ALIGN_EPI) { if (wr == 0) PG8_BAR; }
    PG8_BAR;
    if constexpr (Epi::AFTER_DRAIN) { E.fused(acc, cur, wr, wc, fr, fq, lds, wid, lane); S.done(cur); }
#undef PG8_SA
#undef PG8_SB
#undef PG8_STAGE
#undef PG8_LDA
#undef PG8_LDB
#undef PG8_MMA
#undef PG8_WAIT_V
#undef PG8_WAIT_L
#undef PG8_BAR
#undef PG8_SCHED
}
}
constexpr int M_TOK = 16384, DM = 2048, SEQ = 4096;
constexpr int NWAVES = 8, NTHREADS = 512;
constexpr int A_COLS = 3328, AB_COLS = 5376, C_COLS = 6144;
constexpr float DECAY_SCALE = 0.6065306597126334f;
constexpr float LAMBDA_INIT = 0.35550906759096316f;
constexpr float QSCALE = 0.125f * 1.4426950408889634f;

#define LAS __attribute__((address_space(3)))
typedef unsigned short bf16_t;
typedef short bf16x8 __attribute__((ext_vector_type(8)));
typedef short s16x4 __attribute__((ext_vector_type(4)));
typedef float f32x4 __attribute__((ext_vector_type(4)));
typedef float f32x2 __attribute__((ext_vector_type(2)));
typedef float f32x16 __attribute__((ext_vector_type(16)));
typedef unsigned u32x4 __attribute__((ext_vector_type(4)));
typedef unsigned u32x2 __attribute__((ext_vector_type(2)));
typedef unsigned u32x6 __attribute__((ext_vector_type(6)));
typedef float f32x32 __attribute__((ext_vector_type(32)));
#ifndef FP6_INTERLEAVED
#define FP6_INTERLEAVED 1
#endif
#ifndef L0_FMT
#define L0_FMT 4
#endif
#define FP6_IDX_A(i) (i)
#define FP6_IDX_B(i) (16 + (i))
#if FP6_INTERLEAVED
#define FP6_OUT_A(i) (2 * (i))
#define FP6_OUT_B(i) (2 * (i) + 1)
#else
#define FP6_OUT_A(i) (i)
#define FP6_OUT_B(i) (16 + (i))
#endif

constexpr size_t MiB = 1u << 20;
constexpr size_t WS_CTL = 0;
constexpr size_t WS_WT_AB = 2 * MiB, WS_WT_ABO = 23 * MiB, WS_WT_C = 31 * MiB, WS_WT_CO = 55 * MiB, WS_WT_Q = 63 * MiB  ;
constexpr size_t WS_BT_LORA = 79 * MiB, WS_KEYS = 81 * MiB, WS_ROPE = 82 * MiB, WS_SCALE = 83 * MiB;
constexpr size_t WS_UT = 84 * MiB, WS_VT = 212 * MiB, WS_XN = 340 * MiB;
constexpr size_t WS_PA = 404 * MiB, WS_Z = 508 * MiB, WS_ALORA = 572 * MiB, WS_DLOG = 580 * MiB, WS_ICLR = 612 * MiB, WS_GATE = 644 * MiB;
constexpr size_t WS_BONUS = 868 * MiB, WS_Y = 869 * MiB, WS_YAB = 933 * MiB, WS_END = 997 * MiB;
constexpr size_t WS_QP = 404 * MiB, WS_EIDX = 468 * MiB, WS_EGATE = 476 * MiB;
constexpr size_t WS_QKV = 508 * MiB, WS_OB = 700 * MiB;
constexpr int LDS_BYTES = 147456;

__device__ __forceinline__ float bf_lo(unsigned w) { return __uint_as_float(w << 16); }
__device__ __forceinline__ float bf_hi(unsigned w) { return __uint_as_float(w & 0xffff0000u); }
__device__ __forceinline__ float bf_1(unsigned short w) { return __uint_as_float(((unsigned)w) << 16); }
__device__ __forceinline__ unsigned pkbf(float lo, float hi) { return pg8::cvt_pk_bf16(lo, hi); }
typedef __bf16 bf16x2_t __attribute__((ext_vector_type(2)));
__device__ __forceinline__ unsigned pkbf_c(float lo, float hi) { const f32x2 v = {lo, hi}; const bf16x2_t b = __builtin_convertvector(v, bf16x2_t); return __builtin_bit_cast(unsigned, b); }
__device__ __forceinline__ void unpack8(const u32x4 a, float (&o)[8]) {
    o[0] = bf_lo(a.x); o[1] = bf_hi(a.x); o[2] = bf_lo(a.y); o[3] = bf_hi(a.y); o[4] = bf_lo(a.z); o[5] = bf_hi(a.z); o[6] = bf_lo(a.w); o[7] = bf_hi(a.w);
}
__device__ __forceinline__ u32x4 pack8(const float (&o)[8]) { u32x4 r; r.x = pkbf(o[0], o[1]); r.y = pkbf(o[2], o[3]); r.z = pkbf(o[4], o[5]); r.w = pkbf(o[6], o[7]); return r; }
__device__ __forceinline__ void ld16bf(const bf16_t* p, float (&o)[16]) {
    const u32x4 a = *(const u32x4*)p, b = *(const u32x4*)(p + 8); float t[8];
    unpack8(a, t);
#pragma unroll
    for (int i = 0; i < 8; ++i) o[i] = t[i];
    unpack8(b, t);
#pragma unroll
    for (int i = 0; i < 8; ++i) o[8 + i] = t[i];
}
__device__ __forceinline__ void st16bf(bf16_t* p, const float (&o)[16]) {
    u32x4 a, b; a.x = pkbf(o[0], o[1]); a.y = pkbf(o[2], o[3]); a.z = pkbf(o[4], o[5]); a.w = pkbf(o[6], o[7]);
    b.x = pkbf(o[8], o[9]); b.y = pkbf(o[10], o[11]); b.z = pkbf(o[12], o[13]); b.w = pkbf(o[14], o[15]);
    *(u32x4*)p = a; *(u32x4*)(p + 8) = b;
}
__device__ __forceinline__ void ld16f(const float* p, float (&o)[16]) {
#pragma unroll
    for (int i = 0; i < 4; ++i) { const f32x4 v = *(const f32x4*)(p + 4 * i); o[4 * i] = v.x; o[4 * i + 1] = v.y; o[4 * i + 2] = v.z; o[4 * i + 3] = v.w; }
}
__device__ __forceinline__ float sigmoidf_(float x) { return __builtin_amdgcn_rcpf(1.0f + __expf(-x)); }

template <int CTRL> __device__ __forceinline__ float dpp_mov(float x) { return __int_as_float(__builtin_amdgcn_update_dpp(0, __float_as_int(x), CTRL, 0xf, 0xf, true)); }
__device__ __forceinline__ float quad_sum(float x) { x += dpp_mov<0xB1>(x); x += dpp_mov<0x4E>(x); return x; }
__device__ __forceinline__ float oct_sum(float x) { x = quad_sum(x); x += dpp_mov<0x141>(x); return x; }
__device__ __forceinline__ float row16_sum(float x) { x = oct_sum(x); x += dpp_mov<0x140>(x); return x; }
__device__ __forceinline__ float wave_sum(float x) { x = row16_sum(x); x += __shfl_xor(x, 16); x += __shfl_xor(x, 32); return x; }
__device__ __forceinline__ float row16_max(float x) {
    x = fmaxf(x, dpp_mov<0xB1>(x)); x = fmaxf(x, dpp_mov<0x4E>(x)); x = fmaxf(x, dpp_mov<0x141>(x)); x = fmaxf(x, dpp_mov<0x140>(x)); return x;
}
__device__ __forceinline__ float wave_max(float x) { x = row16_max(x); x = fmaxf(x, __shfl_xor(x, 16)); x = fmaxf(x, __shfl_xor(x, 32)); return x; }

__device__ __forceinline__ unsigned fkey(float f) { const unsigned u = __float_as_uint(f); return u ^ ((unsigned)((int)u >> 31) | 0x80000000u); }
__device__ __forceinline__ int crow(int r, int hi) { return (r & 3) + 8 * (r >> 2) + 4 * hi; }
__device__ __forceinline__ s16x4 vtr(LAS unsigned char* p) { typedef short v4i16_t __attribute__((ext_vector_type(4))); return __builtin_bit_cast(s16x4, __builtin_amdgcn_ds_read_tr16_b64_v4i16((LAS v4i16_t*)p)); }
__device__ __forceinline__ float gelu1(float v) { pg8::f32x2 r = pg8::gelu_pk((pg8::f32x2){v, v}); return r.x; }

struct EpiAB {
    static constexpr bool PERM = true, AFTER_DRAIN = false;
    bf16_t* PA; bf16_t* Z;
    __device__ __forceinline__ void operator()(const pg8::f32x4 (&acc)[2][2][4][2], const pg8::Unit& u, int wr, int wc, int fr, int fq) const {
        const int row0 = u.pm * 256 + wr * 64 + fr;
        const bool isz = u.pn >= 13;
        bf16_t* base = isz ? Z : PA; const int ldc = isz ? 2048 : A_COLS; const int colt = isz ? (u.pn - 13) * 256 : u.pn * 256;
        const int col0 = colt + wc * 32 + 8 * fq;
#pragma unroll
        for (int ai = 0; ai < 2; ++ai)
#pragma unroll
            for (int m = 0; m < 4; ++m) { bf16_t* rowp = base + (size_t)(row0 + ai * 128 + m * 16) * ldc + col0;
#pragma unroll
                for (int bj = 0; bj < 2; ++bj) { pg8::f32x4 v0 = acc[ai][bj][m][0], v1 = acc[ai][bj][m][1];
                    if (isz) { pg8::f32x2 a = pg8::gelu_pk((pg8::f32x2){v0[0], v0[1]}), b = pg8::gelu_pk((pg8::f32x2){v0[2], v0[3]}), c = pg8::gelu_pk((pg8::f32x2){v1[0], v1[1]}), d = pg8::gelu_pk((pg8::f32x2){v1[2], v1[3]});
                        v0 = (pg8::f32x4){a.x, a.y, b.x, b.y}; v1 = (pg8::f32x4){c.x, c.y, d.x, d.y}; }
                    u32x4 w; w.x = pkbf(v0[0], v0[1]); w.y = pkbf(v0[2], v0[3]); w.z = pkbf(v1[0], v1[1]); w.w = pkbf(v1[2], v1[3]);
                    *(u32x4*)(rowp + bj * 128) = w; } }
    }
};
struct EpiLora {
    static constexpr bool PERM = true, AFTER_DRAIN = false;
    bf16_t* base3; const float *dbias, *ibias;
    __device__ __forceinline__ void operator()(const pg8::f32x4 (&acc)[2][2][4][2], const pg8::Unit& u, int wr, int wc, int fr, int fq) const {
        const int row0 = u.pm * 256 + wr * 64 + fr;
        const int kind = u.pn >> 2; const int colt = (u.pn & 3) * 256;
        bf16_t* base = base3 + (size_t)kind * (size_t)(16 * MiB);
        const float* bias = kind == 0 ? dbias : ibias;
        const int col0 = colt + wc * 32 + 8 * fq;
#pragma unroll
        for (int bj = 0; bj < 2; ++bj) {
            pg8::f32x4 b0 = (pg8::f32x4){0.f, 0.f, 0.f, 0.f}, b1 = b0;
            if (kind < 2) { b0 = *(const pg8::f32x4*)(bias + col0 + bj * 128); b1 = *(const pg8::f32x4*)(bias + col0 + bj * 128 + 4); }
#pragma unroll
            for (int ai = 0; ai < 2; ++ai)
#pragma unroll
                for (int m = 0; m < 4; ++m) { bf16_t* rowp = base + (size_t)(row0 + ai * 128 + m * 16) * 1024 + col0;
                    pg8::f32x4 v0 = acc[ai][bj][m][0] + b0, v1 = acc[ai][bj][m][1] + b1;
                    if (kind < 2) { const float sc = kind == 0 ? DECAY_SCALE : 1.0f;
#pragma unroll
                        for (int i = 0; i < 4; ++i) { v0[i] = sc * sigmoidf_(v0[i]); v1[i] = sc * sigmoidf_(v1[i]); } }
                    u32x4 w; w.x = pkbf(v0[0], v0[1]); w.y = pkbf(v0[2], v0[3]); w.z = pkbf(v1[0], v1[1]); w.w = pkbf(v1[2], v1[3]);
                    *(u32x4*)(rowp + bj * 128) = w; } }
    }
};
struct EpiRes {
    static constexpr bool PERM = false, AFTER_DRAIN = false;
    const float* res; float* out;
    __device__ __forceinline__ void operator()(const pg8::f32x4 (&acc)[2][2][4][2], const pg8::Unit& u, int wr, int wc, int fr, int fq) const {
        const int row0 = u.pm * 256 + wr * 64 + fr; const int col0 = u.pn * 256 + wc * 32 + 4 * fq;
#pragma unroll
        for (int ai = 0; ai < 2; ++ai)
#pragma unroll
            for (int m = 0; m < 4; ++m) { const size_t off = (size_t)(row0 + ai * 128 + m * 16) * DM + col0;
#pragma unroll
                for (int bj = 0; bj < 2; ++bj)
#pragma unroll
                    for (int n = 0; n < 2; ++n) { const pg8::f32x4 r = *(const pg8::f32x4*)(res + off + bj * 128 + n * 16); *(pg8::f32x4*)(out + off + bj * 128 + n * 16) = r + acc[ai][bj][m][n]; } }
    }
};

struct Frame {
    LAS unsigned char* lds;
    int tid, lane, wave, G, bid;
    int gw, NGW;
};

__device__ __forceinline__ void rms_row_to_bf16(const float* xrow, const float* g, bf16_t* orow, int lane) {
    const f32x4* xr = (const f32x4*)xrow + lane; f32x4 v[8]; float s = 0.f;
#pragma unroll
    for (int j = 0; j < 8; ++j) { v[j] = xr[64 * j]; s += (v[j].x * v[j].x + v[j].y * v[j].y) + (v[j].z * v[j].z + v[j].w * v[j].w); }
    const float rstd = rsqrtf(wave_sum(s) * (1.0f / DM) + 1e-6f);
    const f32x4* gr = (const f32x4*)g + lane; u32x2* o8 = (u32x2*)orow + lane;
#pragma unroll
    for (int j = 0; j < 8; ++j) { const f32x4 gv = gr[64 * j]; u32x2 w; w.x = pkbf(v[j].x * rstd * gv.x, v[j].y * rstd * gv.y); w.y = pkbf(v[j].z * rstd * gv.z, v[j].w * rstd * gv.w); o8[64 * j] = w; }
}

__device__ __forceinline__ void p0_transpose_item(const float* W, int K, int N, bf16_t* WT, int row_off, LAS float* scr, int item, int lane) {
    const int nblk = N / 32, kb = item / nblk, nb = item % nblk, k0 = 64 * kb, n0 = 32 * nb;
#pragma unroll 8
    for (int i = 0; i < 32; ++i) { const int kk = 2 * i + (lane >> 5); scr[kk * 33 + (lane & 31)] = W[(size_t)(k0 + kk) * N + n0 + (lane & 31)]; }
    asm volatile("s_waitcnt lgkmcnt(0)" ::: "memory");
    const int c = lane & 7;
#pragma unroll
    for (int j = 0; j < 4; ++j) { const int n = (lane >> 3) + 8 * j; const LAS float* s = scr + (8 * c) * 33 + n;
        u32x4 o; o.x = pkbf(s[0 * 33], s[1 * 33]); o.y = pkbf(s[2 * 33], s[3 * 33]); o.z = pkbf(s[4 * 33], s[5 * 33]); o.w = pkbf(s[6 * 33], s[7 * 33]);
        *(u32x4*)(WT + (size_t)(row_off + n0 + n) * K + k0 + 8 * c) = o; }
    asm volatile("s_waitcnt lgkmcnt(0)" ::: "memory");
}

struct Ptrs {
    const float* in[33];
    float* out;
    unsigned char* ws;
};
typedef const __attribute__((address_space(4))) Ptrs* CP;
__device__ __forceinline__ CP launder(CP p) { asm volatile("" : "+s"(p)); return p; }

__device__ __forceinline__ void quant_load(CP P, int r, int lane, f32x4 (&x)[8]) {
    const int rr = r & 32767; const bool isv = r >= 32768;
    const float* src = (isv ? P->in[32] : P->in[31]) + (size_t)rr * DM + 4 * lane;
#pragma unroll
    for (int k = 0; k < 8; ++k) x[k] = *(const f32x4*)(src + 256 * k);
}
__device__ __forceinline__ void quant_finish(CP P, int r, int lane, const f32x4 (&x)[8]) {
    unsigned char* ws = P->ws; float* SC = (float*)(ws + WS_SCALE);
    const int rr = r & 32767; const bool isv = r >= 32768; const int layer = rr >> 14, e = rr & 16383;
    unsigned char* tab = ws + (isv ? WS_VT : WS_UT);
    float v[32]; float am = 0.f;
#pragma unroll
    for (int k = 0; k < 8; ++k) { v[4 * k] = x[k].x; v[4 * k + 1] = x[k].y; v[4 * k + 2] = x[k].z; v[4 * k + 3] = x[k].w;
        am = fmaxf(am, fmaxf(fmaxf(fabsf(x[k].x), fabsf(x[k].y)), fmaxf(fabsf(x[k].z), fabsf(x[k].w)))); }
    am = wave_max(am); const bool f6 = (layer == 0 && L0_FMT == 6); const float sc = fmaxf(am, 1e-30f) * (f6 ? (1.0f / 7.5f) : (1.0f / 6.0f)), inv = 1.0f / sc;
#pragma unroll
    for (int i = 0; i < 32; ++i) v[i] *= inv;
    if (f6) {
        f32x16 a, b;
#pragma unroll
        for (int i = 0; i < 16; ++i) { a[i] = v[FP6_IDX_A(i)]; b[i] = v[FP6_IDX_B(i)]; }
        const u32x6 q = __builtin_amdgcn_cvt_scalef32_2xpk16_fp6_f32(a, b, 1.0f);
        unsigned char* dst = tab + (size_t)e * 1536;
        *(u32x4*)(dst + 16 * lane) = (u32x4){q[0], q[1], q[2], q[3]}; *(u32x2*)(dst + 1024 + 8 * lane) = (u32x2){q[4], q[5]};
    } else {
        u32x4 q;
#pragma unroll
        for (int d = 0; d < 4; ++d) { unsigned w = 0u;
            w = __builtin_amdgcn_cvt_scalef32_pk_fp4_f32(w, v[8 * d + 0], v[8 * d + 1], 1.0f, 0); w = __builtin_amdgcn_cvt_scalef32_pk_fp4_f32(w, v[8 * d + 2], v[8 * d + 3], 1.0f, 1);
            w = __builtin_amdgcn_cvt_scalef32_pk_fp4_f32(w, v[8 * d + 4], v[8 * d + 5], 1.0f, 2); w = __builtin_amdgcn_cvt_scalef32_pk_fp4_f32(w, v[8 * d + 6], v[8 * d + 7], 1.0f, 3); q[d] = w; }
        *(u32x4*)(tab + (size_t)layer * 32 * MiB + (size_t)e * 1024 + 16 * lane) = q;
    }
    if (lane == 0) SC[r] = sc;
}

__device__ __forceinline__ void late_transpose_item(CP P, int item, LAS float* scr, int lane) {
    unsigned char* ws = P->ws; constexpr int I_SQ = 32 * 64, I_C = 32 * (C_COLS / 32);
    int r = item;
    if (r < I_SQ) { p0_transpose_item(P->in[19], DM, DM, (bf16_t*)(ws + WS_WT_ABO), 0, scr, r, lane); return; } r -= I_SQ;
    if (r < I_C) { p0_transpose_item(P->in[20], DM, C_COLS, (bf16_t*)(ws + WS_WT_C), 0, scr, r, lane); return; } r -= I_C;
    if (r < I_SQ) { p0_transpose_item(P->in[28], DM, DM, (bf16_t*)(ws + WS_WT_CO), 0, scr, r, lane); return; } r -= I_SQ;
    if (r < I_SQ) { p0_transpose_item(P->in[29], DM, DM, (bf16_t*)(ws + WS_WT_Q), 0, scr, r, lane); return; } r -= I_SQ;
    p0_transpose_item(P->in[29] + (size_t)DM * DM, DM, DM, (bf16_t*)(ws + WS_WT_Q + 8 * MiB), 0, scr, r, lane);
}

__device__ __forceinline__ void phase_prologue(const Frame& F, CP P) {
    unsigned char* ws = P->ws;
    LAS float* scr = (LAS float*)(F.lds + F.wave * 16384);
    constexpr int I_AB = 32 * (AB_COLS / 32), I_SQ = 32 * 64;
    for (int it = F.gw; it < I_AB; it += F.NGW) p0_transpose_item(P->in[3], DM, AB_COLS, (bf16_t*)(ws + WS_WT_AB), 0, scr, it, F.lane);
    const int gt = F.bid * NTHREADS + F.tid, NGT = F.G * NTHREADS;
    {   bf16_t* BT = (bf16_t*)(ws + WS_BT_LORA);
        for (int it = gt; it < 3072 * 32; it += NGT) {
            const int kg = it / 3072, n = it % 3072, k0 = kg * 8; float v[8];
#pragma unroll
            for (int i = 0; i < 8; ++i) { const int k = k0 + i; float x = 0.f;
                if (n < 1024) { if (k < 64) x = P->in[6][(size_t)k * 1024 + n]; }
                else if (n < 2048) { if (k >= 64 && k < 128) x = P->in[8][(size_t)(k - 64) * 1024 + (n - 1024)]; }
                else { if (k >= 128) x = P->in[9][(size_t)(k - 128) * 1024 + (n - 2048)]; }
                v[i] = x; }
            *(u32x4*)(BT + (size_t)n * 256 + k0) = pack8(v);
        } }
    {   const f32x4* src = (const f32x4*)P->in[30]; u32x4* dst = (u32x4*)(ws + WS_KEYS);
        for (int it = gt; it < 65536; it += NGT) { const f32x4 a = src[2 * it], b = src[2 * it + 1]; u32x4 o; o.x = pkbf(a.x, a.y); o.y = pkbf(a.z, a.w); o.z = pkbf(b.x, b.y); o.w = pkbf(b.z, b.w); dst[it] = o; } }
    {   f32x2* rt = (f32x2*)(ws + WS_ROPE);
        for (int it = gt; it < 4096 * 8; it += NGT) { const int pos = it >> 3, i = it & 7; const float inv = powf(500000.0f, -(float)i * 0.125f); const float ang = (float)pos * inv; rt[it] = (f32x2){cosf(ang), sinf(ang)}; } }
    for (int m = F.gw; m < M_TOK; m += F.NGW) rms_row_to_bf16(P->in[0] + (size_t)m * DM, P->in[1], (bf16_t*)(ws + WS_XN) + (size_t)m * DM, F.lane);
}

__device__ __forceinline__ void phase_row_a(const Frame& F, CP P) {
    const bf16_t* PA = (const bf16_t*)(P->ws + WS_PA); bf16_t* Z = (bf16_t*)(P->ws + WS_Z); bf16_t* AL = (bf16_t*)(P->ws + WS_ALORA);
    const float* mu = P->in[4] + 3072; const float* lnw = P->in[15]; const float* lnb = P->in[16];
    const int lane = F.lane;
    for (int t = F.gw; t < M_TOK; t += F.NGW) {
        {   const int c = 4 * lane;
            const u32x2 cu = *(const u32x2*)(PA + (size_t)t * A_COLS + 3072 + c);
            u32x2 pv = (u32x2){0u, 0u}; if ((t & (SEQ - 1)) != 0) pv = *(const u32x2*)(PA + (size_t)(t - 1) * A_COLS + 3072 + c);
            const f32x4 m4 = *(const f32x4*)(mu + c);
            float cur[4] = {bf_lo(cu.x), bf_hi(cu.x), bf_lo(cu.y), bf_hi(cu.y)}, prv[4] = {bf_lo(pv.x), bf_hi(pv.x), bf_lo(pv.y), bf_hi(pv.y)}, mm[4] = {m4.x, m4.y, m4.z, m4.w}, o[4];
#pragma unroll
            for (int i = 0; i < 4; ++i) { const float v = cur[i] + (prv[i] - cur[i]) * mm[i]; o[i] = (c < 64) ? tanhf(v) : ((c < 128) ? v : sigmoidf_(v)); }
            u32x2 w; w.x = pkbf(o[0], o[1]); w.y = pkbf(o[2], o[3]); *(u32x2*)(AL + (size_t)t * 256 + c) = w; }
        {   bf16_t* zr = Z + (size_t)t * 2048 + 1024; float v[16]; float t8[8];
            unpack8(*(const u32x4*)(zr + 8 * lane), t8);
#pragma unroll
            for (int i = 0; i < 8; ++i) v[i] = t8[i];
            unpack8(*(const u32x4*)(zr + 512 + 8 * lane), t8);
#pragma unroll
            for (int i = 0; i < 8; ++i) v[8 + i] = t8[i];
            float s = 0.f;
#pragma unroll
            for (int i = 0; i < 16; ++i) s += v[i];
            const float mean = wave_sum(s) * (1.0f / 1024.0f); float q = 0.f;
#pragma unroll
            for (int i = 0; i < 16; ++i) { v[i] -= mean; q += v[i] * v[i]; }
            const float rstd = rsqrtf(wave_sum(q) * (1.0f / 1024.0f) + 1e-5f);
#pragma unroll
            for (int j = 0; j < 2; ++j) { const int c = 512 * j + 8 * lane; float o[8];
                const f32x4 w0 = *(const f32x4*)(lnw + c), w1 = *(const f32x4*)(lnw + c + 4), b0 = *(const f32x4*)(lnb + c), b1 = *(const f32x4*)(lnb + c + 4);
                const float ww[8] = {w0.x, w0.y, w0.z, w0.w, w1.x, w1.y, w1.z, w1.w}, bb[8] = {b0.x, b0.y, b0.z, b0.w, b1.x, b1.y, b1.z, b1.w};
#pragma unroll
                for (int i = 0; i < 8; ++i) o[i] = v[8 * j + i] * rstd * ww[i] + bb[i];
                *(u32x4*)(zr + c) = pack8(o); } }
    }
}

__device__ __forceinline__ void sgu_tile(const Frame& F, CP P, int tile) {
    const int tid = F.tid, wave = F.wave, lane = F.lane, q31 = lane & 31, hh = lane >> 5; const int cch = tile >> 3, g = tile & 7, t0 = cch * 128;
    const bf16_t* Z = (const bf16_t*)(P->ws + WS_Z); bf16_t* YAB = (bf16_t*)(P->ws + WS_YAB);
    const float* Wg = P->in[17] + (size_t)g * 16384; const float* bs = P->in[18] + g * 128;
    LAS unsigned char* Wl = F.lds;
    LAS unsigned char* Vl = F.lds + 34816;
#pragma unroll
    for (int i = 0; i < 8; ++i) { const int p = tid + 512 * i, t = p >> 5, s4 = (p & 31) * 4; f32x4 w = *(const f32x4*)(Wg + t * 128 + s4);
        if (s4 + 0 > t) w.x = 0.f; if (s4 + 1 > t) w.y = 0.f; if (s4 + 2 > t) w.z = 0.f; if (s4 + 3 > t) w.w = 0.f;
        *(LAS u32x2*)(Wl + t * 272 + s4 * 2) = (u32x2){pkbf(w.x, w.y), pkbf(w.z, w.w)}; }
#pragma unroll
    for (int i = 0; i < 4; ++i) { const int p = tid + 512 * i, s = p >> 4, d8 = (p & 15) * 8;
        *(LAS u32x4*)(Vl + s * 320 + d8 * 2) = *(const u32x4*)(Z + (size_t)(t0 + s) * 2048 + 1024 + g * 128 + d8); }
    __syncthreads();
    const int dt = wave & 3, tiA = (wave >> 2) ? 1 : 0, tiB = (wave >> 2) ? 2 : 3;
    f32x16 accA, accB;
#pragma unroll
    for (int r = 0; r < 16; ++r) { accA[r] = 0.f; accB[r] = 0.f; }
    LAS unsigned char* Vb = Vl + (8 * hh + ((lane >> 2) & 3)) * 320 + (32 * dt + 16 * ((lane >> 4) & 1) + 4 * (lane & 3)) * 2;
    const LAS unsigned char* WbA = Wl + (32 * tiA + q31) * 272 + hh * 16; const LAS unsigned char* WbB = Wl + (32 * tiB + q31) * 272 + hh * 16;
    const int nA = 2 * tiA + 2, nB = 2 * tiB + 2;
    for (int ks = 0; ks < nB; ++ks) {
        const s16x4 lo = vtr(Vb + (16 * ks) * 320), hi = vtr(Vb + (16 * ks + 4) * 320);
        const bf16x8 vf = (bf16x8){lo[0], lo[1], lo[2], lo[3], hi[0], hi[1], hi[2], hi[3]};
        const bf16x8 wb = *(const LAS bf16x8*)(WbB + ks * 32);
        accB = __builtin_amdgcn_mfma_f32_32x32x16_bf16(vf, wb, accB, 0, 0, 0);
        if (ks < nA) { const bf16x8 wa = *(const LAS bf16x8*)(WbA + ks * 32); accA = __builtin_amdgcn_mfma_f32_32x32x16_bf16(vf, wa, accA, 0, 0, 0); }
    }
#pragma unroll
    for (int which = 0; which < 2; ++which) { const int ti = which ? tiB : tiA; const int t = 32 * ti + q31; const float bias = bs[t];
        const bf16_t* up = Z + (size_t)(t0 + t) * 2048 + g * 128 + 32 * dt + 4 * hh; bf16_t* op = YAB + (size_t)(t0 + t) * 2048 + 1024 + g * 128 + 32 * dt + 4 * hh;
#pragma unroll
        for (int g4 = 0; g4 < 4; ++g4) { const u32x2 uu = *(const u32x2*)(up + 8 * g4);
            const float a0 = which ? accB[4 * g4 + 0] : accA[4 * g4 + 0], a1 = which ? accB[4 * g4 + 1] : accA[4 * g4 + 1], a2 = which ? accB[4 * g4 + 2] : accA[4 * g4 + 2], a3 = which ? accB[4 * g4 + 3] : accA[4 * g4 + 3];
            *(u32x2*)(op + 8 * g4) = (u32x2){pkbf(bf_lo(uu.x) * (a0 + bias), bf_hi(uu.x) * (a1 + bias)), pkbf(bf_lo(uu.y) * (a2 + bias), bf_hi(uu.y) * (a3 + bias))}; } }
    __syncthreads();
}

__device__ __forceinline__ void phase_gn(const Frame& F, CP P) {
    const float* Y = (const float*)(P->ws + WS_Y); const float* BON = (const float*)(P->ws + WS_BONUS);
    const bf16_t* GT = (const bf16_t*)(P->ws + WS_GATE); bf16_t* YAB = (bf16_t*)(P->ws + WS_YAB);
    const float* gnw = P->in[13]; const float* gnb = P->in[14];
    const int lane = F.lane, c = 16 * lane, h = lane >> 2, q = lane & 3;
    for (int t = F.gw; t < M_TOK; t += F.NGW) {
        float y[16], tmp[16], tb[16], o[16];
        ld16f(Y + (size_t)t * 1024 + c, y); float s = 0.f;
#pragma unroll
        for (int i = 0; i < 16; ++i) s += y[i];
        const float mean = quad_sum(s) * (1.0f / 64.0f); float qq = 0.f;
#pragma unroll
        for (int i = 0; i < 16; ++i) { y[i] -= mean; qq += y[i] * y[i]; }
        const float rstd = rsqrtf(quad_sum(qq) * (1.0f / 64.0f) + 64e-5f);
        ld16f(gnw + c, tmp); ld16f(gnb + c, tb);
#pragma unroll
        for (int i = 0; i < 16; ++i) y[i] = y[i] * rstd * tmp[i] + tb[i];
        const float bon = BON[(size_t)t * 16 + h];
        {   const bf16_t* PA = (const bf16_t*)(P->ws + WS_PA); float vp[16], mv[16];
            ld16bf(PA + (size_t)t * A_COLS + 2048 + c, tmp); ld16f(P->in[4] + 2048 + c, mv);
            if ((t & (SEQ - 1)) != 0) { ld16bf(PA + (size_t)(t - 1) * A_COLS + 2048 + c, vp);
#pragma unroll
                for (int i = 0; i < 16; ++i) tmp[i] += (vp[i] - tmp[i]) * mv[i]; }
            else {
#pragma unroll
                for (int i = 0; i < 16; ++i) tmp[i] -= tmp[i] * mv[i]; } }
        ld16bf(GT + (size_t)t * 1024 + c, tb);
#pragma unroll
        for (int i = 0; i < 16; ++i) o[i] = (y[i] + bon * tmp[i]) * tb[i];
        st16bf(YAB + (size_t)t * 2048 + c, o);
    }
}

__device__ __forceinline__ void phase_rmsnorm(const Frame& F, const float* X, const float* g, bf16_t* XN) {
    for (int m = F.gw; m < M_TOK; m += F.NGW) rms_row_to_bf16(X + (size_t)m * DM, g, XN + (size_t)m * DM, F.lane);
}

constexpr int TK_WAVE_BYTES = 17024;
__device__ __forceinline__ void peer_topk_unit(const Frame& F, CP P, int layer, int u) {
    const int wave = F.wave, lane = F.lane, lr = lane & 15, lg = lane >> 4;
    const int h = u & 7, tg = u >> 3;
    const bf16_t* KEYS = (const bf16_t*)(P->ws + WS_KEYS) + (size_t)((layer * 8 + h) * 2) * 16384;
    const bf16_t* QP = (const bf16_t*)(P->ws + WS_QP);
    int* EIDX = (int*)(P->ws + WS_EIDX); float* EGATE = (float*)(P->ws + WS_EGATE);
    LAS float* sc = (LAS float*)(F.lds + wave * TK_WAVE_BYTES);
    LAS float* rv = sc + 2176; LAS int* ri = (LAS int*)(rv + 1024); LAS float* fvs = rv + 2048; LAS int* cds = (LAS int*)(rv + 2064);
    const int t0 = tg * 256 + wave * 32;
#pragma unroll 1
    for (int p = 0; p < 2; ++p) {
        bf16x8 kb[8][4];
#pragma unroll
        for (int nt = 0; nt < 8; ++nt)
#pragma unroll
            for (int ks = 0; ks < 4; ++ks) kb[nt][ks] = *(const bf16x8*)(KEYS + (size_t)(p * 128 + 16 * nt + lr) * 128 + 32 * ks + 8 * lg);
#pragma unroll 1
        for (int bt = 0; bt < 2; ++bt) {
            bf16x8 qa[4];
#pragma unroll
            for (int ks = 0; ks < 4; ++ks) qa[ks] = *(const bf16x8*)(QP + (size_t)(t0 + 16 * bt + lr) * 2048 + h * 256 + p * 128 + 32 * ks + 8 * lg);
            f32x4 acc[8];
#pragma unroll
            for (int nt = 0; nt < 8; ++nt) { acc[nt] = (f32x4){0.f, 0.f, 0.f, 0.f};
#pragma unroll
                for (int ks = 0; ks < 4; ++ks) acc[nt] = __builtin_amdgcn_mfma_f32_16x16x32_bf16(qa[ks], kb[nt][ks], acc[nt], 0, 0, 0); }
#pragma unroll
            for (int nt = 0; nt < 8; ++nt)
#pragma unroll
                for (int r = 0; r < 4; ++r) sc[(4 * lg + r) * 132 + 16 * nt + lr] = acc[nt][r];
#pragma unroll 1
            for (int tk = 0; tk < 16; ++tk) {
                const float a0 = sc[tk * 132 + lane], a1 = sc[tk * 132 + 64 + lane]; const unsigned k0 = fkey(a0), k1 = fkey(a1); unsigned thr = 0u;
                for (int bit = 31; bit >= 0; --bit) { const unsigned cd = thr | (1u << bit);
                    const int cnt = __popcll(__ballot(k0 >= cd)) + __popcll(__ballot(k1 >= cd));
                    if (cnt >= 16) { thr = cd; if (cnt == 16) break; } }
                const unsigned long long b0 = __ballot(k0 >= thr), b1 = __ballot(k1 >= thr);
                const int s0 = __builtin_amdgcn_mbcnt_hi((unsigned)(b0 >> 32), __builtin_amdgcn_mbcnt_lo((unsigned)b0, 0u));
                const int s1 = __popcll(b0) + __builtin_amdgcn_mbcnt_hi((unsigned)(b1 >> 32), __builtin_amdgcn_mbcnt_lo((unsigned)b1, 0u));
                const int ro = (p * 32 + 16 * bt + tk) * 16;
                if (k0 >= thr && s0 < 16) { rv[ro + s0] = a0; ri[ro + s0] = lane; }
                if (k1 >= thr && s1 < 16) { rv[ro + s1] = a1; ri[ro + s1] = lane + 64; } }
        }
    }
#pragma unroll 1
    for (int tk = 0; tk < 32; ++tk) {
        const int t = t0 + tk; const LAS float* sv0 = rv + tk * 16; const LAS float* sv1 = rv + (32 + tk) * 16;
        float cand[4]; unsigned ck[4];
        {   const float s0 = sv0[lane >> 2]; const f32x4 s1 = *(const LAS f32x4*)(sv1 + (lane & 3) * 4);
            cand[0] = s0 + s1.x; cand[1] = s0 + s1.y; cand[2] = s0 + s1.z; cand[3] = s0 + s1.w;
#pragma unroll
            for (int m = 0; m < 4; ++m) ck[m] = fkey(cand[m]); }
        {   unsigned thr = 0u;
            for (int bit = 31; bit >= 0; --bit) { const unsigned cd = thr | (1u << bit);
                const int cnt = (__popcll(__ballot(ck[0] >= cd)) + __popcll(__ballot(ck[1] >= cd))) + (__popcll(__ballot(ck[2] >= cd)) + __popcll(__ballot(ck[3] >= cd)));
                if (cnt >= 16) { thr = cd; if (cnt == 16) break; } }
            int base = 0;
#pragma unroll
            for (int m = 0; m < 4; ++m) { const unsigned long long bm = __ballot(ck[m] >= thr);
                const int sl = base + __builtin_amdgcn_mbcnt_hi((unsigned)(bm >> 32), __builtin_amdgcn_mbcnt_lo((unsigned)bm, 0u));
                if (ck[m] >= thr && sl < 16) { fvs[sl] = cand[m]; cds[sl] = lane * 4 + m; }
                base += __popcll(bm); } }
        {   const float fv = (lane < 16) ? fvs[lane] : -3.0e38f; const int code = (lane < 16) ? cds[lane] : 0;
            const float mx = row16_max(fv); const float e = (lane < 16) ? __expf(fv - mx) : 0.f; const float sum = row16_sum(e);
            if (lane < 16) { const int e0 = ri[tk * 16 + (code >> 4)], e1 = ri[(32 + tk) * 16 + (code & 15)];
                EIDX[((size_t)t * 8 + h) * 16 + lane] = e0 * 128 + e1; EGATE[((size_t)t * 8 + h) * 16 + lane] = e / sum; } }
    }
}

__device__ __forceinline__ float wave_sum_u(float x) {
    x = row16_sum(x); const int xi = __float_as_int(x);
    return (__int_as_float(__builtin_amdgcn_readlane(xi, 0)) + __int_as_float(__builtin_amdgcn_readlane(xi, 16))) + (__int_as_float(__builtin_amdgcn_readlane(xi, 32)) + __int_as_float(__builtin_amdgcn_readlane(xi, 48)));
}
template <int FMT> struct RowQ { u32x4 a; u32x2 b; };
template <int FMT> __device__ __forceinline__ constexpr int rowq_elem(int j) { return (FMT == 6 && FP6_INTERLEAVED) ? ((j & 1) ? 16 + (j >> 1) : (j >> 1)) : j; }
template <int FMT> __device__ __forceinline__ void rowq_load(RowQ<FMT>& q, const unsigned char* tab, int eid, int lane) {
    if (FMT == 6) { const unsigned char* row = tab + (size_t)eid * 1536; q.a = *(const u32x4*)(row + 16 * lane); q.b = *(const u32x2*)(row + 1024 + 8 * lane); }
    else { q.a = *(const u32x4*)(tab + (size_t)eid * 1024 + 16 * lane); }
}
template <int FMT> __device__ __forceinline__ void rowq_deq(const RowQ<FMT>& q, f32x2 (&o)[16]) {
    if (FMT == 6) { const u32x6 s = (u32x6){q.a[0], q.a[1], q.a[2], q.a[3], q.b[0], q.b[1]}; const f32x32 r = __builtin_amdgcn_cvt_scalef32_pk32_f32_fp6(s, 1.0f);
#pragma unroll
        for (int k = 0; k < 16; ++k) o[k] = (f32x2){r[2 * k], r[2 * k + 1]}; }
    else {
#pragma unroll
        for (int d = 0; d < 4; ++d) { o[4 * d] = __builtin_amdgcn_cvt_scalef32_pk_f32_fp4(q.a[d], 1.0f, 0); o[4 * d + 1] = __builtin_amdgcn_cvt_scalef32_pk_f32_fp4(q.a[d], 1.0f, 1);
            o[4 * d + 2] = __builtin_amdgcn_cvt_scalef32_pk_f32_fp4(q.a[d], 1.0f, 2); o[4 * d + 3] = __builtin_amdgcn_cvt_scalef32_pk_f32_fp4(q.a[d], 1.0f, 3); } }
}
template <int FMT, int DIAG = 0>
__device__ __forceinline__ void phase_experts(const Frame& F, CP P, int layer, const float* gnext, float* X) {
    const bf16_t* XN = (const bf16_t*)(P->ws + WS_XN); bf16_t* XNo = (bf16_t*)(P->ws + WS_XN);
    const unsigned char* UT = P->ws + WS_UT + (size_t)layer * 32 * MiB; const unsigned char* VT = P->ws + WS_VT + (size_t)layer * 32 * MiB;
    const float* SCU = (const float*)(P->ws + WS_SCALE) + layer * 16384; const float* SCV = SCU + 32768;
    const int* EIDX = (const int*)(P->ws + WS_EIDX); const float* EGATE = (const float*)(P->ws + WS_EGATE);
    const int lane = F.lane;
    for (int t = F.gw; t < M_TOK; t += F.NGW) {
        f32x2 hx[16];
        {   float hn[32];
#pragma unroll
            for (int j = 0; j < 8; ++j) { const u32x2 w = *(const u32x2*)(XN + (size_t)t * DM + 256 * j + 4 * lane); hn[4 * j] = bf_lo(w.x); hn[4 * j + 1] = bf_hi(w.x); hn[4 * j + 2] = bf_lo(w.y); hn[4 * j + 3] = bf_hi(w.y); }
#pragma unroll
            for (int k = 0; k < 16; ++k) hx[k] = (f32x2){hn[rowq_elem<FMT>(2 * k)], hn[rowq_elem<FMT>(2 * k + 1)]}; }
        int i0 = EIDX[(size_t)t * 128 + lane], i1 = EIDX[(size_t)t * 128 + 64 + lane]; if (DIAG == 2) { i0 &= 255; i1 &= 255; }
        const float g0 = EGATE[(size_t)t * 128 + lane], g1 = EGATE[(size_t)t * 128 + 64 + lane];
        float a0 = 0.f, a1 = 0.f;
        const float sc0 = SCU[i0], sc1 = SCU[i1];
#pragma unroll
        for (int half = 0; half < 2; ++half) {
            const int iv = half ? i1 : i0;
            for (int e8 = 0; e8 < 64; e8 += 8) {
                RowQ<FMT> ld[8];
#pragma unroll
                for (int x = 0; x < 8; ++x) { const int eid = __builtin_amdgcn_readlane(iv, e8 + x); rowq_load<FMT>(ld[x], UT, eid, lane); }
                float pv = 0.f;
#pragma unroll
                for (int x = 0; x < 8; ++x) { f32x2 r[16]; rowq_deq<FMT>(ld[x], r); f32x2 s2 = r[0] * hx[0];
#pragma unroll
                    for (int k = 1; k < 16; ++k) s2 = r[k] * hx[k] + s2;
                    const float r16 = row16_sum(s2.x + s2.y); pv = ((lane & 15) == ((e8 + x) & 15)) ? r16 : pv; }
                pv += __shfl_xor(pv, 16); pv += __shfl_xor(pv, 32);
                const float act = gelu1(pv * (half ? sc1 : sc0)) * (half ? g1 : g0);
                if (lane >= e8 && lane < e8 + 8) { if (half) a1 = act; else a0 = act; }
            }
        }
        f32x2 out2[16];
#pragma unroll
        for (int k = 0; k < 16; ++k) out2[k] = (f32x2){0.f, 0.f};
#pragma unroll
        for (int half = 0; half < 2; ++half) {
            const int iv = half ? i1 : i0; const float av = half ? a1 * SCV[i1] : a0 * SCV[i0];
            for (int e8 = 0; e8 < 64; e8 += 8) {
                RowQ<FMT> ld[8]; float ac[8];
#pragma unroll
                for (int x = 0; x < 8; ++x) { const int eid = __builtin_amdgcn_readlane(iv, e8 + x); rowq_load<FMT>(ld[x], VT, eid, lane);
                    ac[x] = __int_as_float(__builtin_amdgcn_readlane(__float_as_int(av), e8 + x)); }
#pragma unroll
                for (int x = 0; x < 8; ++x) { f32x2 r[16]; rowq_deq<FMT>(ld[x], r); const f32x2 a2 = (f32x2){ac[x], ac[x]};
#pragma unroll
                    for (int k = 0; k < 16; ++k) out2[k] = a2 * r[k] + out2[k]; }
            }
        }
        float out[32];
#pragma unroll
        for (int k = 0; k < 16; ++k) { out[rowq_elem<FMT>(2 * k)] = out2[k].x; out[rowq_elem<FMT>(2 * k + 1)] = out2[k].y; }
        float* xr = X + (size_t)t * DM + 4 * lane; float ss = 0.f;
#pragma unroll
        for (int k = 0; k < 8; ++k) { f32x4 a = *(const f32x4*)(xr + 256 * k);
            a.x += out[4 * k + 0]; a.y += out[4 * k + 1]; a.z += out[4 * k + 2]; a.w += out[4 * k + 3];
            *(f32x4*)(xr + 256 * k) = a;
            out[4 * k + 0] = a.x; out[4 * k + 1] = a.y; out[4 * k + 2] = a.z; out[4 * k + 3] = a.w;
            ss += (a.x * a.x + a.y * a.y) + (a.z * a.z + a.w * a.w); }
        if (gnext) { const float rstd = rsqrtf(wave_sum(ss) * (1.0f / DM) + 1e-6f);
#pragma unroll
            for (int k = 0; k < 8; ++k) { const f32x4 g4 = *(const f32x4*)(gnext + 256 * k + 4 * lane);
                *(u32x2*)(XNo + (size_t)t * DM + 256 * k + 4 * lane) = (u32x2){pkbf(out[4 * k] * rstd * g4.x, out[4 * k + 1] * rstd * g4.y), pkbf(out[4 * k + 2] * rstd * g4.z, out[4 * k + 3] * rstd * g4.w)}; } }
    }
}

__device__ __forceinline__ void phase_qknorm(const Frame& F, CP P) {
    bf16_t* QKV = (bf16_t*)(P->ws + WS_QKV); const f32x2* rope = (const f32x2*)(P->ws + WS_ROPE);
    const float* qn = P->in[21]; const float* kn = P->in[22]; const int lane = F.lane, d0 = 8 * (lane & 7), sub = lane & 7;
    for (int t = F.gw; t < M_TOK; t += F.NGW) {
        const int pos = t & (SEQ - 1);
#pragma unroll
        for (int j = 0; j < 8; ++j) {
            bf16_t* p = QKV + (size_t)t * C_COLS + 512 * j + 8 * lane; float v[8]; unpack8(*(const u32x4*)p, v);
            float ss = 0.f;
#pragma unroll
            for (int i = 0; i < 8; ++i) ss += v[i] * v[i];
            ss = oct_sum(ss); const float rstd = rsqrtf(ss * (1.0f / 64.0f) + 1e-6f);
            const float* wn = (j < 4) ? qn : kn; const f32x4 w0 = *(const f32x4*)(wn + d0), w1 = *(const f32x4*)(wn + d0 + 4);
            const float ww[8] = {w0.x, w0.y, w0.z, w0.w, w1.x, w1.y, w1.z, w1.w};
#pragma unroll
            for (int i = 0; i < 8; ++i) v[i] = v[i] * rstd * ww[i];
            float o[8];
#pragma unroll
            for (int i = 0; i < 8; ++i) { const float pr = dpp_mov<0xB1>(v[i]); const f32x2 cs = rope[pos * 8 + i];
                const float rot = (sub == 0) ? (v[i] * cs.x - pr * cs.y) : (v[i] * cs.x + pr * cs.y);
                o[i] = (sub < 2) ? rot : v[i]; }
            if (j < 4) {
#pragma unroll
                for (int i = 0; i < 8; ++i) o[i] *= QSCALE; }
            *(u32x4*)p = pack8(o);
        }
    }
}

constexpr int AT_KB = 9216, AT_BUF = 38912;
__device__ __forceinline__ float max3f(float a, float b, float c) { return __builtin_fmaxf(__builtin_fmaxf(a, b), c); }
template <int VAR>
__device__ __forceinline__ void attn_tile(LAS unsigned char* buf, int kv0, int q0w, int map, int lane, int q31, int hh, int qpos, bool first, const bf16x8 (&qf)[4],
                                          f32x16 (&O)[4], f32x16& negm, float& mref, float& lsum, LAS float* wsc) {
    LAS unsigned char* Kb = buf + map * AT_KB;
    f32x16 p0 = negm, p1 = negm;
#pragma unroll
    for (int ks = 0; ks < 4; ++ks) {
        const bf16x8 a0 = *(LAS bf16x8*)(Kb + q31 * 144 + ks * 32 + hh * 16);
        const bf16x8 a1 = *(LAS bf16x8*)(Kb + (32 + q31) * 144 + ks * 32 + hh * 16);
        if (VAR != 3) { p0 = __builtin_amdgcn_mfma_f32_32x32x16_bf16(a0, qf[ks], p0, 0, 0, 0);
        p1 = __builtin_amdgcn_mfma_f32_32x32x16_bf16(a1, qf[ks], p1, 0, 0, 0); } else { p0[ks] += __builtin_bit_cast(float, (int)a0[0]) ; p1[ks] += __builtin_bit_cast(float, (int)a1[1]); }
    }
    if (kv0 + 63 > q0w) {
#pragma unroll
        for (int r = 0; r < 16; ++r) { const int kv = kv0 + crow(r, hh); if (kv > qpos) p0[r] = -1.0e30f; if (kv + 32 > qpos) p1[r] = -1.0e30f; } }
    if (VAR != 2) {
    float ma = max3f(p0[0], p0[1], p1[0]), mb = max3f(p0[2], p0[3], p1[1]); ma = max3f(ma, p1[2], p1[3]);
#pragma unroll
    for (int r = 4; r < 16; r += 4) { ma = max3f(ma, p0[r], p0[r + 1]); mb = max3f(mb, p0[r + 2], p0[r + 3]); ma = max3f(ma, p1[r], p1[r + 1]); mb = max3f(mb, p1[r + 2], p1[r + 3]); }
    float mx = __builtin_fmaxf(ma, mb);
    {   const auto rr = __builtin_amdgcn_permlane32_swap(__float_as_uint(mx), __float_as_uint(mx), false, false); mx = __builtin_fmaxf(__uint_as_float(rr[0]), __uint_as_float(rr[1])); }
    if (first || __any(mx > 0.f)) {
        const float dl = first ? mx : __builtin_fmaxf(mx, 0.f); mref += dl;
#pragma unroll
        for (int r = 0; r < 16; ++r) { p0[r] -= dl; p1[r] -= dl; negm[r] = -mref; }
        if (first) lsum = 0.f;
        else { const float alpha = __builtin_amdgcn_exp2f(-dl); lsum *= alpha;
            if (hh == 0) wsc[q31] = alpha;
#pragma unroll
            for (int g = 0; g < 4; ++g) { const f32x4 al = *(LAS f32x4*)(wsc + 8 * g + 4 * hh);
#pragma unroll
                for (int d = 0; d < 4; ++d) { O[d][4 * g + 0] *= al.x; O[d][4 * g + 1] *= al.y; O[d][4 * g + 2] *= al.z; O[d][4 * g + 3] *= al.w; } } }
    }
    float ps0 = 0.f, ps1 = 0.f;
#pragma unroll
    for (int r = 0; r < 16; ++r) { p0[r] = __builtin_amdgcn_exp2f(p0[r]); p1[r] = __builtin_amdgcn_exp2f(p1[r]); ps0 += p0[r]; ps1 += p1[r]; }
    lsum += ps0 + ps1;
    }
    bf16x8 pa[4];
#pragma unroll
    for (int s = 0; s < 2; ++s) {
        u32x4 w0, w1;
        w0.x = pkbf(p0[8 * s + 0], p0[8 * s + 1]); w0.y = pkbf(p0[8 * s + 2], p0[8 * s + 3]); w0.z = pkbf(p0[8 * s + 4], p0[8 * s + 5]); w0.w = pkbf(p0[8 * s + 6], p0[8 * s + 7]);
        w1.x = pkbf(p1[8 * s + 0], p1[8 * s + 1]); w1.y = pkbf(p1[8 * s + 2], p1[8 * s + 3]); w1.z = pkbf(p1[8 * s + 4], p1[8 * s + 5]); w1.w = pkbf(p1[8 * s + 6], p1[8 * s + 7]);
        pa[s] = __builtin_bit_cast(bf16x8, w0); pa[2 + s] = __builtin_bit_cast(bf16x8, w1); }
    LAS unsigned char* Vb = buf + 2 * AT_KB + (4 * hh + ((lane >> 2) & 3)) * 320 + (16 * ((lane >> 4) & 1) + 4 * (lane & 3)) * 2;
#pragma unroll
    for (int kst = 0; kst < 4; ++kst)
#pragma unroll
        for (int d = 0; d < 4; ++d) {
            if (VAR == 1) { O[d][kst] += __builtin_bit_cast(float, (int)pa[kst][d]); continue; }
            const s16x4 lo = vtr(Vb + (16 * kst) * 320 + d * 64), hi = vtr(Vb + (16 * kst + 8) * 320 + d * 64);
            const bf16x8 vf = (bf16x8){lo[0], lo[1], lo[2], lo[3], hi[0], hi[1], hi[2], hi[3]};
            O[d] = __builtin_amdgcn_mfma_f32_32x32x16_bf16(pa[kst], vf, O[d], 0, 0, 0);
        }
}
template <int VAR = 0>
__device__ __forceinline__ void attn_unit(const Frame& F, CP P, int bh, int qb, float lam) {
    const int tid = F.tid, wave = F.wave, lane = F.lane, map = wave >> 2, wq = wave & 3, q31 = lane & 31, hh = lane >> 5;
    const int b = bh >> 4, h = bh & 15, q0 = qb * 128;
    const bf16_t* QKV = (const bf16_t*)(P->ws + WS_QKV) + (size_t)b * SEQ * C_COLS; bf16_t* OB = (bf16_t*)(P->ws + (VAR ? WS_PA : WS_OB));
    const float* subln = P->in[27];
    LAS unsigned char* lds = F.lds; LAS float* wsc = (LAS float*)(lds + 2 * AT_BUF) + wave * 32;
    bf16x8 qf[4];
    {   const bf16_t* qp = QKV + (size_t)(q0 + 32 * wq + q31) * C_COLS + h * 128 + map * 64 + 8 * hh;
#pragma unroll
        for (int ks = 0; ks < 4; ++ks) qf[ks] = *(const bf16x8*)(qp + 16 * ks); }
    const int NT = 2 * qb + 2;
    const int krow = tid >> 3, kc8 = tid & 7;
    const unsigned koff = (unsigned)((krow * C_COLS + 2048 + h * 128 + kc8 * 8) * 2), voff = (unsigned)(((tid >> 4) * C_COLS + 4096 + h * 128 + (tid & 15) * 8) * 2);
    const unsigned char* qkvb = (const unsigned char*)QKV;
    const int kdst = krow * 144 + kc8 * 16, vdst = 2 * AT_KB + (tid >> 4) * 320 + (tid & 15) * 16;
    u32x4 pfA[4], pfB[4];
#define AT_LOAD(pf, tt) do { const unsigned char* tb = qkvb + (size_t)(tt) * (64 * C_COLS * 2); pf[0] = *(const u32x4*)(tb + koff); pf[1] = *(const u32x4*)(tb + koff + 128); \
        pf[2] = *(const u32x4*)(tb + voff); pf[3] = *(const u32x4*)(tb + voff + 32 * C_COLS * 2); } while (0)
#define AT_STORE(pf, bufp) do { *(LAS u32x4*)((bufp) + kdst) = pf[0]; *(LAS u32x4*)((bufp) + AT_KB + kdst) = pf[1]; *(LAS u32x4*)((bufp) + vdst) = pf[2]; *(LAS u32x4*)((bufp) + vdst + 32 * 320) = pf[3]; } while (0)
    AT_LOAD(pfA, 0); AT_LOAD(pfB, 1); AT_STORE(pfA, lds); __syncthreads();
    asm volatile("" :: "v"(qf[0]), "v"(qf[1]), "v"(qf[2]), "v"(qf[3]));
    f32x16 O[4];
#pragma unroll
    for (int d = 0; d < 4; ++d)
#pragma unroll
        for (int r = 0; r < 16; ++r) O[d][r] = 0.f;
    float mrow = 0.f, lsum = 0.f; f32x16 negm;
#pragma unroll
    for (int r = 0; r < 16; ++r) negm[r] = 0.f;
    const int qpos = q0 + 32 * wq + q31, q0w = q0 + 32 * wq;
    for (int tt = 0; tt < NT; tt += 2) {
        if (VAR != 4 && tt + 2 < NT) AT_LOAD(pfA, tt + 2);
        if (tt * 64 <= q0w + 31) attn_tile<VAR>(lds, tt * 64, q0w, map, lane, q31, hh, qpos, tt == 0, qf, O, negm, mrow, lsum, wsc);
        if (VAR != 4) AT_STORE(pfB, lds + AT_BUF);
        __syncthreads();
        if (VAR != 4 && tt + 3 < NT) AT_LOAD(pfB, tt + 3);
        if ((tt + 1) * 64 <= q0w + 31) attn_tile<VAR>(lds + AT_BUF, (tt + 1) * 64, q0w, map, lane, q31, hh, qpos, false, qf, O, negm, mrow, lsum, wsc);
        if (VAR != 4 && tt + 2 < NT) AT_STORE(pfA, lds);
        __syncthreads();
    }
#undef AT_LOAD
#undef AT_STORE
    {   const float lt = lsum + __shfl_xor(lsum, 32); if (hh == 0) wsc[q31] = 1.0f / lt;
#pragma unroll
        for (int g = 0; g < 4; ++g) { const f32x4 al = *(LAS f32x4*)(wsc + 8 * g + 4 * hh);
#pragma unroll
            for (int d = 0; d < 4; ++d) { O[d][4 * g + 0] *= al.x; O[d][4 * g + 1] *= al.y; O[d][4 * g + 2] *= al.z; O[d][4 * g + 3] *= al.w; } } }
    LAS float* xch = (LAS float*)lds;
    if (map == 1) {
#pragma unroll
        for (int d = 0; d < 4; ++d)
#pragma unroll
            for (int r = 0; r < 16; ++r) xch[(wq * 64 + d * 16 + r) * 64 + lane] = O[d][r]; }
    __syncthreads();
    if (map == 0) {
        float ss[16];
#pragma unroll
        for (int r = 0; r < 16; ++r) ss[r] = 0.f;
#pragma unroll
        for (int d = 0; d < 4; ++d)
#pragma unroll
            for (int r = 0; r < 16; ++r) { const float o = O[d][r] - lam * xch[(wq * 64 + d * 16 + r) * 64 + lane]; O[d][r] = o; ss[r] += o * o; }
        float sl[4];
#pragma unroll
        for (int d = 0; d < 4; ++d) sl[d] = subln[d * 32 + q31];
#pragma unroll
        for (int r = 0; r < 16; ++r) { float s = row16_sum(ss[r]); s += __shfl_xor(s, 16); const float rs = rsqrtf(s * (1.0f / 128.0f) + 1e-5f) * (1.0f - LAMBDA_INIT);
            const size_t tok = (size_t)b * SEQ + q0 + 32 * wq + crow(r, hh);
#pragma unroll
            for (int d = 0; d < 4; ++d) OB[tok * DM + h * 128 + d * 32 + q31] = (bf16_t)(pkbf(O[d][r] * rs * sl[d], 0.f) & 0xffffu); }
    }
    __syncthreads();
}

constexpr int CK_C = 32;
constexpr size_t WS_PHI = 132 * MiB  , WS_RP = 260 * MiB  , WS_Y0T = 292 * MiB  , WS_PSI = 676 * MiB  ;
constexpr int CP_SZ = 67584;
constexpr int CP_RT = 0, CP_AT = 4608, CP_BT = 9216, CP_KT = 13824, CP_WTT = 4608  , CP_U0T = 9728  ;
constexpr int CP_ATT = 18432, CP_BHT = 23552, CP_KHT = 28672, CP_VT = 33792, CP_AKVT = 38912;
constexpr int CP_PW = 44032  , CP_X = 54272  , CP_AAK = 59392, CP_ARB = 61952, CP_ARK = 64512, CP_D = 44032  , CP_GC = 67072  ;
__device__ __forceinline__ int ck_pos(int j) { return (j >> 5) * 32 + ((j >> 2) & 3) * 8 + ((j >> 4) & 1) * 4 + (j & 3); }
__device__ __forceinline__ f32x16 ck_mm(f32x16 acc, const LAS unsigned char* A, int pa, const LAS unsigned char* Bt, int pb, int nks, int lane) {
    const LAS unsigned char* ap = A + (lane & 31) * pa + (lane >> 5) * 16; const LAS unsigned char* bp = Bt + (lane & 31) * pb + (lane >> 5) * 16;
    for (int ks = 0; ks < nks; ++ks) acc = __builtin_amdgcn_mfma_f32_32x32x16_bf16(*(const LAS bf16x8*)(ap + ks * 32), *(const LAS bf16x8*)(bp + ks * 32), acc, 0, 0, 0);
    return acc;
}
__device__ __forceinline__ f32x16 ck_zero() { f32x16 z; for (int r = 0; r < 16; ++r) z[r] = 0.f; return z; }
__device__ __forceinline__ void ck_st(LAS unsigned char* dst, int pitch, const f32x16& a, int lane) {
    const int col = lane & 31, hh = lane >> 5;
#pragma unroll
    for (int r = 0; r < 16; ++r) *(LAS bf16_t*)(dst + crow(r, hh) * pitch + col * 2) = (bf16_t)(pkbf_c(a[r], 0.f) & 0xffffu);
}
__device__ __forceinline__ void ck_stT(LAS unsigned char* dst, int pitch, const f32x16& a, int lane) {
    const int col = lane & 31, hh = lane >> 5;
#pragma unroll
    for (int g = 0; g < 4; ++g) *(LAS u32x2*)(dst + col * pitch + (8 * g + 4 * hh) * 2) = (u32x2){pkbf_c(a[4 * g], a[4 * g + 1]), pkbf_c(a[4 * g + 2], a[4 * g + 3])};
}
__device__ __forceinline__ void ck_bar() { asm volatile("s_waitcnt lgkmcnt(0)" ::: "memory"); __syncthreads(); }

__device__ __forceinline__ void chunk_prep_fetch(CP P, int pair, int wave, int tid, u32x4 (&raw)[8]) {
    const int hf = wave >> 2, htid = tid & 255, item = 2 * pair + hf, bh = item >> 7, cc = item & 127, t = htid >> 3, j8 = (htid & 7) * 8, tt = cc * 32 + t, hc = (bh & 15) * 64 + j8;
    const size_t tg = (size_t)(bh >> 4) * SEQ + tt; const bf16_t* row = (const bf16_t*)(P->ws + WS_PA) + tg * A_COLS + hc; const u32x4 z4 = (u32x4){0u, 0u, 0u, 0u};
    raw[0] = *(const u32x4*)row; raw[1] = *(const u32x4*)(row + 1024); raw[2] = *(const u32x4*)(row + 2048);
    raw[3] = tt ? *(const u32x4*)(row - A_COLS) : z4; raw[4] = tt ? *(const u32x4*)(row - A_COLS + 1024) : z4; raw[5] = tt ? *(const u32x4*)(row - A_COLS + 2048) : z4;
    raw[6] = *(const u32x4*)((const bf16_t*)(P->ws + WS_ICLR) + tg * 1024 + hc); raw[7] = *(const u32x4*)((const bf16_t*)(P->ws + WS_DLOG) + tg * 1024 + hc);
}
constexpr int CP_PAR = 2 * CP_SZ;
template <int ABL = 0>
__device__ __forceinline__ void chunk_prep_pair(const Frame& F, CP P, int pair, int next_pair, u32x4 (&raw)[8]) {
    const int hf = F.wave >> 2, hw = F.wave & 3, htid = F.tid & 255, lane = F.lane; const int item = 2 * pair + hf;
    f32x4 qrow[8]; const int qr0 = (pair * 8 + F.wave) * 2; quant_load(P, qr0, lane, qrow);
    LAS unsigned char* L = F.lds + hf * CP_SZ;
    const int bh = item >> 7, cc = item & 127, bb_ = bh >> 4, hd = bh & 15;
    bf16_t* PHI = (bf16_t*)(P->ws + WS_PHI) + (size_t)item * 4096; bf16_t* RPo = (bf16_t*)(P->ws + WS_RP) + (size_t)item * 2048;
    bf16_t* Y0T = (bf16_t*)(P->ws + WS_Y0T) + (size_t)item * 2048; bf16_t* PSI = (bf16_t*)(P->ws + WS_PSI) + (size_t)item * 4096;
    {   const int t = htid >> 3, j8 = (htid & 7) * 8, tt = cc * 32 + t; const size_t tg = (size_t)bb_ * SEQ + tt;
        float rr[8], dd[8], kf[8], vv[8], kq[8], bb[8], tp[8];
        const LAS float* par = (const LAS float*)(F.lds + CP_PAR) + j8; float pp[8];
#define CK_PAR(a_) do { const f32x4 x_ = *(const LAS f32x4*)(par + (a_) * 64), y_ = *(const LAS f32x4*)(par + (a_) * 64 + 4); pp[0] = x_.x; pp[1] = x_.y; pp[2] = x_.z; pp[3] = x_.w; pp[4] = y_.x; pp[5] = y_.y; pp[6] = y_.z; pp[7] = y_.w; } while (0)
#define CK_SHIFT(x, ri) do { unpack8(raw[ri], x); unpack8(raw[(ri) + 3], tp); CK_PAR(ri); _Pragma("unroll") for (int i = 0; i < 8; ++i) x[i] += (tp[i] - x[i]) * pp[i]; } while (0)
        CK_SHIFT(rr, 0); CK_SHIFT(kf, 1); CK_SHIFT(vv, 2);
        float ic[8]; unpack8(raw[6], ic); unpack8(raw[7], dd);
        if (next_pair >= 0) chunk_prep_fetch(P, next_pair, F.wave, F.tid, raw);
        float ss_ = 0.f;
        CK_PAR(3);
#pragma unroll
        for (int i = 0; i < 8; ++i) { kq[i] = kf[i] * pp[i]; ss_ += kq[i] * kq[i]; }
        ss_ = oct_sum(ss_); const float rn_ = rsqrtf(fmaxf(ss_, 1e-12f));
        CK_PAR(4);
#pragma unroll
        for (int i = 0; i < 8; ++i) { kq[i] *= rn_; kf[i] = kf[i] * (1.0f + (ic[i] - 1.0f) * pp[i]); bb[i] = kq[i] * ic[i]; }
        float bs_ = 0.f;
        CK_PAR(5);
#pragma unroll
        for (int i = 0; i < 8; ++i) bs_ += rr[i] * kf[i] * pp[i];
        bs_ = oct_sum(bs_);
        if ((htid & 7) == 0) ((float*)(P->ws + WS_BONUS))[tg * 16 + hd] = bs_;
#undef CK_SHIFT
#undef CK_PAR
        *(LAS f32x4*)(L + CP_D + (t * 64 + j8) * 4) = (f32x4){dd[0], dd[1], dd[2], dd[3]}; *(LAS f32x4*)(L + CP_D + (t * 64 + j8 + 4) * 4) = (f32x4){dd[4], dd[5], dd[6], dd[7]};
        ck_bar();
        f32x4 a0 = (f32x4){0.f, 0.f, 0.f, 0.f}, a1 = a0, m0 = a0, m1 = a0, t0 = a0, t1 = a0;
        for (int s = 0; s < CK_C; ++s) { if (s == t) { m0 = a0; m1 = a1; } a0 += *(const LAS f32x4*)(L + CP_D + (s * 64 + j8) * 4); a1 += *(const LAS f32x4*)(L + CP_D + (s * 64 + j8 + 4) * 4); if (s == t) { t0 = a0; t1 = a1; } }
        const float Dm1[8] = {m0[0], m0[1], m0[2], m0[3], m1[0], m1[1], m1[2], m1[3]}, Dt[8] = {t0[0], t0[1], t0[2], t0[3], t1[0], t1[1], t1[2], t1[3]}, DC[8] = {a0[0], a0[1], a0[2], a0[3], a1[0], a1[1], a1[2], a1[3]};
        ck_bar();
        float at[8], rt[8], bt[8], kt[8], bh[8], kh[8];
#pragma unroll
        for (int q = 0; q < 8; ++q) { const float em1 = __expf(-Dm1[q]), e0 = __expf(-Dt[q]), ep = __expf(Dt[q]), ec = __expf(Dt[q] - DC[q]);
            at[q] = -kq[q] * em1; rt[q] = rr[q] * e0; bt[q] = bb[q] * ep; kt[q] = kf[q] * ep; bh[q] = bb[q] * ec; kh[q] = kf[q] * ec; }
        *(LAS u32x4*)(L + CP_AT + t * 144 + j8 * 2) = (u32x4){pkbf(at[0], at[1]), pkbf(at[2], at[3]), pkbf(at[4], at[5]), pkbf(at[6], at[7])};
        *(LAS u32x4*)(L + CP_RT + t * 144 + j8 * 2) = (u32x4){pkbf(rt[0], rt[1]), pkbf(rt[2], rt[3]), pkbf(rt[4], rt[5]), pkbf(rt[6], rt[7])};
        *(LAS u32x4*)(L + CP_BT + t * 144 + j8 * 2) = (u32x4){pkbf(bt[0], bt[1]), pkbf(bt[2], bt[3]), pkbf(bt[4], bt[5]), pkbf(bt[6], bt[7])};
        *(LAS u32x4*)(L + CP_KT + t * 144 + j8 * 2) = (u32x4){pkbf(kt[0], kt[1]), pkbf(kt[2], kt[3]), pkbf(kt[4], kt[5]), pkbf(kt[6], kt[7])};
#pragma unroll
        for (int q = 0; q < 8; ++q) { const int o = (j8 + q) * 80 + t * 2;
            *(LAS bf16_t*)(L + CP_ATT + o) = (bf16_t)(pkbf(at[q], 0.f) & 0xffffu); *(LAS bf16_t*)(L + CP_BHT + o) = (bf16_t)(pkbf(bh[q], 0.f) & 0xffffu);
            *(LAS bf16_t*)(L + CP_KHT + o) = (bf16_t)(pkbf(kh[q], 0.f) & 0xffffu); *(LAS bf16_t*)(L + CP_VT + o) = (bf16_t)(pkbf(vv[q], 0.f) & 0xffffu);
            if (t == CK_C - 1) *(LAS float*)(L + CP_GC + (j8 + q) * 4) = __expf(-DC[q]); }
    }
    ck_bar();
    if (ABL == 2) { quant_finish(P, qr0, lane, qrow); return; }
    const int col = lane & 31, hh = lane >> 5;
    {   const int pi = hw >> 1, qi = hw & 1;
        f32x16 a = ck_mm(ck_zero(), L + (pi ? CP_RT : CP_AT), 144, L + (qi ? CP_KT : CP_BT), 144, 4, lane);
#pragma unroll
        for (int r = 0; r < 16; ++r) { const int t = crow(r, hh); if (pi == 0 ? (col >= t) : (col > t)) a[r] = 0.f; }
        if (hw == 0) { ck_st(L + CP_PW, 80, a, lane); ck_stT(L + CP_PW + 2560, 80, a, lane);
#pragma unroll
            for (int r = 0; r < 16; ++r) if (crow(r, hh) == col) a[r] += 1.0f;
            ck_st(L + CP_X, 80, a, lane); }
        else ck_st(L + (hw == 1 ? CP_AAK : (hw == 2 ? CP_ARB : CP_ARK)), 80, a, lane);
    }
    quant_finish(P, qr0, lane, qrow); quant_load(P, qr0 + 1, lane, qrow);
    ck_bar();
    for (int r = 1; r <= (ABL == 1 ? 1 : 5); ++r) {
        const LAS unsigned char* pc = L + CP_PW + ((r - 1) & 1) * 5120; LAS unsigned char* pn = L + CP_PW + (r & 1) * 5120;
        if (hw == 0 && r <= 4) { const f32x16 a = ck_mm(ck_zero(), pc, 80, pc + 2560, 80, 2, lane); ck_st(pn, 80, a, lane); ck_stT(pn + 2560, 80, a, lane); }
        if (hw == 1 && r >= 2) {
            const LAS unsigned char* xc = L + CP_X + (r & 1) * 2560; LAS unsigned char* xn = L + CP_X + ((r + 1) & 1) * 2560;
            f32x16 a;
#pragma unroll
            for (int q = 0; q < 16; ++q) a[q] = bf_1(*(const LAS bf16_t*)(xc + crow(q, hh) * 80 + col * 2));
            a = ck_mm(a, xc, 80, pc + 2560, 80, 2, lane); ck_st(xn, 80, a, lane); }
        if (r == 1 && hw >= 2) { const int ih = hw - 2;
            const f32x16 a = ck_mm(ck_zero(), L + CP_AAK, 80, L + CP_VT + ih * 2560, 80, 2, lane); ck_stT(L + CP_AKVT + ih * 2560, 80, a, lane); }
        ck_bar();
    }
    const LAS unsigned char* Tn = L + CP_X;
    if (hw < 2) { const f32x16 a = ck_mm(ck_zero(), Tn, 80, L + CP_ATT + hw * 2560, 80, 2, lane); ck_stT(L + CP_WTT + hw * 2560, 80, a, lane); }
    else { const int ih = hw - 2; const f32x16 a = ck_mm(ck_zero(), Tn, 80, L + CP_AKVT + ih * 2560, 80, 2, lane); ck_stT(L + CP_U0T + ih * 2560, 80, a, lane); }
    ck_bar();
    {   const int jph = hw >> 1, jh = hw & 1;
        f32x16 a = ck_mm(ck_zero(), L + CP_BHT + jph * 2560, 80, L + CP_WTT + jh * 2560, 80, 2, lane);
        const int j = 32 * jh + col; const int pj = ck_pos(j);
#pragma unroll
        for (int r = 0; r < 16; ++r) { const int jp = 32 * jph + crow(r, hh); float x = a[r]; if (jp == j) x += *(const LAS float*)(L + CP_GC + j * 4);
            PHI[jp * 64 + pj] = (bf16_t)(pkbf_c(x, 0.f) & 0xffffu); } }
    {   const int jph = hw >> 1, ih = hw & 1;
        f32x16 a = ck_mm(ck_zero(), L + CP_BHT + jph * 2560, 80, L + CP_U0T + ih * 2560, 80, 2, lane);
        a = ck_mm(a, L + CP_KHT + jph * 2560, 80, L + CP_VT + ih * 2560, 80, 2, lane);
        const int i = 32 * ih + col;
#pragma unroll
        for (int g = 0; g < 4; ++g) *(u32x2*)(PSI + i * 64 + 32 * jph + 8 * g + 4 * hh) = (u32x2){pkbf_c(a[4 * g], a[4 * g + 1]), pkbf_c(a[4 * g + 2], a[4 * g + 3])}; }
    if (hw < 2) { const int jh = hw;
        f32x16 a;
        const int j = 32 * jh + col; const int pj = ck_pos(j);
#pragma unroll
        for (int r = 0; r < 16; ++r) a[r] = bf_1(*(const LAS bf16_t*)(L + CP_RT + crow(r, hh) * 144 + j * 2));
        a = ck_mm(a, L + CP_ARB, 80, L + CP_WTT + jh * 2560, 80, 2, lane);
#pragma unroll
        for (int r = 0; r < 16; ++r) RPo[crow(r, hh) * 64 + pj] = (bf16_t)(pkbf_c(a[r], 0.f) & 0xffffu);
    } else { const int ih = hw - 2;
        f32x16 a = ck_mm(ck_zero(), L + CP_ARB, 80, L + CP_U0T + ih * 2560, 80, 2, lane);
        a = ck_mm(a, L + CP_ARK, 80, L + CP_VT + ih * 2560, 80, 2, lane);
        const int i = 32 * ih + col;
#pragma unroll
        for (int g = 0; g < 4; ++g) *(u32x2*)(Y0T + i * 32 + 8 * g + 4 * hh) = (u32x2){pkbf_c(a[4 * g], a[4 * g + 1]), pkbf_c(a[4 * g + 2], a[4 * g + 3])};
    }
    quant_finish(P, qr0 + 1, lane, qrow);
    ck_bar();
}

typedef float f32x4v __attribute__((ext_vector_type(4)));
__device__ __forceinline__ void chunk_scan_unit4(const Frame& F, CP P, int u, LAS unsigned char* lsf, volatile LAS unsigned* cnt) {
    const int lane = F.lane, T = F.wave, bh = u >> 2, sl = u & 3, b = bh >> 4, h = bh & 15, li = lane & 15, g = lane >> 4;
    const bf16_t* PHI = (const bf16_t*)(P->ws + WS_PHI) + (size_t)bh * 128 * 4096 + (16 * T + li) * 64 + g * 8;
    const bf16_t* PSI = (const bf16_t*)(P->ws + WS_PSI) + (size_t)bh * 128 * 4096 + (16 * sl + li) * 64 + 16 * T + 4 * g;
    const bf16_t* RPi = (const bf16_t*)(P->ws + WS_RP) + (size_t)bh * 128 * 2048 + (16 * (T & 1) + li) * 64 + g * 8;
    const bf16_t* Y0T = (const bf16_t*)(P->ws + WS_Y0T) + (size_t)bh * 128 * 2048 + (16 * sl + li) * 32 + 16 * (T & 1) + 4 * g;
    float* Y = (float*)(P->ws + WS_Y) + (size_t)b * SEQ * 1024 + h * 64 + 16 * sl + li;
    const bool yw = T < 2;
    f32x4v S = (f32x4v){0.f, 0.f, 0.f, 0.f};
    bf16x8 phi[8][2], rp[8][2]; u32x2 psi[8], y0[8];
#define CS_LOAD(k, c) do { phi[k][0] = *(const bf16x8*)(PHI + (size_t)(c) * 4096); phi[k][1] = *(const bf16x8*)(PHI + (size_t)(c) * 4096 + 32); psi[k] = *(const u32x2*)(PSI + (size_t)(c) * 4096); \
        if (yw) { rp[k][0] = *(const bf16x8*)(RPi + (size_t)(c) * 2048); rp[k][1] = *(const bf16x8*)(RPi + (size_t)(c) * 2048 + 32); y0[k] = *(const u32x2*)(Y0T + (size_t)(c) * 2048); } } while (0)
#pragma unroll
    for (int k = 0; k < 8; ++k) CS_LOAD(k, k);
    LAS unsigned char* mine = lsf + (T >> 1) * 1024 + lane * 16 + (T & 1) * 8;
    for (int c0 = 0; c0 < 128; c0 += 8) {
#pragma unroll
        for (int k = 0; k < 8; ++k) { const int c = c0 + k; LAS unsigned char* img = lsf + (c & 1) * 2048;
            *(LAS u32x2*)(mine + (c & 1) * 2048) = (u32x2){pkbf_c(S[0], S[1]), pkbf_c(S[2], S[3])};
            if (lane == 0) __hip_atomic_fetch_add((LAS unsigned*)cnt, 1u, __ATOMIC_RELAXED, __HIP_MEMORY_SCOPE_WORKGROUP);
            const unsigned want = 4u * (unsigned)(c + 1);
            while (*cnt < want) { }
            const bf16x8 sf0 = *(const LAS bf16x8*)(img + lane * 16), sf1 = *(const LAS bf16x8*)(img + 1024 + lane * 16);
            if (yw) { f32x4v a = (f32x4v){bf_lo(y0[k].x), bf_hi(y0[k].x), bf_lo(y0[k].y), bf_hi(y0[k].y)};
                a = __builtin_amdgcn_mfma_f32_16x16x32_bf16(rp[k][0], sf0, a, 0, 0, 0); a = __builtin_amdgcn_mfma_f32_16x16x32_bf16(rp[k][1], sf1, a, 0, 0, 0);
#pragma unroll
                for (int r = 0; r < 4; ++r) Y[(size_t)(c * 32 + 16 * T + 4 * g + r) * 1024] = a[r]; }
            {   f32x4v a = (f32x4v){bf_lo(psi[k].x), bf_hi(psi[k].x), bf_lo(psi[k].y), bf_hi(psi[k].y)};
                a = __builtin_amdgcn_mfma_f32_16x16x32_bf16(phi[k][0], sf0, a, 0, 0, 0); a = __builtin_amdgcn_mfma_f32_16x16x32_bf16(phi[k][1], sf1, a, 0, 0, 0); S = a; }
            if (c + 8 < 128) CS_LOAD(k, c + 8);
        }
    }
#undef CS_LOAD
}
#define XB_TMO      128
#define XB_XCNT(j)  (256  + 64 * (j))
#define XB_XSUB(j)  (1280 + 64 * (j))
#define XB_XGEN(j)  (2304 + 64 * (j))
#define XB_TOP      3328
#define XB_TOPGEN   3392
#define XCD_BAR_WORDS 3456
#define XB_SPIN_CAP (1u << 18)

__device__ __forceinline__ unsigned xb_ld(unsigned* p)              { return __hip_atomic_load(p, __ATOMIC_RELAXED, __HIP_MEMORY_SCOPE_AGENT); }
__device__ __forceinline__ unsigned xb_add(unsigned* p, unsigned v) { return __hip_atomic_fetch_add(p, v, __ATOMIC_RELAXED, __HIP_MEMORY_SCOPE_AGENT); }
__device__ __forceinline__ unsigned xb_xcc_id() { return (unsigned)__builtin_amdgcn_s_getreg((3 << 11) | 20) & 0xFu; }
#define XB_SPIN(cond, bar) do { unsigned _sp = 0; while (cond) { __builtin_amdgcn_s_sleep(1); \
    if ((++_sp & 255u) == 0u) { if (xb_ld(&(bar)[XB_TMO])) break; if (_sp > XB_SPIN_CAP) { atomicAdd(&(bar)[XB_TMO], 1u); break; } } } } while (0)

struct XcdBarrier {
    unsigned* bar; unsigned x;
    volatile LAS unsigned* st;
};

__device__ __forceinline__ XcdBarrier xcd_barrier_post(unsigned* bar, volatile LAS unsigned* st) {
    XcdBarrier b; b.bar = bar; b.x = xb_xcc_id(); b.st = st;
    if (threadIdx.x == 0) (void)xb_add(&bar[XB_XCNT(b.x)], 1u);
    return b;
}
__device__ __forceinline__ void xcd_barrier_complete(unsigned* bar, unsigned x, unsigned& nloc, unsigned& nx) {
    const unsigned G = gridDim.x * gridDim.y * gridDim.z;
    unsigned sum, cnt, mine, sp = 0u;
    for (;;) {
        sum = 0u; cnt = 0u; mine = 0u;
#pragma unroll
        for (unsigned j = 0; j < 16; ++j) { const unsigned c = xb_ld(&bar[XB_XCNT(j)]); sum += c; cnt += (c > 0u) ? 1u : 0u; mine = (j == x) ? c : mine; }
        if (sum == G) break;
        __builtin_amdgcn_s_sleep(1);
        if ((++sp & 255u) == 0u) { if (xb_ld(&bar[XB_TMO])) break; if (sp > XB_SPIN_CAP) { atomicAdd(&bar[XB_TMO], 1u); break; } }
    }
    nloc = mine > 0u ? mine : 1u; nx = cnt > 0u ? cnt : 1u;
}

__device__ __forceinline__ void xcd_barrier(const XcdBarrier& b) {
    asm volatile("s_waitcnt vmcnt(0)" ::: "memory");
    __syncthreads();
    if (threadIdx.x == 0) {
        unsigned* bar = b.bar;
        __builtin_amdgcn_s_waitcnt(0);
        unsigned nloc = b.st[0], nx = b.st[1];
        if (nloc == 0u) { xcd_barrier_complete(bar, b.x, nloc, nx); b.st[0] = nloc; b.st[1] = nx; }
        const unsigned old = xb_add(&bar[XB_XSUB(b.x)], 1u);
        const unsigned gen = old / nloc;
        if (old + 1u == (gen + 1u) * nloc) {
            __builtin_amdgcn_fence(__ATOMIC_RELEASE, "agent");
            asm volatile("s_waitcnt vmcnt(0)" ::: "memory");
            const unsigned og = xb_add(&bar[XB_TOP], 1u);
            const unsigned tg = og / nx;
            if (og + 1u == (tg + 1u) * nx) xb_add(&bar[XB_TOPGEN], 1u);
            else XB_SPIN(xb_ld(&bar[XB_TOPGEN]) == tg, bar);
            __builtin_amdgcn_fence(__ATOMIC_ACQUIRE, "agent");
            xb_add(&bar[XB_XGEN(b.x)], 1u);
            asm volatile("s_waitcnt vmcnt(0)" ::: "memory");
        } else {
            XB_SPIN(xb_ld(&bar[XB_XGEN(b.x)]) == gen, bar);
            __builtin_amdgcn_fence(__ATOMIC_ACQUIRE, "agent");
            asm volatile("s_waitcnt vmcnt(0)" ::: "memory");
        }
    }
    __syncthreads();
}

#ifndef MK_ONE_LAUNCH
#define MK_ONE_LAUNCH 1
#endif
constexpr int N_PHASES = 20;
#ifndef PROBE_REP
#define PROBE_REP (-1)
#endif
#define REPS(k) for (int rep_ = 0; rep_ < ((PROBE_REP == (k)) ? 2 : 1); ++rep_)
struct Args { Ptrs p; int ph_lo, ph_hi; };

__global__ void __launch_bounds__(NTHREADS, 2) fwd_kernel(Args args) {
    extern __shared__ __attribute__((aligned(16))) unsigned char lds_raw[];
    const int tid0 = threadIdx.x;
    const CP P0 = launder((CP)__builtin_amdgcn_kernarg_segment_ptr());
    const int lo = ((const __attribute__((address_space(4))) int*)P0)[70], hi = ((const __attribute__((address_space(4))) int*)P0)[71];
#define PH_BEGIN Frame F; { int t_ = tid0; asm volatile("" : "+v"(t_)); F.lds = (LAS unsigned char*)lds_raw; F.tid = t_; F.lane = t_ & 63; F.wave = __builtin_amdgcn_readfirstlane(t_ >> 6); \
        F.G = gridDim.x; F.bid = blockIdx.x; F.gw = F.bid * NWAVES + F.wave; F.NGW = F.G * NWAVES; } const CP P = launder(P0); unsigned char* const ws = P->ws; bf16_t* const XN = (bf16_t*)(ws + WS_XN); (void)XN;
    cg::grid_group grid = cg::this_grid();
    for (int u = tid0; u < 64; u += NTHREADS) ((LAS unsigned*)((LAS unsigned char*)lds_raw + LDS_BYTES - 256))[u] = 0u;
    __syncthreads();
    const XcdBarrier bar = xcd_barrier_post((unsigned*)(P0->ws + WS_CTL) + 4096, (volatile LAS unsigned*)((LAS unsigned char*)lds_raw + LDS_BYTES - 256) + 8);
#define IN(k) (lo <= (k) && (k) < hi)
#define SEAM(k) do { if (IN(k) && IN((k) + 1)) { if ((k) == 0) grid.sync(); else xcd_barrier(bar); } } while (0)

    if (IN(0)) { PH_BEGIN REPS(0) phase_prologue(F, P); } SEAM(0);
    if (IN(1)) { PH_BEGIN
        pg8::Gemm g{XN, (const bf16_t*)(ws + WS_WT_AB), M_TOK, AB_COLS, DM}; pg8::StaticOrder S; S.init(M_TOK, AB_COLS, F.G, F.bid);
        EpiAB E{(bf16_t*)(ws + WS_PA), (bf16_t*)(ws + WS_Z)};
        REPS(1) pg8::gemm_phase<EpiAB, pg8::StaticOrder, true, true>(F.lds, g, S, E);
    } SEAM(1);
    if (IN(2)) { PH_BEGIN phase_row_a(F, P); } SEAM(2);
    if (IN(3)) { PH_BEGIN
        int kl = 256; asm volatile("" : "+s"(kl));
        pg8::Gemm g{(const bf16_t*)(ws + WS_ALORA), (const bf16_t*)(ws + WS_BT_LORA), M_TOK, 3072, kl}; pg8::StaticOrder S; S.init(M_TOK, 3072, F.G, F.bid);
        EpiLora E{(bf16_t*)(ws + WS_DLOG), P->in[5], P->in[7]};
        REPS(3) pg8::gemm_phase<EpiLora, pg8::StaticOrder, true, true>(F.lds, g, S, E);
    } SEAM(3);
    if (IN(5)) { PH_BEGIN
        {   const int ppb = (4096 + F.G - 1) / F.G, p0 = F.bid * ppb, pend = (p0 + ppb < 4096) ? p0 + ppb : 4096; int cur_head = -1;
            u32x4 raw[8]; if (p0 < pend) chunk_prep_fetch(P, p0, F.wave, F.tid, raw);
            for (int pr = p0; pr < pend; ++pr) {
                const int hd = (pr >> 6) & 15;
                if (hd != cur_head) { __syncthreads(); cur_head = hd;
                    if (F.tid < 384) { const int arr = F.tid >> 6, ch = F.tid & 63; const float* src = arr < 3 ? P->in[4] + arr * 1024 : P->in[7 + arr];
                        ((LAS float*)(F.lds + CP_PAR))[F.tid] = src[hd * 64 + ch]; }
                    __syncthreads(); }
                chunk_prep_pair<0>(F, P, pr, pr + 1 < pend ? pr + 1 : -1, raw);
            } }
        REPS(25) for (int t = F.bid; t < 1024; t += F.G) sgu_tile(F, P, t);
        xcd_barrier(bar);
        {   volatile LAS unsigned* cnt = (volatile LAS unsigned*)(F.lds + 4096);
            REPS(55) for (int u = F.bid; u < 256; u += F.G) {
                if (F.tid == 0) *cnt = 0u;
                __syncthreads();
                if (F.wave < 4) chunk_scan_unit4(F, P, u, F.lds, cnt);
                else if (u == F.bid) { const int hw = F.bid * 4 + (F.wave - 4), NHW = F.G * 4;
                    for (int it = hw; it < 14336; it += NHW) late_transpose_item(P, it, (LAS float*)(F.lds + 8192 + (F.wave - 4) * 8448), F.lane); }
                __syncthreads();
            } }
    } SEAM(5);
    if (IN(6)) { PH_BEGIN REPS(6) phase_gn(F, P); } SEAM(6);
    if (IN(7)) { PH_BEGIN
        pg8::Gemm g{(const bf16_t*)(ws + WS_YAB), (const bf16_t*)(ws + WS_WT_ABO), M_TOK, DM, DM}; pg8::StaticOrder S; S.init(M_TOK, DM, F.G, F.bid);
        EpiRes E{P->in[0], P->out};
        REPS(7) pg8::gemm_phase<EpiRes, pg8::StaticOrder, true, true>(F.lds, g, S, E);
    } SEAM(7);
#define PEER_BLOCK(layer, pb) \
    if (IN(pb)) { PH_BEGIN REPS(pb) phase_rmsnorm(F, P->out, P->in[2] + (layer) * DM, XN); } SEAM(pb); \
    if (IN((pb) + 1)) { PH_BEGIN \
        pg8::Gemm g{XN, (const bf16_t*)(ws + WS_WT_Q + (size_t)(layer) * 8 * MiB), M_TOK, DM, DM}; pg8::StaticOrder S; S.init(M_TOK, DM, F.G, F.bid); \
        pg8::EpiBf16<0> E{(bf16_t*)(ws + WS_QP), DM, nullptr, 0, 0, 1.f}; \
        REPS((pb) + 1) pg8::gemm_phase<pg8::EpiBf16<0>, pg8::StaticOrder, true, true>(F.lds, g, S, E); \
    } SEAM((pb) + 1); \
    if (IN((pb) + 2)) { PH_BEGIN REPS((pb) + 2) for (int u = F.bid; u < 512; u += F.G) peer_topk_unit(F, P, (layer), u); } SEAM((pb) + 2); \
    if (IN((pb) + 3)) { PH_BEGIN if (PROBE_REP == (pb) + 3) phase_experts<(layer) == 0 ? L0_FMT : 4>(F, P, (layer), nullptr, (float*)(ws + WS_Y)); if (PROBE_REP == (pb) + 43) phase_experts<(layer) == 0 ? L0_FMT : 4, 2>(F, P, (layer), nullptr, (float*)(ws + WS_Y)); phase_experts<(layer) == 0 ? L0_FMT : 4>(F, P, (layer), (layer) == 0 ? P->in[1] + DM : nullptr, P->out); }
    PEER_BLOCK(0, 8) SEAM(11);
    if (IN(12)) { PH_BEGIN
        pg8::Gemm g{XN, (const bf16_t*)(ws + WS_WT_C), M_TOK, C_COLS, DM}; pg8::StaticOrder S; S.init(M_TOK, C_COLS, F.G, F.bid);
        pg8::EpiBf16<0> E{(bf16_t*)(ws + WS_QKV), C_COLS, nullptr, 0, 0, 1.f};
        REPS(12) pg8::gemm_phase<pg8::EpiBf16<0>, pg8::StaticOrder, true, true>(F.lds, g, S, E);
    } SEAM(12);
    if (IN(13)) { PH_BEGIN   phase_qknorm(F, P); } SEAM(13);
    if (IN(14)) { PH_BEGIN
        float lam;
        {   const float a = (F.lane < 64) ? P->in[23][F.lane] * P->in[24][F.lane] : 0.f, b2 = P->in[25][F.lane] * P->in[26][F.lane];
            lam = __expf(wave_sum(a)) - __expf(wave_sum(b2)) + LAMBDA_INIT; }
#define ATT_PASS(V) for (int u = F.bid; u < 2048; u += F.G) { const int c = u & 255, i = u >> 8, s = c & 3; const int qb = (i & 1) ? (8 * (i >> 1) + 7 - s) : (8 * (i >> 1) + s); attn_unit<V>(F, P, c >> 2, qb, lam); }
        if (PROBE_REP == 14) { ATT_PASS(5) } if (PROBE_REP == 141) { ATT_PASS(1) } if (PROBE_REP == 142) { ATT_PASS(2) } if (PROBE_REP == 143) { ATT_PASS(3) } if (PROBE_REP == 144) { ATT_PASS(4) }
        ATT_PASS(0)
#undef ATT_PASS
    } SEAM(14);
    if (IN(15)) { PH_BEGIN
        pg8::Gemm g{(const bf16_t*)(ws + WS_OB), (const bf16_t*)(ws + WS_WT_CO), M_TOK, DM, DM}; pg8::StaticOrder S; S.init(M_TOK, DM, F.G, F.bid);
        EpiRes E{P->out, P->out};
        pg8::gemm_phase<EpiRes, pg8::StaticOrder, true, true>(F.lds, g, S, E);
    } SEAM(15);
    PEER_BLOCK(1, 16)
#undef PEER_BLOCK
#undef IN
#undef SEAM
}

extern "C" void kernel_launch(void* const* d_in, const int* in_sizes, int n_in, void* d_out, int out_size, void* d_ws, size_t ws_size, hipStream_t stream) {
    static int grid = 0;
    if (grid == 0) {
        if (n_in != 33 || out_size != M_TOK * DM || ws_size < WS_END) { fprintf(stderr, "kernel_launch: unexpected problem (n_in %d out %d ws %zu)\n", n_in, out_size, ws_size); grid = -1; return; }
        int dev = 0, cus = 0, per_cu = 0;
        hipGetDevice(&dev); hipDeviceGetAttribute(&cus, hipDeviceAttributeMultiprocessorCount, dev);
        if (hipFuncSetAttribute((const void*)fwd_kernel, hipFuncAttributeMaxDynamicSharedMemorySize, LDS_BYTES) != hipSuccess) { fprintf(stderr, "kernel_launch: hipFuncSetAttribute failed\n"); grid = -1; return; }
        if (hipOccupancyMaxActiveBlocksPerMultiprocessor(&per_cu, (const void*)fwd_kernel, NTHREADS, LDS_BYTES) != hipSuccess || per_cu < 1) { fprintf(stderr, "kernel_launch: occupancy query says %d\n", per_cu); per_cu = 1; }
        (void)hipGetLastError();
        grid = cus * 1;
        fprintf(stderr, "kernel_launch: grid %d (cus %d, per_cu %d)\n", grid, cus, per_cu);
    }
    if (grid < 0) return;
    if (hipMemsetAsync((char*)d_ws + WS_CTL, 0, 65536, stream) != hipSuccess) { fprintf(stderr, "kernel_launch: memset failed\n"); return; }
    Args a{};
    for (int i = 0; i < 33; ++i) a.p.in[i] = (const float*)d_in[i];
    a.p.out = (float*)d_out; a.p.ws = (unsigned char*)d_ws;
#if MK_ONE_LAUNCH
    a.ph_lo = 0; a.ph_hi = N_PHASES;
    void* kargs[] = {&a};
    hipError_t e = hipLaunchCooperativeKernel((const void*)fwd_kernel, dim3(grid), dim3(NTHREADS), kargs, LDS_BYTES, stream);
    if (e != hipSuccess) fprintf(stderr, "kernel_launch: cooperative launch failed: %s\n", hipGetErrorString(e));
#else
    for (int ph = 0; ph < N_PHASES; ++ph) {
        a.ph_lo = ph; a.ph_hi = ph + 1;
        hipLaunchKernelGGL(fwd_kernel, dim3(grid), dim3(NTHREADS), LDS_BYTES, stream, a);
    }
#endif
}
```

```cpp
#include <hip/hip_runtime.h>
#include <hip/hip_cooperative_groups.h>
#include <cstdio>
#include <cstdint>
namespace cg = cooperative_groups;
namespace pg8 {
#define PG8_LAS __attribute__((address_space(3)))
typedef unsigned short bf16_t;
typedef short bf16x8 __attribute__((ext_vector_type(8)));
typedef float f32x4 __attribute__((ext_vector_type(4)));
typedef unsigned u32x4 __attribute__((ext_vector_type(4)));
constexpr int BM = 256, BK = 64, HALF = 128, HTB = HALF * BK * 2  , STAGE_BYTES = 8 * HTB, NXCD = 8, WGM = 8;

__host__ __device__ __forceinline__ int lds_byte(int r, int c) { const int st = (r >> 4) * 2 + (c >> 5), rr = r & 15, cc = c & 31, ob = rr * 64 + cc * 2; return st * 1024 + (ob ^ (((ob >> 9) & 1) << 5)); }
__host__ __device__ __forceinline__ void stage_rc(int b, int& R, int& C) { const int st = b / 1024, sb = b % 1024, swz = sb ^ (((sb >> 9) & 1) << 5); R = (st >> 1) * 16 + swz / 64; C = (st & 1) * 32 + (swz % 64) / 2; }
__host__ __device__ __forceinline__ int perm32(int rho) { const int n = rho >> 4, i = rho & 15; return 8 * (i >> 2) + 4 * n + (i & 3); }

struct Unit { int pm, pn; };
struct Gemm { const bf16_t* A; const bf16_t* Bt; int M, N, K; };

struct StaticOrder {
    int nM, nN, nwg, G, c;
    __host__ __device__ void init(int M, int N, int G_, int c_) { nM = M / BM; nN = N / BM; nwg = nM * nN; G = G_; c = c_; }
    __host__ __device__ bool next(int i, Unit& u) const {
        const long L = (long)i * G + c; if (L >= nwg) return false;
        int wgid = (int)L; { const int q = nwg / NXCD, r = nwg % NXCD, xcd = wgid % NXCD, off = wgid / NXCD; wgid = (xcd < r ? xcd * (q + 1) : r * (q + 1) + (xcd - r) * q) + off; }
        const int nig = WGM * nN, gid = wgid / nig, fm = gid * WGM, gsz = (nM - fm) < WGM ? (nM - fm) : WGM;
        u.pm = fm + ((wgid % nig) % gsz); u.pn = (wgid % nig) / gsz; return true;
    }
    __device__ __forceinline__ void a_ready(const Unit&) const {}
    __device__ __forceinline__ void done(const Unit&) const {}
};

__device__ __forceinline__ unsigned cvt_pk_bf16(float lo, float hi) { unsigned r; asm volatile("v_cvt_pk_bf16_f32 %0, %1, %2" : "=v"(r) : "v"(lo), "v"(hi)); return r; }
typedef float f32x2 __attribute__((ext_vector_type(2)));
__device__ __forceinline__ f32x2 gelu_pk(f32x2 v) {
    const f32x2 av = __builtin_elementwise_abs(v), d = av * 0.2316418882f + 1.0f;
    f32x2 t; t.x = __builtin_amdgcn_rcpf(d.x); t.y = __builtin_amdgcn_rcpf(d.y);
    f32x2 q = t * 0.5307027145f + (-0.7265760135f); q = q * t + 0.7107068705f; q = q * t + (-0.142248368f); q = q * t + 0.127414796f; q = q * t;
    const f32x2 s = (v * v) * (-0.72134752044f);
    f32x2 e; e.x = __builtin_amdgcn_exp2f(s.x); e.y = __builtin_amdgcn_exp2f(s.y);
    const f32x2 m = v * (q * e), r = v - m;
    f32x2 o; o.x = v.x < 0.f ? m.x : r.x; o.y = v.y < 0.f ? m.y : r.y; return o;
}

template <int ACT  > struct EpiBf16 {
    static constexpr bool PERM = true, AFTER_DRAIN = false; static_assert(ACT == 0 || ACT == 1, "EpiBf16: ACT is 0 (none) or 1 (gelu_pk)");
    bf16_t* O; int ldc; const float* bias; int split_cols; size_t split_stride; float scale0;
    __device__ __forceinline__ void operator()(const f32x4 (&acc)[2][2][4][2], const Unit& u, int wr, int wc, int fr, int fq) const {
        const int row0 = u.pm * BM + wr * 64 + fr; int colt = u.pn * BM; bf16_t* base = O;
        float sc = 1.f; if (split_cols) { const int t = colt / split_cols; base += (size_t)t * split_stride; colt -= t * split_cols; if (t == 0) sc = scale0; }
        const int col0 = colt + wc * 32 + 8 * fq, bcol0 = u.pn * BM + wc * 32 + 8 * fq;
        f32x4 bv[2][2];
#pragma unroll
        for (int bj = 0; bj < 2; ++bj)
#pragma unroll
            for (int n = 0; n < 2; ++n) bv[bj][n] = bias ? *(const f32x4*)(bias + bcol0 + bj * HALF + 4 * n) : (f32x4){0.f, 0.f, 0.f, 0.f};
#pragma unroll
        for (int ai = 0; ai < 2; ++ai)
#pragma unroll
            for (int m = 0; m < 4; ++m) { bf16_t* rowp = base + (size_t)(row0 + ai * HALF + m * 16) * ldc + col0;
#pragma unroll
                for (int bj = 0; bj < 2; ++bj) { f32x4 v0 = acc[ai][bj][m][0] + bv[bj][0], v1 = acc[ai][bj][m][1] + bv[bj][1];
                    if (ACT == 1) { f32x2 a = gelu_pk((f32x2){v0[0], v0[1]}), b = gelu_pk((f32x2){v0[2], v0[3]}), c = gelu_pk((f32x2){v1[0], v1[1]}), d = gelu_pk((f32x2){v1[2], v1[3]});
                        v0 = (f32x4){a.x, a.y, b.x, b.y}; v1 = (f32x4){c.x, c.y, d.x, d.y}; }
                    v0 = v0 * sc; v1 = v1 * sc; u32x4 w; w.x = cvt_pk_bf16(v0[0], v0[1]); w.y = cvt_pk_bf16(v0[2], v0[3]); w.z = cvt_pk_bf16(v1[0], v1[1]); w.w = cvt_pk_bf16(v1[2], v1[3]);
                    *(u32x4*)(rowp + bj * HALF) = w; } }
    }
};
template <class Epi, class Sched, bool ALIGN_EPI = false, bool SP2 = false>
__device__ __forceinline__ void gemm_phase(PG8_LAS unsigned char* lds, const Gemm g, const Sched& S, const Epi& E) {
    const int tid = threadIdx.x, wid = __builtin_amdgcn_readfirstlane(tid >> 6), lane = tid & 63, wr = wid >> 2, wc = wid & 3, fr = lane & 15, fq = lane >> 4;
    const int K = g.K, nt = K / BK;
    unsigned voffA[2], voffB[2];
#pragma unroll
    for (int i = 0; i < 2; ++i) { int R, C; stage_rc(tid * 16 + i * 8192, R, C); const int Rb = Epi::PERM ? ((R & ~31) + perm32(R & 31)) : R;
        voffA[i] = (unsigned)(R * K + C) * 2u; voffB[i] = (unsigned)(Rb * K + C) * 2u; }
    const size_t kstep = (size_t)(BK * 2);
    const size_t hstep = (size_t)HALF * K * 2;
    const size_t tstep = 2 * hstep;
    const unsigned ldsw = (unsigned)wid * 1024u;
    const int aoff = lds_byte(wr * 64 + fr, fq * 8), boff = lds_byte(wc * 32 + fr, fq * 8);
#define PG8_SA(b, h) (((b) * 2 + (h)) * HTB)
#define PG8_SB(b, h) ((4 + (b) * 2 + (h)) * HTB)
#define PG8_STAGE(bufoff, gbase, voff) do { _Pragma("unroll") for (int _i = 0; _i < 2; ++_i) \
        __builtin_amdgcn_global_load_lds((const unsigned*)((const char*)(gbase) + (voff)[_i]), (PG8_LAS unsigned*)(lds + (bufoff) + ldsw + _i * 8192), 16, 0, 0); } while (0)
#define PG8_LDA(dst, b, h) do { _Pragma("unroll") for (int m = 0; m < 4; ++m) _Pragma("unroll") for (int k = 0; k < 2; ++k) dst[m][k] = *(const PG8_LAS bf16x8*)(lds + PG8_SA(b, h) + aoff + m * 2048 + k * 1024); } while (0)
#define PG8_LDB(dst, b, h) do { _Pragma("unroll") for (int n = 0; n < 2; ++n) _Pragma("unroll") for (int k = 0; k < 2; ++k) dst[n][k] = *(const PG8_LAS bf16x8*)(lds + PG8_SB(b, h) + boff + n * 2048 + k * 1024); } while (0)
#define PG8_MMA(ai, bj, At, Bt) do { __builtin_amdgcn_s_setprio(1); _Pragma("unroll") for (int m = 0; m < 4; ++m) _Pragma("unroll") for (int n = 0; n < 2; ++n) _Pragma("unroll") for (int k = 0; k < 2; ++k) \
        acc[ai][bj][m][n] = __builtin_amdgcn_mfma_f32_16x16x32_bf16(Bt[n][k], At[m][k], acc[ai][bj][m][n], 0, 0, 0); __builtin_amdgcn_s_setprio(0); } while (0)
#define PG8_WAIT_V(n) asm volatile("s_waitcnt vmcnt(" #n ")" ::: "memory")
#define PG8_WAIT_L(n) asm volatile("s_waitcnt lgkmcnt(" #n ")" ::: "memory")
#define PG8_BAR __builtin_amdgcn_s_barrier()
#define PG8_SCHED __builtin_amdgcn_sched_barrier(0)
    Unit cur, nxt; int ui = 0;
    if (!S.next(0, cur)) return;
    f32x4 acc[2][2][4][2];
#pragma unroll
    for (int a = 0; a < 2; ++a)
#pragma unroll
        for (int b = 0; b < 2; ++b)
#pragma unroll
            for (int m = 0; m < 4; ++m)
#pragma unroll
                for (int n = 0; n < 2; ++n) acc[a][b][m][n] = (f32x4){0.f, 0.f, 0.f, 0.f};
    bf16x8 At[4][2], B0[2][2], B1[2][2];
    const char* cA = (const char*)g.A + (size_t)cur.pm * tstep; const char* cB = (const char*)g.Bt + (size_t)cur.pn * tstep;
    S.a_ready(cur);
    if constexpr (SP2) {
        PG8_STAGE(PG8_SB(0, 0), cB, voffB); PG8_STAGE(PG8_SB(0, 1), cB + hstep, voffB); PG8_STAGE(PG8_SA(0, 0), cA, voffA); PG8_STAGE(PG8_SA(0, 1), cA + hstep, voffA);
        if (wr == 1) PG8_BAR;
        PG8_WAIT_V(2); PG8_BAR;
        PG8_STAGE(PG8_SB(1, 0), cB + kstep, voffB); PG8_STAGE(PG8_SA(1, 0), cA + kstep, voffA); PG8_STAGE(PG8_SB(1, 1), cB + hstep + kstep, voffB);
        PG8_WAIT_V(6); PG8_BAR;
    } else {
        PG8_STAGE(PG8_SB(0, 0), cB, voffB); PG8_STAGE(PG8_SA(0, 0), cA, voffA); PG8_STAGE(PG8_SB(0, 1), cB + hstep, voffB); PG8_STAGE(PG8_SA(0, 1), cA + hstep, voffA);
        if (wr == 1) PG8_BAR;
        PG8_WAIT_V(4); PG8_BAR;
        PG8_STAGE(PG8_SB(1, 0), cB + kstep, voffB); PG8_STAGE(PG8_SA(1, 0), cA + kstep, voffA); PG8_STAGE(PG8_SB(1, 1), cB + hstep + kstep, voffB);
        PG8_WAIT_V(6); PG8_BAR;
    }
    for (;;) {
        const bool has_next = S.next(ui + 1, nxt);
        const char* nA = has_next ? (const char*)g.A + (size_t)nxt.pm * tstep : cA; const char* nB = has_next ? (const char*)g.Bt + (size_t)nxt.pn * tstep : cB;
        for (int t = 0; t < nt; t += 2) {
            const bool last = (t == nt - 2);
            const char* a1 = cA + (size_t)(t + 1) * kstep;
            const char* a2 = last ? nA : cA + (size_t)(t + 2) * kstep; const char* b2 = last ? nB : cB + (size_t)(t + 2) * kstep;
            const char* a3 = a2 + kstep; const char* b3 = b2 + kstep;
            if (last && has_next) S.a_ready(nxt);
            if constexpr (SP2) {
            PG8_LDB(B0, 0, 0); PG8_LDB(B1, 0, 1); PG8_SCHED; PG8_LDA(At, 0, 0); PG8_STAGE(PG8_SA(1, 1), a1 + hstep, voffA);
            PG8_WAIT_V(8); PG8_WAIT_L(0); PG8_BAR; PG8_MMA(0, 0, At, B0); PG8_MMA(0, 1, At, B1); PG8_BAR; PG8_SCHED;
            PG8_LDA(At, 0, 1); PG8_STAGE(PG8_SB(0, 0), b2, voffB); PG8_STAGE(PG8_SB(0, 1), b2 + hstep, voffB); PG8_STAGE(PG8_SA(0, 0), a2, voffA);
            PG8_WAIT_V(8); PG8_WAIT_L(0); PG8_BAR; PG8_MMA(1, 0, At, B0); PG8_MMA(1, 1, At, B1); PG8_BAR; PG8_SCHED;
            PG8_LDB(B0, 1, 0); PG8_LDB(B1, 1, 1); PG8_SCHED; PG8_LDA(At, 1, 0); PG8_STAGE(PG8_SA(0, 1), a2 + hstep, voffA);
            PG8_WAIT_V(8); PG8_WAIT_L(0); PG8_BAR; PG8_MMA(0, 0, At, B0); PG8_MMA(0, 1, At, B1); PG8_BAR; PG8_SCHED;
            PG8_LDA(At, 1, 1); PG8_STAGE(PG8_SB(1, 0), b3, voffB); PG8_STAGE(PG8_SB(1, 1), b3 + hstep, voffB); PG8_STAGE(PG8_SA(1, 0), a3, voffA);
            PG8_WAIT_V(8); PG8_WAIT_L(0); PG8_BAR; PG8_MMA(1, 0, At, B0); PG8_MMA(1, 1, At, B1); PG8_BAR; PG8_SCHED;
            } else {
            PG8_LDB(B0, 0, 0); PG8_SCHED; PG8_LDA(At, 0, 0); PG8_STAGE(PG8_SA(1, 1), a1 + hstep, voffA);
            PG8_WAIT_L(8); PG8_BAR; PG8_WAIT_L(0); PG8_MMA(0, 0, At, B0); PG8_BAR; PG8_SCHED;
            PG8_LDB(B1, 0, 1); PG8_STAGE(PG8_SB(0, 0), b2, voffB);
            PG8_BAR; PG8_WAIT_L(0); PG8_MMA(0, 1, At, B1); PG8_BAR;
            PG8_LDA(At, 0, 1); PG8_STAGE(PG8_SA(0, 0), a2, voffA);
            PG8_BAR; PG8_WAIT_L(0); PG8_MMA(1, 0, At, B0); PG8_BAR; PG8_SCHED;
            PG8_STAGE(PG8_SB(0, 1), b2 + hstep, voffB);
            PG8_WAIT_V(6); PG8_BAR; PG8_MMA(1, 1, At, B1); PG8_BAR;
            PG8_LDB(B0, 1, 0); PG8_SCHED; PG8_LDA(At, 1, 0); PG8_STAGE(PG8_SA(0, 1), a2 + hstep, voffA);
            PG8_WAIT_L(8); PG8_BAR; PG8_WAIT_L(0); PG8_MMA(0, 0, At, B0); PG8_BAR; PG8_SCHED;
            PG8_LDB(B1, 1, 1); PG8_STAGE(PG8_SB(1, 0), b3, voffB);
            PG8_BAR; PG8_WAIT_L(0); PG8_MMA(0, 1, At, B1); PG8_BAR;
            PG8_LDA(At, 1, 1); PG8_STAGE(PG8_SA(1, 0), a3, voffA);
            PG8_BAR; PG8_WAIT_L(0); PG8_MMA(1, 0, At, B0); PG8_BAR; PG8_SCHED;
            PG8_STAGE(PG8_SB(1, 1), b3 + hstep, voffB);
            PG8_WAIT_V(6); PG8_BAR; PG8_MMA(1, 1, At, B1); PG8_BAR;
            }
        }
        if constexpr (ALIGN_EPI) { if (wr == 0) PG8_BAR; }
        if constexpr (!Epi::AFTER_DRAIN) { E(acc, cur, wr, wc, fr, fq); S.done(cur); }
        if (!has_next) break;
#pragma unroll
        for (int a = 0; a < 2; ++a)
#pragma unroll
            for (int b = 0; b < 2; ++b)
#pragma unroll
                for (int m = 0; m < 4; ++m)
#pragma unroll
                    for (int n = 0; n < 2; ++n) acc[a][b][m][n] = (f32x4){0.f, 0.f, 0.f, 0.f};
        cur = nxt; cA = nA; cB = nB; ++ui;
        if constexpr (ALIGN_EPI) { if (wr == 1) PG8_BAR; }
    }
    PG8_WAIT_V(0);
    if constexpr (!ALIGN_EPI) { if (wr == 0) PG8_BAR; }
    PG8_BAR;
    if constexpr (Epi::AFTER_DRAIN) { E.fused(acc, cur, wr, wc, fr, fq, lds, wid, lane); S.done(cur); }
#undef PG8_SA
#undef PG8_SB
#undef PG8_STAGE
#undef PG8_LDA
#undef PG8_LDB
#undef PG8_MMA
#undef PG8_WAIT_V
#undef PG8_WAIT_L
#undef PG8_BAR
#undef PG8_SCHED
}
}
constexpr int M_TOK = 16384, DM = 2048, SEQ = 4096;
constexpr int NWAVES = 8, NTHREADS = 512;
constexpr int A_COLS = 3328, AB_COLS = 5376, C_COLS = 6144;
constexpr float DECAY_SCALE = 0.6065306597126334f;
constexpr float LAMBDA_INIT = 0.35550906759096316f;
constexpr float QSCALE = 0.125f * 1.4426950408889634f;

#define LAS __attribute__((address_space(3)))
typedef unsigned short bf16_t;
typedef short bf16x8 __attribute__((ext_vector_type(8)));
typedef short s16x4 __attribute__((ext_vector_type(4)));
typedef float f32x4 __attribute__((ext_vector_type(4)));
typedef float f32x2 __attribute__((ext_vector_type(2)));
typedef float f32x16 __attribute__((ext_vector_type(16)));
typedef unsigned u32x4 __attribute__((ext_vector_type(4)));
typedef unsigned u32x2 __attribute__((ext_vector_type(2)));
typedef unsigned u32x6 __attribute__((ext_vector_type(6)));
typedef float f32x32 __attribute__((ext_vector_type(32)));
#ifndef FP6_INTERLEAVED
#define FP6_INTERLEAVED 1
#endif
#ifndef L0_FMT
#define L0_FMT 4
#endif
#define FP6_IDX_A(i) (i)
#define FP6_IDX_B(i) (16 + (i))
#if FP6_INTERLEAVED
#define FP6_OUT_A(i) (2 * (i))
#define FP6_OUT_B(i) (2 * (i) + 1)
#else
#define FP6_OUT_A(i) (i)
#define FP6_OUT_B(i) (16 + (i))
#endif

constexpr size_t MiB = 1u << 20;
constexpr size_t WS_CTL = 0;
constexpr size_t WS_WT_AB = 2 * MiB, WS_WT_ABO = 23 * MiB, WS_WT_C = 31 * MiB, WS_WT_CO = 55 * MiB, WS_WT_Q = 63 * MiB  ;
constexpr size_t WS_BT_LORA = 79 * MiB, WS_KEYS = 81 * MiB, WS_ROPE = 82 * MiB, WS_SCALE = 83 * MiB;
constexpr size_t WS_UT = 84 * MiB, WS_VT = 212 * MiB, WS_XN = 340 * MiB;
constexpr size_t WS_PA = 404 * MiB, WS_Z = 508 * MiB, WS_ALORA = 572 * MiB, WS_DLOG = 580 * MiB, WS_ICLR = 612 * MiB, WS_GATE = 644 * MiB;
constexpr size_t WS_BONUS = 868 * MiB, WS_Y = 869 * MiB, WS_YAB = 933 * MiB, WS_END = 997 * MiB;
constexpr size_t WS_QP = 404 * MiB, WS_EIDX = 468 * MiB, WS_EGATE = 476 * MiB;
constexpr size_t WS_QKV = 508 * MiB, WS_OB = 700 * MiB;
constexpr int LDS_BYTES = 147456;

__device__ __forceinline__ float bf_lo(unsigned w) { return __uint_as_float(w << 16); }
__device__ __forceinline__ float bf_hi(unsigned w) { return __uint_as_float(w & 0xffff0000u); }
__device__ __forceinline__ float bf_1(unsigned short w) { return __uint_as_float(((unsigned)w) << 16); }
__device__ __forceinline__ unsigned pkbf(float lo, float hi) { return pg8::cvt_pk_bf16(lo, hi); }
typedef __bf16 bf16x2_t __attribute__((ext_vector_type(2)));
__device__ __forceinline__ unsigned pkbf_c(float lo, float hi) { const f32x2 v = {lo, hi}; const bf16x2_t b = __builtin_convertvector(v, bf16x2_t); return __builtin_bit_cast(unsigned, b); }
__device__ __forceinline__ void unpack8(const u32x4 a, float (&o)[8]) {
    o[0] = bf_lo(a.x); o[1] = bf_hi(a.x); o[2] = bf_lo(a.y); o[3] = bf_hi(a.y); o[4] = bf_lo(a.z); o[5] = bf_hi(a.z); o[6] = bf_lo(a.w); o[7] = bf_hi(a.w);
}
__device__ __forceinline__ u32x4 pack8(const float (&o)[8]) { u32x4 r; r.x = pkbf(o[0], o[1]); r.y = pkbf(o[2], o[3]); r.z = pkbf(o[4], o[5]); r.w = pkbf(o[6], o[7]); return r; }
__device__ __forceinline__ void ld16bf(const bf16_t* p, float (&o)[16]) {
    const u32x4 a = *(const u32x4*)p, b = *(const u32x4*)(p + 8); float t[8];
    unpack8(a, t);
#pragma unroll
    for (int i = 0; i < 8; ++i) o[i] = t[i];
    unpack8(b, t);
#pragma unroll
    for (int i = 0; i < 8; ++i) o[8 + i] = t[i];
}
__device__ __forceinline__ void st16bf(bf16_t* p, const float (&o)[16]) {
    u32x4 a, b; a.x = pkbf(o[0], o[1]); a.y = pkbf(o[2], o[3]); a.z = pkbf(o[4], o[5]); a.w = pkbf(o[6], o[7]);
    b.x = pkbf(o[8], o[9]); b.y = pkbf(o[10], o[11]); b.z = pkbf(o[12], o[13]); b.w = pkbf(o[14], o[15]);
    *(u32x4*)p = a; *(u32x4*)(p + 8) = b;
}
__device__ __forceinline__ void ld16f(const float* p, float (&o)[16]) {
#pragma unroll
    for (int i = 0; i < 4; ++i) { const f32x4 v = *(const f32x4*)(p + 4 * i); o[4 * i] = v.x; o[4 * i + 1] = v.y; o[4 * i + 2] = v.z; o[4 * i + 3] = v.w; }
}
__device__ __forceinline__ float sigmoidf_(float x) { return __builtin_amdgcn_rcpf(1.0f + __expf(-x)); }

template <int CTRL> __device__ __forceinline__ float dpp_mov(float x) { return __int_as_float(__builtin_amdgcn_update_dpp(0, __float_as_int(x), CTRL, 0xf, 0xf, true)); }
__device__ __forceinline__ float quad_sum(float x) { x += dpp_mov<0xB1>(x); x += dpp_mov<0x4E>(x); return x; }
__device__ __forceinline__ float oct_sum(float x) { x = quad_sum(x); x += dpp_mov<0x141>(x); return x; }
__device__ __forceinline__ float row16_sum(float x) { x = oct_sum(x); x += dpp_mov<0x140>(x); return x; }
__device__ __forceinline__ float wave_sum(float x) { x = row16_sum(x); x += __shfl_xor(x, 16); x += __shfl_xor(x, 32); return x; }
__device__ __forceinline__ float row16_max(float x) {
    x = fmaxf(x, dpp_mov<0xB1>(x)); x = fmaxf(x, dpp_mov<0x4E>(x)); x = fmaxf(x, dpp_mov<0x141>(x)); x = fmaxf(x, dpp_mov<0x140>(x)); return x;
}
__device__ __forceinline__ float wave_max(float x) { x = row16_max(x); x = fmaxf(x, __shfl_xor(x, 16)); x = fmaxf(x, __shfl_xor(x, 32)); return x; }

__device__ __forceinline__ unsigned fkey(float f) { const unsigned u = __float_as_uint(f); return u ^ ((unsigned)((int)u >> 31) | 0x80000000u); }
__device__ __forceinline__ int crow(int r, int hi) { return (r & 3) + 8 * (r >> 2) + 4 * hi; }
__device__ __forceinline__ s16x4 vtr(LAS unsigned char* p) { typedef short v4i16_t __attribute__((ext_vector_type(4))); return __builtin_bit_cast(s16x4, __builtin_amdgcn_ds_read_tr16_b64_v4i16((LAS v4i16_t*)p)); }
__device__ __forceinline__ float gelu1(float v) { pg8::f32x2 r = pg8::gelu_pk((pg8::f32x2){v, v}); return r.x; }

struct EpiAB {
    static constexpr bool PERM = true, AFTER_DRAIN = false;
    bf16_t* PA; bf16_t* Z;
    __device__ __forceinline__ void operator()(const pg8::f32x4 (&acc)[2][2][4][2], const pg8::Unit& u, int wr, int wc, int fr, int fq) const {
        const int row0 = u.pm * 256 + wr * 64 + fr;
        const bool isz = u.pn >= 13;
        bf16_t* base = isz ? Z : PA; const int ldc = isz ? 2048 : A_COLS; const int colt = isz ? (u.pn - 13) * 256 : u.pn * 256;
        const int col0 = colt + wc * 32 + 8 * fq;
#pragma unroll
        for (int ai = 0; ai < 2; ++ai)
#pragma unroll
            for (int m = 0; m < 4; ++m) { bf16_t* rowp = base + (size_t)(row0 + ai * 128 + m * 16) * ldc + col0;
#pragma unroll
                for (int bj = 0; bj < 2; ++bj) { pg8::f32x4 v0 = acc[ai][bj][m][0], v1 = acc[ai][bj][m][1];
                    if (isz) { pg8::f32x2 a = pg8::gelu_pk((pg8::f32x2){v0[0], v0[1]}), b = pg8::gelu_pk((pg8::f32x2){v0[2], v0[3]}), c = pg8::gelu_pk((pg8::f32x2){v1[0], v1[1]}), d = pg8::gelu_pk((pg8::f32x2){v1[2], v1[3]});
                        v0 = (pg8::f32x4){a.x, a.y, b.x, b.y}; v1 = (pg8::f32x4){c.x, c.y, d.x, d.y}; }
                    u32x4 w; w.x = pkbf(v0[0], v0[1]); w.y = pkbf(v0[2], v0[3]); w.z = pkbf(v1[0], v1[1]); w.w = pkbf(v1[2], v1[3]);
                    *(u32x4*)(rowp + bj * 128) = w; } }
    }
};
struct EpiLora {
    static constexpr bool PERM = true, AFTER_DRAIN = false;
    bf16_t* base3; const float *dbias, *ibias;
    __device__ __forceinline__ void operator()(const pg8::f32x4 (&acc)[2][2][4][2], const pg8::Unit& u, int wr, int wc, int fr, int fq) const {
        const int row0 = u.pm * 256 + wr * 64 + fr;
        const int kind = u.pn >> 2; const int colt = (u.pn & 3) * 256;
        bf16_t* base = base3 + (size_t)kind * (size_t)(16 * MiB);
        const float* bias = kind == 0 ? dbias : ibias;
        const int col0 = colt + wc * 32 + 8 * fq;
#pragma unroll
        for (int bj = 0; bj < 2; ++bj) {
            pg8::f32x4 b0 = (pg8::f32x4){0.f, 0.f, 0.f, 0.f}, b1 = b0;
            if (kind < 2) { b0 = *(const pg8::f32x4*)(bias + col0 + bj * 128); b1 = *(const pg8::f32x4*)(bias + col0 + bj * 128 + 4); }
#pragma unroll
            for (int ai = 0; ai < 2; ++ai)
#pragma unroll
                for (int m = 0; m < 4; ++m) { bf16_t* rowp = base + (size_t)(row0 + ai * 128 + m * 16) * 1024 + col0;
                    pg8::f32x4 v0 = acc[ai][bj][m][0] + b0, v1 = acc[ai][bj][m][1] + b1;
                    if (kind < 2) { const float sc = kind == 0 ? DECAY_SCALE : 1.0f;
#pragma unroll
                        for (int i = 0; i < 4; ++i) { v0[i] = sc * sigmoidf_(v0[i]); v1[i] = sc * sigmoidf_(v1[i]); } }
                    u32x4 w; w.x = pkbf(v0[0], v0[1]); w.y = pkbf(v0[2], v0[3]); w.z = pkbf(v1[0], v1[1]); w.w = pkbf(v1[2], v1[3]);
                    *(u32x4*)(rowp + bj * 128) = w; } }
    }
};
struct EpiRes {
    static constexpr bool PERM = false, AFTER_DRAIN = false;
    const float* res; float* out;
    __device__ __forceinline__ void operator()(const pg8::f32x4 (&acc)[2][2][4][2], const pg8::Unit& u, int wr, int wc, int fr, int fq) const {
        const int row0 = u.pm * 256 + wr * 64 + fr; const int col0 = u.pn * 256 + wc * 32 + 4 * fq;
#pragma unroll
        for (int ai = 0; ai < 2; ++ai)
#pragma unroll
            for (int m = 0; m < 4; ++m) { const size_t off = (size_t)(row0 + ai * 128 + m * 16) * DM + col0;
#pragma unroll
                for (int bj = 0; bj < 2; ++bj)
#pragma unroll
                    for (int n = 0; n < 2; ++n) { const pg8::f32x4 r = *(const pg8::f32x4*)(res + off + bj * 128 + n * 16); *(pg8::f32x4*)(out + off + bj * 128 + n * 16) = r + acc[ai][bj][m][n]; } }
    }
};

struct Frame {
    LAS unsigned char* lds;
    int tid, lane, wave, G, bid;
    int gw, NGW;
};

__device__ __forceinline__ void rms_row_to_bf16(const float* xrow, const float* g, bf16_t* orow, int lane) {
    const f32x4* xr = (const f32x4*)xrow + lane; f32x4 v[8]; float s = 0.f;
#pragma unroll
    for (int j = 0; j < 8; ++j) { v[j] = xr[64 * j]; s += (v[j].x * v[j].x + v[j].y * v[j].y) + (v[j].z * v[j].z + v[j].w * v[j].w); }
    const float rstd = rsqrtf(wave_sum(s) * (1.0f / DM) + 1e-6f);
    const f32x4* gr = (const f32x4*)g + lane; u32x2* o8 = (u32x2*)orow + lane;
#pragma unroll
    for (int j = 0; j < 8; ++j) { const f32x4 gv = gr[64 * j]; u32x2 w; w.x = pkbf(v[j].x * rstd * gv.x, v[j].y * rstd * gv.y); w.y = pkbf(v[j].z * rstd * gv.z, v[j].w * rstd * gv.w); o8[64 * j] = w; }
}

__device__ __forceinline__ void p0_transpose_item(const float* W, int K, int N, bf16_t* WT, int row_off, LAS float* scr, int item, int lane) {
    const int nblk = N / 32, kb = item / nblk, nb = item % nblk, k0 = 64 * kb, n0 = 32 * nb;
#pragma unroll 8
    for (int i = 0; i < 32; ++i) { const int kk = 2 * i + (lane >> 5); scr[kk * 33 + (lane & 31)] = W[(size_t)(k0 + kk) * N + n0 + (lane & 31)]; }
    asm volatile("s_waitcnt lgkmcnt(0)" ::: "memory");
    const int c = lane & 7;
#pragma unroll
    for (int j = 0; j < 4; ++j) { const int n = (lane >> 3) + 8 * j; const LAS float* s = scr + (8 * c) * 33 + n;
        u32x4 o; o.x = pkbf(s[0 * 33], s[1 * 33]); o.y = pkbf(s[2 * 33], s[3 * 33]); o.z = pkbf(s[4 * 33], s[5 * 33]); o.w = pkbf(s[6 * 33], s[7 * 33]);
        *(u32x4*)(WT + (size_t)(row_off + n0 + n) * K + k0 + 8 * c) = o; }
    asm volatile("s_waitcnt lgkmcnt(0)" ::: "memory");
}

struct Ptrs {
    const float* in[33];
    float* out;
    unsigned char* ws;
};
typedef const __attribute__((address_space(4))) Ptrs* CP;
__device__ __forceinline__ CP launder(CP p) { asm volatile("" : "+s"(p)); return p; }

__device__ __forceinline__ void quant_load(CP P, int r, int lane, f32x4 (&x)[8]) {
    const int rr = r & 32767; const bool isv = r >= 32768;
    const float* src = (isv ? P->in[32] : P->in[31]) + (size_t)rr * DM + 4 * lane;
#pragma unroll
    for (int k = 0; k < 8; ++k) x[k] = *(const f32x4*)(src + 256 * k);
}
__device__ __forceinline__ void quant_finish(CP P, int r, int lane, const f32x4 (&x)[8]) {
    unsigned char* ws = P->ws; float* SC = (float*)(ws + WS_SCALE);
    const int rr = r & 32767; const bool isv = r >= 32768; const int layer = rr >> 14, e = rr & 16383;
    unsigned char* tab = ws + (isv ? WS_VT : WS_UT);
    float v[32]; float am = 0.f;
#pragma unroll
    for (int k = 0; k < 8; ++k) { v[4 * k] = x[k].x; v[4 * k + 1] = x[k].y; v[4 * k + 2] = x[k].z; v[4 * k + 3] = x[k].w;
        am = fmaxf(am, fmaxf(fmaxf(fabsf(x[k].x), fabsf(x[k].y)), fmaxf(fabsf(x[k].z), fabsf(x[k].w)))); }
    am = wave_max(am); const bool f6 = (layer == 0 && L0_FMT == 6); const float sc = fmaxf(am, 1e-30f) * (f6 ? (1.0f / 7.5f) : (1.0f / 6.0f)), inv = 1.0f / sc;
#pragma unroll
    for (int i = 0; i < 32; ++i) v[i] *= inv;
    if (f6) {
        f32x16 a, b;
#pragma unroll
        for (int i = 0; i < 16; ++i) { a[i] = v[FP6_IDX_A(i)]; b[i] = v[FP6_IDX_B(i)]; }
        const u32x6 q = __builtin_amdgcn_cvt_scalef32_2xpk16_fp6_f32(a, b, 1.0f);
        unsigned char* dst = tab + (size_t)e * 1536;
        *(u32x4*)(dst + 16 * lane) = (u32x4){q[0], q[1], q[2], q[3]}; *(u32x2*)(dst + 1024 + 8 * lane) = (u32x2){q[4], q[5]};
    } else {
        u32x4 q;
#pragma unroll
        for (int d = 0; d < 4; ++d) { unsigned w = 0u;
            w = __builtin_amdgcn_cvt_scalef32_pk_fp4_f32(w, v[8 * d + 0], v[8 * d + 1], 1.0f, 0); w = __builtin_amdgcn_cvt_scalef32_pk_fp4_f32(w, v[8 * d + 2], v[8 * d + 3], 1.0f, 1);
            w = __builtin_amdgcn_cvt_scalef32_pk_fp4_f32(w, v[8 * d + 4], v[8 * d + 5], 1.0f, 2); w = __builtin_amdgcn_cvt_scalef32_pk_fp4_f32(w, v[8 * d + 6], v[8 * d + 7], 1.0f, 3); q[d] = w; }
        *(u32x4*)(tab + (size_t)layer * 32 * MiB + (size_t)e * 1024 + 16 * lane) = q;
    }
    if (lane == 0) SC[r] = sc;
}

__device__ __forceinline__ void late_transpose_item(CP P, int item, LAS float* scr, int lane) {
    unsigned char* ws = P->ws; constexpr int I_SQ = 32 * 64, I_C = 32 * (C_COLS / 32);
    int r = item;
    if (r < I_SQ) { p0_transpose_item(P->in[19], DM, DM, (bf16_t*)(ws + WS_WT_ABO), 0, scr, r, lane); return; } r -= I_SQ;
    if (r < I_C) { p0_transpose_item(P->in[20], DM, C_COLS, (bf16_t*)(ws + WS_WT_C), 0, scr, r, lane); return; } r -= I_C;
    if (r < I_SQ) { p0_transpose_item(P->in[28], DM, DM, (bf16_t*)(ws + WS_WT_CO), 0, scr, r, lane); return; } r -= I_SQ;
    if (r < I_SQ) { p0_transpose_item(P->in[29], DM, DM, (bf16_t*)(ws + WS_WT_Q), 0, scr, r, lane); return; } r -= I_SQ;
    p0_transpose_item(P->in[29] + (size_t)DM * DM, DM, DM, (bf16_t*)(ws + WS_WT_Q + 8 * MiB), 0, scr, r, lane);
}

__device__ __forceinline__ void phase_prologue(const Frame& F, CP P) {
    unsigned char* ws = P->ws;
    LAS float* scr = (LAS float*)(F.lds + F.wave * 16384);
    constexpr int I_AB = 32 * (AB_COLS / 32), I_SQ = 32 * 64;
    for (int it = F.gw; it < I_AB; it += F.NGW) p0_transpose_item(P->in[3], DM, AB_COLS, (bf16_t*)(ws + WS_WT_AB), 0, scr, it, F.lane);
    const int gt = F.bid * NTHREADS + F.tid, NGT = F.G * NTHREADS;
    {   bf16_t* BT = (bf16_t*)(ws + WS_BT_LORA);
        for (int it = gt; it < 3072 * 32; it += NGT) {
            const int kg = it / 3072, n = it % 3072, k0 = kg * 8; float v[8];
#pragma unroll
            for (int i = 0; i < 8; ++i) { const int k = k0 + i; float x = 0.f;
                if (n < 1024) { if (k < 64) x = P->in[6][(size_t)k * 1024 + n]; }
                else if (n < 2048) { if (k >= 64 && k < 128) x = P->in[8][(size_t)(k - 64) * 1024 + (n - 1024)]; }
                else { if (k >= 128) x = P->in[9][(size_t)(k - 128) * 1024 + (n - 2048)]; }
                v[i] = x; }
            *(u32x4*)(BT + (size_t)n * 256 + k0) = pack8(v);
        } }
    {   const f32x4* src = (const f32x4*)P->in[30]; u32x4* dst = (u32x4*)(ws + WS_KEYS);
        for (int it = gt; it < 65536; it += NGT) { const f32x4 a = src[2 * it], b = src[2 * it + 1]; u32x4 o; o.x = pkbf(a.x, a.y); o.y = pkbf(a.z, a.w); o.z = pkbf(b.x, b.y); o.w = pkbf(b.z, b.w); dst[it] = o; } }
    {   f32x2* rt = (f32x2*)(ws + WS_ROPE);
        for (int it = gt; it < 4096 * 8; it += NGT) { const int pos = it >> 3, i = it & 7; const float inv = powf(500000.0f, -(float)i * 0.125f); const float ang = (float)pos * inv; rt[it] = (f32x2){cosf(ang), sinf(ang)}; } }
    for (int m = F.gw; m < M_TOK; m += F.NGW) rms_row_to_bf16(P->in[0] + (size_t)m * DM, P->in[1], (bf16_t*)(ws + WS_XN) + (size_t)m * DM, F.lane);
}

__device__ __forceinline__ void phase_row_a(const Frame& F, CP P) {
    const bf16_t* PA = (const bf16_t*)(P->ws + WS_PA); bf16_t* Z = (bf16_t*)(P->ws + WS_Z); bf16_t* AL = (bf16_t*)(P->ws + WS_ALORA);
    const float* mu = P->in[4] + 3072; const float* lnw = P->in[15]; const float* lnb = P->in[16];
    const int lane = F.lane;
    for (int t = F.gw; t < M_TOK; t += F.NGW) {
        {   const int c = 4 * lane;
            const u32x2 cu = *(const u32x2*)(PA + (size_t)t * A_COLS + 3072 + c);
            u32x2 pv = (u32x2){0u, 0u}; if ((t & (SEQ - 1)) != 0) pv = *(const u32x2*)(PA + (size_t)(t - 1) * A_COLS + 3072 + c);
            const f32x4 m4 = *(const f32x4*)(mu + c);
            float cur[4] = {bf_lo(cu.x), bf_hi(cu.x), bf_lo(cu.y), bf_hi(cu.y)}, prv[4] = {bf_lo(pv.x), bf_hi(pv.x), bf_lo(pv.y), bf_hi(pv.y)}, mm[4] = {m4.x, m4.y, m4.z, m4.w}, o[4];
#pragma unroll
            for (int i = 0; i < 4; ++i) { const float v = cur[i] + (prv[i] - cur[i]) * mm[i]; o[i] = (c < 64) ? tanhf(v) : ((c < 128) ? v : sigmoidf_(v)); }
            u32x2 w; w.x = pkbf(o[0], o[1]); w.y = pkbf(o[2], o[3]); *(u32x2*)(AL + (size_t)t * 256 + c) = w; }
        {   bf16_t* zr = Z + (size_t)t * 2048 + 1024; float v[16]; float t8[8];
            unpack8(*(const u32x4*)(zr + 8 * lane), t8);
#pragma unroll
            for (int i = 0; i < 8; ++i) v[i] = t8[i];
            unpack8(*(const u32x4*)(zr + 512 + 8 * lane), t8);
#pragma unroll
            for (int i = 0; i < 8; ++i) v[8 + i] = t8[i];
            float s = 0.f;
#pragma unroll
            for (int i = 0; i < 16; ++i) s += v[i];
            const float mean = wave_sum(s) * (1.0f / 1024.0f); float q = 0.f;
#pragma unroll
            for (int i = 0; i < 16; ++i) { v[i] -= mean; q += v[i] * v[i]; }
            const float rstd = rsqrtf(wave_sum(q) * (1.0f / 1024.0f) + 1e-5f);
#pragma unroll
            for (int j = 0; j < 2; ++j) { const int c = 512 * j + 8 * lane; float o[8];
                const f32x4 w0 = *(const f32x4*)(lnw + c), w1 = *(const f32x4*)(lnw + c + 4), b0 = *(const f32x4*)(lnb + c), b1 = *(const f32x4*)(lnb + c + 4);
                const float ww[8] = {w0.x, w0.y, w0.z, w0.w, w1.x, w1.y, w1.z, w1.w}, bb[8] = {b0.x, b0.y, b0.z, b0.w, b1.x, b1.y, b1.z, b1.w};
#pragma unroll
                for (int i = 0; i < 8; ++i) o[i] = v[8 * j + i] * rstd * ww[i] + bb[i];
                *(u32x4*)(zr + c) = pack8(o); } }
    }
}

__device__ __forceinline__ void sgu_tile(const Frame& F, CP P, int tile) {
    const int tid = F.tid, wave = F.wave, lane = F.lane, q31 = lane & 31, hh = lane >> 5; const int cch = tile >> 3, g = tile & 7, t0 = cch * 128;
    const bf16_t* Z = (const bf16_t*)(P->ws + WS_Z); bf16_t* YAB = (bf16_t*)(P->ws + WS_YAB);
    const float* Wg = P->in[17] + (size_t)g * 16384; const float* bs = P->in[18] + g * 128;
    LAS unsigned char* Wl = F.lds;
    LAS unsigned char* Vl = F.lds + 34816;
#pragma unroll
    for (int i = 0; i < 8; ++i) { const int p = tid + 512 * i, t = p >> 5, s4 = (p & 31) * 4; f32x4 w = *(const f32x4*)(Wg + t * 128 + s4);
        if (s4 + 0 > t) w.x = 0.f; if (s4 + 1 > t) w.y = 0.f; if (s4 + 2 > t) w.z = 0.f; if (s4 + 3 > t) w.w = 0.f;
        *(LAS u32x2*)(Wl + t * 272 + s4 * 2) = (u32x2){pkbf(w.x, w.y), pkbf(w.z, w.w)}; }
#pragma unroll
    for (int i = 0; i < 4; ++i) { const int p = tid + 512 * i, s = p >> 4, d8 = (p & 15) * 8;
        *(LAS u32x4*)(Vl + s * 320 + d8 * 2) = *(const u32x4*)(Z + (size_t)(t0 + s) * 2048 + 1024 + g * 128 + d8); }
    __syncthreads();
    const int dt = wave & 3, tiA = (wave >> 2) ? 1 : 0, tiB = (wave >> 2) ? 2 : 3;
    f32x16 accA, accB;
#pragma unroll
    for (int r = 0; r < 16; ++r) { accA[r] = 0.f; accB[r] = 0.f; }
    LAS unsigned char* Vb = Vl + (8 * hh + ((lane >> 2) & 3)) * 320 + (32 * dt + 16 * ((lane >> 4) & 1) + 4 * (lane & 3)) * 2;
    const LAS unsigned char* WbA = Wl + (32 * tiA + q31) * 272 + hh * 16; const LAS unsigned char* WbB = Wl + (32 * tiB + q31) * 272 + hh * 16;
    const int nA = 2 * tiA + 2, nB = 2 * tiB + 2;
    for (int ks = 0; ks < nB; ++ks) {
        const s16x4 lo = vtr(Vb + (16 * ks) * 320), hi = vtr(Vb + (16 * ks + 4) * 320);
        const bf16x8 vf = (bf16x8){lo[0], lo[1], lo[2], lo[3], hi[0], hi[1], hi[2], hi[3]};
        const bf16x8 wb = *(const LAS bf16x8*)(WbB + ks * 32);
        accB = __builtin_amdgcn_mfma_f32_32x32x16_bf16(vf, wb, accB, 0, 0, 0);
        if (ks < nA) { const bf16x8 wa = *(const LAS bf16x8*)(WbA + ks * 32); accA = __builtin_amdgcn_mfma_f32_32x32x16_bf16(vf, wa, accA, 0, 0, 0); }
    }
#pragma unroll
    for (int which = 0; which < 2; ++which) { const int ti = which ? tiB : tiA; const int t = 32 * ti + q31; const float bias = bs[t];
        const bf16_t* up = Z + (size_t)(t0 + t) * 2048 + g * 128 + 32 * dt + 4 * hh; bf16_t* op = YAB + (size_t)(t0 + t) * 2048 + 1024 + g * 128 + 32 * dt + 4 * hh;
#pragma unroll
        for (int g4 = 0; g4 < 4; ++g4) { const u32x2 uu = *(const u32x2*)(up + 8 * g4);
            const float a0 = which ? accB[4 * g4 + 0] : accA[4 * g4 + 0], a1 = which ? accB[4 * g4 + 1] : accA[4 * g4 + 1], a2 = which ? accB[4 * g4 + 2] : accA[4 * g4 + 2], a3 = which ? accB[4 * g4 + 3] : accA[4 * g4 + 3];
            *(u32x2*)(op + 8 * g4) = (u32x2){pkbf(bf_lo(uu.x) * (a0 + bias), bf_hi(uu.x) * (a1 + bias)), pkbf(bf_lo(uu.y) * (a2 + bias), bf_hi(uu.y) * (a3 + bias))}; } }
    __syncthreads();
}

__device__ __forceinline__ void phase_gn(const Frame& F, CP P) {
    const float* Y = (const float*)(P->ws + WS_Y); const float* BON = (const float*)(P->ws + WS_BONUS);
    const bf16_t* GT = (const bf16_t*)(P->ws + WS_GATE); bf16_t* YAB = (bf16_t*)(P->ws + WS_YAB);
    const float* gnw = P->in[13]; const float* gnb = P->in[14];
    const int lane = F.lane, c = 16 * lane, h = lane >> 2, q = lane & 3;
    for (int t = F.gw; t < M_TOK; t += F.NGW) {
        float y[16], tmp[16], tb[16], o[16];
        ld16f(Y + (size_t)t * 1024 + c, y); float s = 0.f;
#pragma unroll
        for (int i = 0; i < 16; ++i) s += y[i];
        const float mean = quad_sum(s) * (1.0f / 64.0f); float qq = 0.f;
#pragma unroll
        for (int i = 0; i < 16; ++i) { y[i] -= mean; qq += y[i] * y[i]; }
        const float rstd = rsqrtf(quad_sum(qq) * (1.0f / 64.0f) + 64e-5f);
        ld16f(gnw + c, tmp); ld16f(gnb + c, tb);
#pragma unroll
        for (int i = 0; i < 16; ++i) y[i] = y[i] * rstd * tmp[i] + tb[i];
        const float bon = BON[(size_t)t * 16 + h];
        {   const bf16_t* PA = (const bf16_t*)(P->ws + WS_PA); float vp[16], mv[16];
            ld16bf(PA + (size_t)t * A_COLS + 2048 + c, tmp); ld16f(P->in[4] + 2048 + c, mv);
            if ((t & (SEQ - 1)) != 0) { ld16bf(PA + (size_t)(t - 1) * A_COLS + 2048 + c, vp);
#pragma unroll
                for (int i = 0; i < 16; ++i) tmp[i] += (vp[i] - tmp[i]) * mv[i]; }
            else {
#pragma unroll
                for (int i = 0; i < 16; ++i) tmp[i] -= tmp[i] * mv[i]; } }
        ld16bf(GT + (size_t)t * 1024 + c, tb);
#pragma unroll
        for (int i = 0; i < 16; ++i) o[i] = (y[i] + bon * tmp[i]) * tb[i];
        st16bf(YAB + (size_t)t * 2048 + c, o);
    }
}

__device__ __forceinline__ void phase_rmsnorm(const Frame& F, const float* X, const float* g, bf16_t* XN) {
    for (int m = F.gw; m < M_TOK; m += F.NGW) rms_row_to_bf16(X + (size_t)m * DM, g, XN + (size_t)m * DM, F.lane);
}

constexpr int TK_WAVE_BYTES = 17024;
__device__ __forceinline__ void peer_topk_unit(const Frame& F, CP P, int layer, int u) {
    const int wave = F.wave, lane = F.lane, lr = lane & 15, lg = lane >> 4;
    const int h = u & 7, tg = u >> 3;
    const bf16_t* KEYS = (const bf16_t*)(P->ws + WS_KEYS) + (size_t)((layer * 8 + h) * 2) * 16384;
    const bf16_t* QP = (const bf16_t*)(P->ws + WS_QP);
    int* EIDX = (int*)(P->ws + WS_EIDX); float* EGATE = (float*)(P->ws + WS_EGATE);
    LAS float* sc = (LAS float*)(F.lds + wave * TK_WAVE_BYTES);
    LAS float* rv = sc + 2176; LAS int* ri = (LAS int*)(rv + 1024); LAS float* fvs = rv + 2048; LAS int* cds = (LAS int*)(rv + 2064);
    const int t0 = tg * 256 + wave * 32;
#pragma unroll 1
    for (int p = 0; p < 2; ++p) {
        bf16x8 kb[8][4];
#pragma unroll
        for (int nt = 0; nt < 8; ++nt)
#pragma unroll
            for (int ks = 0; ks < 4; ++ks) kb[nt][ks] = *(const bf16x8*)(KEYS + (size_t)(p * 128 + 16 * nt + lr) * 128 + 32 * ks + 8 * lg);
#pragma unroll 1
        for (int bt = 0; bt < 2; ++bt) {
            bf16x8 qa[4];
#pragma unroll
            for (int ks = 0; ks < 4; ++ks) qa[ks] = *(const bf16x8*)(QP + (size_t)(t0 + 16 * bt + lr) * 2048 + h * 256 + p * 128 + 32 * ks + 8 * lg);
            f32x4 acc[8];
#pragma unroll
            for (int nt = 0; nt < 8; ++nt) { acc[nt] = (f32x4){0.f, 0.f, 0.f, 0.f};
#pragma unroll
                for (int ks = 0; ks < 4; ++ks) acc[nt] = __builtin_amdgcn_mfma_f32_16x16x32_bf16(qa[ks], kb[nt][ks], acc[nt], 0, 0, 0); }
#pragma unroll
            for (int nt = 0; nt < 8; ++nt)
#pragma unroll
                for (int r = 0; r < 4; ++r) sc[(4 * lg + r) * 132 + 16 * nt + lr] = acc[nt][r];
#pragma unroll 1
            for (int tk = 0; tk < 16; ++tk) {
                const float a0 = sc[tk * 132 + lane], a1 = sc[tk * 132 + 64 + lane]; const unsigned k0 = fkey(a0), k1 = fkey(a1); unsigned thr = 0u;
                for (int bit = 31; bit >= 0; --bit) { const unsigned cd = thr | (1u << bit);
                    const int cnt = __popcll(__ballot(k0 >= cd)) + __popcll(__ballot(k1 >= cd));
                    if (cnt >= 16) { thr = cd; if (cnt == 16) break; } }
                const unsigned long long b0 = __ballot(k0 >= thr), b1 = __ballot(k1 >= thr);
                const int s0 = __builtin_amdgcn_mbcnt_hi((unsigned)(b0 >> 32), __builtin_amdgcn_mbcnt_lo((unsigned)b0, 0u));
                const int s1 = __popcll(b0) + __builtin_amdgcn_mbcnt_hi((unsigned)(b1 >> 32), __builtin_amdgcn_mbcnt_lo((unsigned)b1, 0u));
                const int ro = (p * 32 + 16 * bt + tk) * 16;
                if (k0 >= thr && s0 < 16) { rv[ro + s0] = a0; ri[ro + s0] = lane; }
                if (k1 >= thr && s1 < 16) { rv[ro + s1] = a1; ri[ro + s1] = lane + 64; } }
        }
    }
#pragma unroll 1
    for (int tk = 0; tk < 32; ++tk) {
        const int t = t0 + tk; const LAS float* sv0 = rv + tk * 16; const LAS float* sv1 = rv + (32 + tk) * 16;
        float cand[4]; unsigned ck[4];
        {   const float s0 = sv0[lane >> 2]; const f32x4 s1 = *(const LAS f32x4*)(sv1 + (lane & 3) * 4);
            cand[0] = s0 + s1.x; cand[1] = s0 + s1.y; cand[2] = s0 + s1.z; cand[3] = s0 + s1.w;
#pragma unroll
            for (int m = 0; m < 4; ++m) ck[m] = fkey(cand[m]); }
        {   unsigned thr = 0u;
            for (int bit = 31; bit >= 0; --bit) { const unsigned cd = thr | (1u << bit);
                const int cnt = (__popcll(__ballot(ck[0] >= cd)) + __popcll(__ballot(ck[1] >= cd))) + (__popcll(__ballot(ck[2] >= cd)) + __popcll(__ballot(ck[3] >= cd)));
                if (cnt >= 16) { thr = cd; if (cnt == 16) break; } }
            int base = 0;
#pragma unroll
            for (int m = 0; m < 4; ++m) { const unsigned long long bm = __ballot(ck[m] >= thr);
                const int sl = base + __builtin_amdgcn_mbcnt_hi((unsigned)(bm >> 32), __builtin_amdgcn_mbcnt_lo((unsigned)bm, 0u));
                if (ck[m] >= thr && sl < 16) { fvs[sl] = cand[m]; cds[sl] = lane * 4 + m; }
                base += __popcll(bm); } }
        {   const float fv = (lane < 16) ? fvs[lane] : -3.0e38f; const int code = (lane < 16) ? cds[lane] : 0;
            const float mx = row16_max(fv); const float e = (lane < 16) ? __expf(fv - mx) : 0.f; const float sum = row16_sum(e);
            if (lane < 16) { const int e0 = ri[tk * 16 + (code >> 4)], e1 = ri[(32 + tk) * 16 + (code & 15)];
                EIDX[((size_t)t * 8 + h) * 16 + lane] = e0 * 128 + e1; EGATE[((size_t)t * 8 + h) * 16 + lane] = e / sum; } }
    }
}

__device__ __forceinline__ float wave_sum_u(float x) {
    x = row16_sum(x); const int xi = __float_as_int(x);
    return (__int_as_float(__builtin_amdgcn_readlane(xi, 0)) + __int_as_float(__builtin_amdgcn_readlane(xi, 16))) + (__int_as_float(__builtin_amdgcn_readlane(xi, 32)) + __int_as_float(__builtin_amdgcn_readlane(xi, 48)));
}
template <int FMT> struct RowQ { u32x4 a; u32x2 b; };
template <int FMT> __device__ __forceinline__ constexpr int rowq_elem(int j) { return (FMT == 6 && FP6_INTERLEAVED) ? ((j & 1) ? 16 + (j >> 1) : (j >> 1)) : j; }
template <int FMT> __device__ __forceinline__ void rowq_load(RowQ<FMT>& q, const unsigned char* tab, int eid, int lane) {
    if (FMT == 6) { const unsigned char* row = tab + (size_t)eid * 1536; q.a = *(const u32x4*)(row + 16 * lane); q.b = *(const u32x2*)(row + 1024 + 8 * lane); }
    else { q.a = *(const u32x4*)(tab + (size_t)eid * 1024 + 16 * lane); }
}
template <int FMT> __device__ __forceinline__ void rowq_deq(const RowQ<FMT>& q, f32x2 (&o)[16]) {
    if (FMT == 6) { const u32x6 s = (u32x6){q.a[0], q.a[1], q.a[2], q.a[3], q.b[0], q.b[1]}; const f32x32 r = __builtin_amdgcn_cvt_scalef32_pk32_f32_fp6(s, 1.0f);
#pragma unroll
        for (int k = 0; k < 16; ++k) o[k] = (f32x2){r[2 * k], r[2 * k + 1]}; }
    else {
#pragma unroll
        for (int d = 0; d < 4; ++d) { o[4 * d] = __builtin_amdgcn_cvt_scalef32_pk_f32_fp4(q.a[d], 1.0f, 0); o[4 * d + 1] = __builtin_amdgcn_cvt_scalef32_pk_f32_fp4(q.a[d], 1.0f, 1);
            o[4 * d + 2] = __builtin_amdgcn_cvt_scalef32_pk_f32_fp4(q.a[d], 1.0f, 2); o[4 * d + 3] = __builtin_amdgcn_cvt_scalef32_pk_f32_fp4(q.a[d], 1.0f, 3); } }
}
template <int FMT, int DIAG = 0>
__device__ __forceinline__ void phase_experts(const Frame& F, CP P, int layer, const float* gnext, float* X) {
    const bf16_t* XN = (const bf16_t*)(P->ws + WS_XN); bf16_t* XNo = (bf16_t*)(P->ws + WS_XN);
    const unsigned char* UT = P->ws + WS_UT + (size_t)layer * 32 * MiB; const unsigned char* VT = P->ws + WS_VT + (size_t)layer * 32 * MiB;
    const float* SCU = (const float*)(P->ws + WS_SCALE) + layer * 16384; const float* SCV = SCU + 32768;
    const int* EIDX = (const int*)(P->ws + WS_EIDX); const float* EGATE = (const float*)(P->ws + WS_EGATE);
    const int lane = F.lane;
    for (int t = F.gw; t < M_TOK; t += F.NGW) {
        f32x2 hx[16];
        {   float hn[32];
#pragma unroll
            for (int j = 0; j < 8; ++j) { const u32x2 w = *(const u32x2*)(XN + (size_t)t * DM + 256 * j + 4 * lane); hn[4 * j] = bf_lo(w.x); hn[4 * j + 1] = bf_hi(w.x); hn[4 * j + 2] = bf_lo(w.y); hn[4 * j + 3] = bf_hi(w.y); }
#pragma unroll
            for (int k = 0; k < 16; ++k) hx[k] = (f32x2){hn[rowq_elem<FMT>(2 * k)], hn[rowq_elem<FMT>(2 * k + 1)]}; }
        int i0 = EIDX[(size_t)t * 128 + lane], i1 = EIDX[(size_t)t * 128 + 64 + lane]; if (DIAG == 2) { i0 &= 255; i1 &= 255; }
        const float g0 = EGATE[(size_t)t * 128 + lane], g1 = EGATE[(size_t)t * 128 + 64 + lane];
        float a0 = 0.f, a1 = 0.f;
        const float sc0 = SCU[i0], sc1 = SCU[i1];
#pragma unroll
        for (int half = 0; half < 2; ++half) {
            const int iv = half ? i1 : i0;
            for (int e8 = 0; e8 < 64; e8 += 8) {
                RowQ<FMT> ld[8];
#pragma unroll
                for (int x = 0; x < 8; ++x) { const int eid = __builtin_amdgcn_readlane(iv, e8 + x); rowq_load<FMT>(ld[x], UT, eid, lane); }
                float pv = 0.f;
#pragma unroll
                for (int x = 0; x < 8; ++x) { f32x2 r[16]; rowq_deq<FMT>(ld[x], r); f32x2 s2 = r[0] * hx[0];
#pragma unroll
                    for (int k = 1; k < 16; ++k) s2 = r[k] * hx[k] + s2;
                    const float r16 = row16_sum(s2.x + s2.y); pv = ((lane & 15) == ((e8 + x) & 15)) ? r16 : pv; }
                pv += __shfl_xor(pv, 16); pv += __shfl_xor(pv, 32);
                const float act = gelu1(pv * (half ? sc1 : sc0)) * (half ? g1 : g0);
                if (lane >= e8 && lane < e8 + 8) { if (half) a1 = act; else a0 = act; }
            }
        }
        f32x2 out2[16];
#pragma unroll
        for (int k = 0; k < 16; ++k) out2[k] = (f32x2){0.f, 0.f};
#pragma unroll
        for (int half = 0; half < 2; ++half) {
            const int iv = half ? i1 : i0; const float av = half ? a1 * SCV[i1] : a0 * SCV[i0];
            for (int e8 = 0; e8 < 64; e8 += 8) {
                RowQ<FMT> ld[8]; float ac[8];
#pragma unroll
                for (int x = 0; x < 8; ++x) { const int eid = __builtin_amdgcn_readlane(iv, e8 + x); rowq_load<FMT>(ld[x], VT, eid, lane);
                    ac[x] = __int_as_float(__builtin_amdgcn_readlane(__float_as_int(av), e8 + x)); }
#pragma unroll
                for (int x = 0; x < 8; ++x) { f32x2 r[16]; rowq_deq<FMT>(ld[x], r); const f32x2 a2 = (f32x2){ac[x], ac[x]};
#pragma unroll
                    for (int k = 0; k < 16; ++k) out2[k] = a2 * r[k] + out2[k]; }
            }
        }
        float out[32];
#pragma unroll
        for (int k = 0; k < 16; ++k) { out[rowq_elem<FMT>(2 * k)] = out2[k].x; out[rowq_elem<FMT>(2 * k + 1)] = out2[k].y; }
        float* xr = X + (size_t)t * DM + 4 * lane; float ss = 0.f;
#pragma unroll
        for (int k = 0; k < 8; ++k) { f32x4 a = *(const f32x4*)(xr + 256 * k);
            a.x += out[4 * k + 0]; a.y += out[4 * k + 1]; a.z += out[4 * k + 2]; a.w += out[4 * k + 3];
            *(f32x4*)(xr + 256 * k) = a;
            out[4 * k + 0] = a.x; out[4 * k + 1] = a.y; out[4 * k + 2] = a.z; out[4 * k + 3] = a.w;
            ss += (a.x * a.x + a.y * a.y) + (a.z * a.z + a.w * a.w); }
        if (gnext) { const float rstd = rsqrtf(wave_sum(ss) * (1.0f / DM) + 1e-6f);
#pragma unroll
            for (int k = 0; k < 8; ++k) { const f32x4 g4 = *(const f32x4*)(gnext + 256 * k + 4 * lane);
                *(u32x2*)(XNo + (size_t)t * DM + 256 * k + 4 * lane) = (u32x2){pkbf(out[4 * k] * rstd * g4.x, out[4 * k + 1] * rstd * g4.y), pkbf(out[4 * k + 2] * rstd * g4.z, out[4 * k + 3] * rstd * g4.w)}; } }
    }
}

__device__ __forceinline__ void phase_qknorm(const Frame& F, CP P) {
    bf16_t* QKV = (bf16_t*)(P->ws + WS_QKV); const f32x2* rope = (const f32x2*)(P->ws + WS_ROPE);
    const float* qn = P->in[21]; const float* kn = P->in[22]; const int lane = F.lane, d0 = 8 * (lane & 7), sub = lane & 7;
    for (int t = F.gw; t < M_TOK; t += F.NGW) {
        const int pos = t & (SEQ - 1);
#pragma unroll
        for (int j = 0; j < 8; ++j) {
            bf16_t* p = QKV + (size_t)t * C_COLS + 512 * j + 8 * lane; float v[8]; unpack8(*(const u32x4*)p, v);
            float ss = 0.f;
#pragma unroll
            for (int i = 0; i < 8; ++i) ss += v[i] * v[i];
            ss = oct_sum(ss); const float rstd = rsqrtf(ss * (1.0f / 64.0f) + 1e-6f);
            const float* wn = (j < 4) ? qn : kn; const f32x4 w0 = *(const f32x4*)(wn + d0), w1 = *(const f32x4*)(wn + d0 + 4);
            const float ww[8] = {w0.x, w0.y, w0.z, w0.w, w1.x, w1.y, w1.z, w1.w};
#pragma unroll
            for (int i = 0; i < 8; ++i) v[i] = v[i] * rstd * ww[i];
            float o[8];
#pragma unroll
            for (int i = 0; i < 8; ++i) { const float pr = dpp_mov<0xB1>(v[i]); const f32x2 cs = rope[pos * 8 + i];
                const float rot = (sub == 0) ? (v[i] * cs.x - pr * cs.y) : (v[i] * cs.x + pr * cs.y);
                o[i] = (sub < 2) ? rot : v[i]; }
            if (j < 4) {
#pragma unroll
                for (int i = 0; i < 8; ++i) o[i] *= QSCALE; }
            *(u32x4*)p = pack8(o);
        }
    }
}

constexpr int AT_KB = 9216, AT_BUF = 38912;
__device__ __forceinline__ float max3f(float a, float b, float c) { return __builtin_fmaxf(__builtin_fmaxf(a, b), c); }
template <int VAR>
__device__ __forceinline__ void attn_tile(LAS unsigned char* buf, int kv0, int q0w, int map, int lane, int q31, int hh, int qpos, bool first, const bf16x8 (&qf)[4],
                                          f32x16 (&O)[4], f32x16& negm, float& mref, float& lsum, LAS float* wsc) {
    LAS unsigned char* Kb = buf + map * AT_KB;
    f32x16 p0 = negm, p1 = negm;
#pragma unroll
    for (int ks = 0; ks < 4; ++ks) {
        const bf16x8 a0 = *(LAS bf16x8*)(Kb + q31 * 144 + ks * 32 + hh * 16);
        const bf16x8 a1 = *(LAS bf16x8*)(Kb + (32 + q31) * 144 + ks * 32 + hh * 16);
        if (VAR != 3) { p0 = __builtin_amdgcn_mfma_f32_32x32x16_bf16(a0, qf[ks], p0, 0, 0, 0);
        p1 = __builtin_amdgcn_mfma_f32_32x32x16_bf16(a1, qf[ks], p1, 0, 0, 0); } else { p0[ks] += __builtin_bit_cast(float, (int)a0[0]) ; p1[ks] += __builtin_bit_cast(float, (int)a1[1]); }
    }
    if (kv0 + 63 > q0w) {
#pragma unroll
        for (int r = 0; r < 16; ++r) { const int kv = kv0 + crow(r, hh); if (kv > qpos) p0[r] = -1.0e30f; if (kv + 32 > qpos) p1[r] = -1.0e30f; } }
    if (VAR != 2) {
    float ma = max3f(p0[0], p0[1], p1[0]), mb = max3f(p0[2], p0[3], p1[1]); ma = max3f(ma, p1[2], p1[3]);
#pragma unroll
    for (int r = 4; r < 16; r += 4) { ma = max3f(ma, p0[r], p0[r + 1]); mb = max3f(mb, p0[r + 2], p0[r + 3]); ma = max3f(ma, p1[r], p1[r + 1]); mb = max3f(mb, p1[r + 2], p1[r + 3]); }
    float mx = __builtin_fmaxf(ma, mb);
    {   const auto rr = __builtin_amdgcn_permlane32_swap(__float_as_uint(mx), __float_as_uint(mx), false, false); mx = __builtin_fmaxf(__uint_as_float(rr[0]), __uint_as_float(rr[1])); }
    if (first || __any(mx > 0.f)) {
        const float dl = first ? mx : __builtin_fmaxf(mx, 0.f); mref += dl;
#pragma unroll
        for (int r = 0; r < 16; ++r) { p0[r] -= dl; p1[r] -= dl; negm[r] = -mref; }
        if (first) lsum = 0.f;
        else { const float alpha = __builtin_amdgcn_exp2f(-dl); lsum *= alpha;
            if (hh == 0) wsc[q31] = alpha;
#pragma unroll
            for (int g = 0; g < 4; ++g) { const f32x4 al = *(LAS f32x4*)(wsc + 8 * g + 4 * hh);
#pragma unroll
                for (int d = 0; d < 4; ++d) { O[d][4 * g + 0] *= al.x; O[d][4 * g + 1] *= al.y; O[d][4 * g + 2] *= al.z; O[d][4 * g + 3] *= al.w; } } }
    }
    float ps0 = 0.f, ps1 = 0.f;
#pragma unroll
    for (int r = 0; r < 16; ++r) { p0[r] = __builtin_amdgcn_exp2f(p0[r]); p1[r] = __builtin_amdgcn_exp2f(p1[r]); ps0 += p0[r]; ps1 += p1[r]; }
    lsum += ps0 + ps1;
    }
    bf16x8 pa[4];
#pragma unroll
    for (int s = 0; s < 2; ++s) {
        u32x4 w0, w1;
        w0.x = pkbf(p0[8 * s + 0], p0[8 * s + 1]); w0.y = pkbf(p0[8 * s + 2], p0[8 * s + 3]); w0.z = pkbf(p0[8 * s + 4], p0[8 * s + 5]); w0.w = pkbf(p0[8 * s + 6], p0[8 * s + 7]);
        w1.x = pkbf(p1[8 * s + 0], p1[8 * s + 1]); w1.y = pkbf(p1[8 * s + 2], p1[8 * s + 3]); w1.z = pkbf(p1[8 * s + 4], p1[8 * s + 5]); w1.w = pkbf(p1[8 * s + 6], p1[8 * s + 7]);
        pa[s] = __builtin_bit_cast(bf16x8, w0); pa[2 + s] = __builtin_bit_cast(bf16x8, w1); }
    LAS unsigned char* Vb = buf + 2 * AT_KB + (4 * hh + ((lane >> 2) & 3)) * 320 + (16 * ((lane >> 4) & 1) + 4 * (lane & 3)) * 2;
#pragma unroll
    for (int kst = 0; kst < 4; ++kst)
#pragma unroll
        for (int d = 0; d < 4; ++d) {
            if (VAR == 1) { O[d][kst] += __builtin_bit_cast(float, (int)pa[kst][d]); continue; }
            const s16x4 lo = vtr(Vb + (16 * kst) * 320 + d * 64), hi = vtr(Vb + (16 * kst + 8) * 320 + d * 64);
            const bf16x8 vf = (bf16x8){lo[0], lo[1], lo[2], lo[3], hi[0], hi[1], hi[2], hi[3]};
            O[d] = __builtin_amdgcn_mfma_f32_32x32x16_bf16(pa[kst], vf, O[d], 0, 0, 0);
        }
}
template <int VAR = 0>
__device__ __forceinline__ void attn_unit(const Frame& F, CP P, int bh, int qb, float lam) {
    const int tid = F.tid, wave = F.wave, lane = F.lane, map = wave >> 2, wq = wave & 3, q31 = lane & 31, hh = lane >> 5;
    const int b = bh >> 4, h = bh & 15, q0 = qb * 128;
    const bf16_t* QKV = (const bf16_t*)(P->ws + WS_QKV) + (size_t)b * SEQ * C_COLS; bf16_t* OB = (bf16_t*)(P->ws + (VAR ? WS_PA : WS_OB));
    const float* subln = P->in[27];
    LAS unsigned char* lds = F.lds; LAS float* wsc = (LAS float*)(lds + 2 * AT_BUF) + wave * 32;
    bf16x8 qf[4];
    {   const bf16_t* qp = QKV + (size_t)(q0 + 32 * wq + q31) * C_COLS + h * 128 + map * 64 + 8 * hh;
#pragma unroll
        for (int ks = 0; ks < 4; ++ks) qf[ks] = *(const bf16x8*)(qp + 16 * ks); }
    const int NT = 2 * qb + 2;
    const int krow = tid >> 3, kc8 = tid & 7;
    const unsigned koff = (unsigned)((krow * C_COLS + 2048 + h * 128 + kc8 * 8) * 2), voff = (unsigned)(((tid >> 4) * C_COLS + 4096 + h * 128 + (tid & 15) * 8) * 2);
    const unsigned char* qkvb = (const unsigned char*)QKV;
    const int kdst = krow * 144 + kc8 * 16, vdst = 2 * AT_KB + (tid >> 4) * 320 + (tid & 15) * 16;
    u32x4 pfA[4], pfB[4];
#define AT_LOAD(pf, tt) do { const unsigned char* tb = qkvb + (size_t)(tt) * (64 * C_COLS * 2); pf[0] = *(const u32x4*)(tb + koff); pf[1] = *(const u32x4*)(tb + koff + 128); \
        pf[2] = *(const u32x4*)(tb + voff); pf[3] = *(const u32x4*)(tb + voff + 32 * C_COLS * 2); } while (0)
#define AT_STORE(pf, bufp) do { *(LAS u32x4*)((bufp) + kdst) = pf[0]; *(LAS u32x4*)((bufp) + AT_KB + kdst) = pf[1]; *(LAS u32x4*)((bufp) + vdst) = pf[2]; *(LAS u32x4*)((bufp) + vdst + 32 * 320) = pf[3]; } while (0)
    AT_LOAD(pfA, 0); AT_LOAD(pfB, 1); AT_STORE(pfA, lds); __syncthreads();
    asm volatile("" :: "v"(qf[0]), "v"(qf[1]), "v"(qf[2]), "v"(qf[3]));
    f32x16 O[4];
#pragma unroll
    for (int d = 0; d < 4; ++d)
#pragma unroll
        for (int r = 0; r < 16; ++r) O[d][r] = 0.f;
    float mrow = 0.f, lsum = 0.f; f32x16 negm;
#pragma unroll
    for (int r = 0; r < 16; ++r) negm[r] = 0.f;
    const int qpos = q0 + 32 * wq + q31, q0w = q0 + 32 * wq;
    for (int tt = 0; tt < NT; tt += 2) {
        if (VAR != 4 && tt + 2 < NT) AT_LOAD(pfA, tt + 2);
        if (tt * 64 <= q0w + 31) attn_tile<VAR>(lds, tt * 64, q0w, map, lane, q31, hh, qpos, tt == 0, qf, O, negm, mrow, lsum, wsc);
        if (VAR != 4) AT_STORE(pfB, lds + AT_BUF);
        __syncthreads();
        if (VAR != 4 && tt + 3 < NT) AT_LOAD(pfB, tt + 3);
        if ((tt + 1) * 64 <= q0w + 31) attn_tile<VAR>(lds + AT_BUF, (tt + 1) * 64, q0w, map, lane, q31, hh, qpos, false, qf, O, negm, mrow, lsum, wsc);
        if (VAR != 4 && tt + 2 < NT) AT_STORE(pfA, lds);
        __syncthreads();
    }
#undef AT_LOAD
#undef AT_STORE
    {   const float lt = lsum + __shfl_xor(lsum, 32); if (hh == 0) wsc[q31] = 1.0f / lt;
#pragma unroll
        for (int g = 0; g < 4; ++g) { const f32x4 al = *(LAS f32x4*)(wsc + 8 * g + 4 * hh);
#pragma unroll
            for (int d = 0; d < 4; ++d) { O[d][4 * g + 0] *= al.x; O[d][4 * g + 1] *= al.y; O[d][4 * g + 2] *= al.z; O[d][4 * g + 3] *= al.w; } } }
    LAS float* xch = (LAS float*)lds;
    if (map == 1) {
#pragma unroll
        for (int d = 0; d < 4; ++d)
#pragma unroll
            for (int r = 0; r < 16; ++r) xch[(wq * 64 + d * 16 + r) * 64 + lane] = O[d][r]; }
    __syncthreads();
    if (map == 0) {
        float ss[16];
#pragma unroll
        for (int r = 0; r < 16; ++r) ss[r] = 0.f;
#pragma unroll
        for (int d = 0; d < 4; ++d)
#pragma unroll
            for (int r = 0; r < 16; ++r) { const float o = O[d][r] - lam * xch[(wq * 64 + d * 16 + r) * 64 + lane]; O[d][r] = o; ss[r] += o * o; }
        float sl[4];
#pragma unroll
        for (int d = 0; d < 4; ++d) sl[d] = subln[d * 32 + q31];
#pragma unroll
        for (int r = 0; r < 16; ++r) { float s = row16_sum(ss[r]); s += __shfl_xor(s, 16); const float rs = rsqrtf(s * (1.0f / 128.0f) + 1e-5f) * (1.0f - LAMBDA_INIT);
            const size_t tok = (size_t)b * SEQ + q0 + 32 * wq + crow(r, hh);
#pragma unroll
            for (int d = 0; d < 4; ++d) OB[tok * DM + h * 128 + d * 32 + q31] = (bf16_t)(pkbf(O[d][r] * rs * sl[d], 0.f) & 0xffffu); }
    }
    __syncthreads();
}

constexpr int CK_C = 32;
constexpr size_t WS_PHI = 132 * MiB  , WS_RP = 260 * MiB  , WS_Y0T = 292 * MiB  , WS_PSI = 676 * MiB  ;
constexpr int CP_SZ = 67584;
constexpr int CP_RT = 0, CP_AT = 4608, CP_BT = 9216, CP_KT = 13824, CP_WTT = 4608  , CP_U0T = 9728  ;
constexpr int CP_ATT = 18432, CP_BHT = 23552, CP_KHT = 28672, CP_VT = 33792, CP_AKVT = 38912;
constexpr int CP_PW = 44032  , CP_X = 54272  , CP_AAK = 59392, CP_ARB = 61952, CP_ARK = 64512, CP_D = 44032  , CP_GC = 67072  ;
__device__ __forceinline__ int ck_pos(int j) { return (j >> 5) * 32 + ((j >> 2) & 3) * 8 + ((j >> 4) & 1) * 4 + (j & 3); }
__device__ __forceinline__ f32x16 ck_mm(f32x16 acc, const LAS unsigned char* A, int pa, const LAS unsigned char* Bt, int pb, int nks, int lane) {
    const LAS unsigned char* ap = A + (lane & 31) * pa + (lane >> 5) * 16; const LAS unsigned char* bp = Bt + (lane & 31) * pb + (lane >> 5) * 16;
    for (int ks = 0; ks < nks; ++ks) acc = __builtin_amdgcn_mfma_f32_32x32x16_bf16(*(const LAS bf16x8*)(ap + ks * 32), *(const LAS bf16x8*)(bp + ks * 32), acc, 0, 0, 0);
    return acc;
}
__device__ __forceinline__ f32x16 ck_zero() { f32x16 z; for (int r = 0; r < 16; ++r) z[r] = 0.f; return z; }
__device__ __forceinline__ void ck_st(LAS unsigned char* dst, int pitch, const f32x16& a, int lane) {
    const int col = lane & 31, hh = lane >> 5;
#pragma unroll
    for (int r = 0; r < 16; ++r) *(LAS bf16_t*)(dst + crow(r, hh) * pitch + col * 2) = (bf16_t)(pkbf_c(a[r], 0.f) & 0xffffu);
}
__device__ __forceinline__ void ck_stT(LAS unsigned char* dst, int pitch, const f32x16& a, int lane) {
    const int col = lane & 31, hh = lane >> 5;
#pragma unroll
    for (int g = 0; g < 4; ++g) *(LAS u32x2*)(dst + col * pitch + (8 * g + 4 * hh) * 2) = (u32x2){pkbf_c(a[4 * g], a[4 * g + 1]), pkbf_c(a[4 * g + 2], a[4 * g + 3])};
}
__device__ __forceinline__ void ck_bar() { asm volatile("s_waitcnt lgkmcnt(0)" ::: "memory"); __syncthreads(); }

__device__ __forceinline__ void chunk_prep_fetch(CP P, int pair, int wave, int tid, u32x4 (&raw)[8]) {
    const int hf = wave >> 2, htid = tid & 255, item = 2 * pair + hf, bh = item >> 7, cc = item & 127, t = htid >> 3, j8 = (htid & 7) * 8, tt = cc * 32 + t, hc = (bh & 15) * 64 + j8;
    const size_t tg = (size_t)(bh >> 4) * SEQ + tt; const bf16_t* row = (const bf16_t*)(P->ws + WS_PA) + tg * A_COLS + hc; const u32x4 z4 = (u32x4){0u, 0u, 0u, 0u};
    raw[0] = *(const u32x4*)row; raw[1] = *(const u32x4*)(row + 1024); raw[2] = *(const u32x4*)(row + 2048);
    raw[3] = tt ? *(const u32x4*)(row - A_COLS) : z4; raw[4] = tt ? *(const u32x4*)(row - A_COLS + 1024) : z4; raw[5] = tt ? *(const u32x4*)(row - A_COLS + 2048) : z4;
    raw[6] = *(const u32x4*)((const bf16_t*)(P->ws + WS_ICLR) + tg * 1024 + hc); raw[7] = *(const u32x4*)((const bf16_t*)(P->ws + WS_DLOG) + tg * 1024 + hc);
}
constexpr int CP_PAR = 2 * CP_SZ;
template <int ABL = 0>
__device__ __forceinline__ void chunk_prep_pair(const Frame& F, CP P, int pair, int next_pair, u32x4 (&raw)[8]) {
    const int hf = F.wave >> 2, hw = F.wave & 3, htid = F.tid & 255, lane = F.lane; const int item = 2 * pair + hf;
    f32x4 qrow[8]; const int qr0 = (pair * 8 + F.wave) * 2; quant_load(P, qr0, lane, qrow);
    LAS unsigned char* L = F.lds + hf * CP_SZ;
    const int bh = item >> 7, cc = item & 127, bb_ = bh >> 4, hd = bh & 15;
    bf16_t* PHI = (bf16_t*)(P->ws + WS_PHI) + (size_t)item * 4096; bf16_t* RPo = (bf16_t*)(P->ws + WS_RP) + (size_t)item * 2048;
    bf16_t* Y0T = (bf16_t*)(P->ws + WS_Y0T) + (size_t)item * 2048; bf16_t* PSI = (bf16_t*)(P->ws + WS_PSI) + (size_t)item * 4096;
    {   const int t = htid >> 3, j8 = (htid & 7) * 8, tt = cc * 32 + t; const size_t tg = (size_t)bb_ * SEQ + tt;
        float rr[8], dd[8], kf[8], vv[8], kq[8], bb[8], tp[8];
        const LAS float* par = (const LAS float*)(F.lds + CP_PAR) + j8; float pp[8];
#define CK_PAR(a_) do { const f32x4 x_ = *(const LAS f32x4*)(par + (a_) * 64), y_ = *(const LAS f32x4*)(par + (a_) * 64 + 4); pp[0] = x_.x; pp[1] = x_.y; pp[2] = x_.z; pp[3] = x_.w; pp[4] = y_.x; pp[5] = y_.y; pp[6] = y_.z; pp[7] = y_.w; } while (0)
#define CK_SHIFT(x, ri) do { unpack8(raw[ri], x); unpack8(raw[(ri) + 3], tp); CK_PAR(ri); _Pragma("unroll") for (int i = 0; i < 8; ++i) x[i] += (tp[i] - x[i]) * pp[i]; } while (0)
        CK_SHIFT(rr, 0); CK_SHIFT(kf, 1); CK_SHIFT(vv, 2);
        float ic[8]; unpack8(raw[6], ic); unpack8(raw[7], dd);
        if (next_pair >= 0) chunk_prep_fetch(P, next_pair, F.wave, F.tid, raw);
        float ss_ = 0.f;
        CK_PAR(3);
#pragma unroll
        for (int i = 0; i < 8; ++i) { kq[i] = kf[i] * pp[i]; ss_ += kq[i] * kq[i]; }
        ss_ = oct_sum(ss_); const float rn_ = rsqrtf(fmaxf(ss_, 1e-12f));
        CK_PAR(4);
#pragma unroll
        for (int i = 0; i < 8; ++i) { kq[i] *= rn_; kf[i] = kf[i] * (1.0f + (ic[i] - 1.0f) * pp[i]); bb[i] = kq[i] * ic[i]; }
        float bs_ = 0.f;
        CK_PAR(5);
#pragma unroll
        for (int i = 0; i < 8; ++i) bs_ += rr[i] * kf[i] * pp[i];
        bs_ = oct_sum(bs_);
        if ((htid & 7) == 0) ((float*)(P->ws + WS_BONUS))[tg * 16 + hd] = bs_;
#undef CK_SHIFT
#undef CK_PAR
        *(LAS f32x4*)(L + CP_D + (t * 64 + j8) * 4) = (f32x4){dd[0], dd[1], dd[2], dd[3]}; *(LAS f32x4*)(L + CP_D + (t * 64 + j8 + 4) * 4) = (f32x4){dd[4], dd[5], dd[6], dd[7]};
        ck_bar();
        f32x4 a0 = (f32x4){0.f, 0.f, 0.f, 0.f}, a1 = a0, m0 = a0, m1 = a0, t0 = a0, t1 = a0;
        for (int s = 0; s < CK_C; ++s) { if (s == t) { m0 = a0; m1 = a1; } a0 += *(const LAS f32x4*)(L + CP_D + (s * 64 + j8) * 4); a1 += *(const LAS f32x4*)(L + CP_D + (s * 64 + j8 + 4) * 4); if (s == t) { t0 = a0; t1 = a1; } }
        const float Dm1[8] = {m0[0], m0[1], m0[2], m0[3], m1[0], m1[1], m1[2], m1[3]}, Dt[8] = {t0[0], t0[1], t0[2], t0[3], t1[0], t1[1], t1[2], t1[3]}, DC[8] = {a0[0], a0[1], a0[2], a0[3], a1[0], a1[1], a1[2], a1[3]};
        ck_bar();
        float at[8], rt[8], bt[8], kt[8], bh[8], kh[8];
#pragma unroll
        for (int q = 0; q < 8; ++q) { const float em1 = __expf(-Dm1[q]), e0 = __expf(-Dt[q]), ep = __expf(Dt[q]), ec = __expf(Dt[q] - DC[q]);
            at[q] = -kq[q] * em1; rt[q] = rr[q] * e0; bt[q] = bb[q] * ep; kt[q] = kf[q] * ep; bh[q] = bb[q] * ec; kh[q] = kf[q] * ec; }
        *(LAS u32x4*)(L + CP_AT + t * 144 + j8 * 2) = (u32x4){pkbf(at[0], at[1]), pkbf(at[2], at[3]), pkbf(at[4], at[5]), pkbf(at[6], at[7])};
        *(LAS u32x4*)(L + CP_RT + t * 144 + j8 * 2) = (u32x4){pkbf(rt[0], rt[1]), pkbf(rt[2], rt[3]), pkbf(rt[4], rt[5]), pkbf(rt[6], rt[7])};
        *(LAS u32x4*)(L + CP_BT + t * 144 + j8 * 2) = (u32x4){pkbf(bt[0], bt[1]), pkbf(bt[2], bt[3]), pkbf(bt[4], bt[5]), pkbf(bt[6], bt[7])};
        *(LAS u32x4*)(L + CP_KT + t * 144 + j8 * 2) = (u32x4){pkbf(kt[0], kt[1]), pkbf(kt[2], kt[3]), pkbf(kt[4], kt[5]), pkbf(kt[6], kt[7])};
#pragma unroll
        for (int q = 0; q < 8; ++q) { const int o = (j8 + q) * 80 + t * 2;
            *(LAS bf16_t*)(L + CP_ATT + o) = (bf16_t)(pkbf(at[q], 0.f) & 0xffffu); *(LAS bf16_t*)(L + CP_BHT + o) = (bf16_t)(pkbf(bh[q], 0.f) & 0xffffu);
            *(LAS bf16_t*)(L + CP_KHT + o) = (bf16_t)(pkbf(kh[q], 0.f) & 0xffffu); *(LAS bf16_t*)(L + CP_VT + o) = (bf16_t)(pkbf(vv[q], 0.f) & 0xffffu);
            if (t == CK_C - 1) *(LAS float*)(L + CP_GC + (j8 + q) * 4) = __expf(-DC[q]); }
    }
    ck_bar();
    if (ABL == 2) { quant_finish(P, qr0, lane, qrow); return; }
    const int col = lane & 31, hh = lane >> 5;
    {   const int pi = hw >> 1, qi = hw & 1;
        f32x16 a = ck_mm(ck_zero(), L + (pi ? CP_RT : CP_AT), 144, L + (qi ? CP_KT : CP_BT), 144, 4, lane);
#pragma unroll
        for (int r = 0; r < 16; ++r) { const int t = crow(r, hh); if (pi == 0 ? (col >= t) : (col > t)) a[r] = 0.f; }
        if (hw == 0) { ck_st(L + CP_PW, 80, a, lane); ck_stT(L + CP_PW + 2560, 80, a, lane);
#pragma unroll
            for (int r = 0; r < 16; ++r) if (crow(r, hh) == col) a[r] += 1.0f;
            ck_st(L + CP_X, 80, a, lane);
            asm volatile("s_waitcnt lgkmcnt(0)" ::: "memory");
            const f32x16 q = ck_mm(ck_zero(), L + CP_PW, 80, L + CP_PW + 2560, 80, 2, lane); ck_st(L + CP_PW + 5120, 80, q, lane); ck_stT(L + CP_PW + 5120 + 2560, 80, q, lane); }
        else ck_st(L + (hw == 1 ? CP_AAK : (hw == 2 ? CP_ARB : CP_ARK)), 80, a, lane);
    }
    quant_finish(P, qr0, lane, qrow); quant_load(P, qr0 + 1, lane, qrow);
    ck_bar();
    for (int r = 2; r <= (ABL == 1 ? 2 : 5); ++r) {
        const LAS unsigned char* pc = L + CP_PW + ((r - 1) & 1) * 5120; LAS unsigned char* pn = L + CP_PW + (r & 1) * 5120;
        if (hw == 0 && r <= 4) { const f32x16 a = ck_mm(ck_zero(), pc, 80, pc + 2560, 80, 2, lane); ck_st(pn, 80, a, lane); ck_stT(pn + 2560, 80, a, lane); }
        if (hw == 1 && r >= 2) {
            const LAS unsigned char* xc = L + CP_X + (r & 1) * 2560; LAS unsigned char* xn = L + CP_X + ((r + 1) & 1) * 2560;
            f32x16 a;
#pragma unroll
            for (int q = 0; q < 16; ++q) a[q] = bf_1(*(const LAS bf16_t*)(xc + crow(q, hh) * 80 + col * 2));
            a = ck_mm(a, xc, 80, pc + 2560, 80, 2, lane); ck_st(xn, 80, a, lane); }
        if (r == 2 && hw >= 2) { const int ih = hw - 2;
            const f32x16 a = ck_mm(ck_zero(), L + CP_AAK, 80, L + CP_VT + ih * 2560, 80, 2, lane); ck_stT(L + CP_AKVT + ih * 2560, 80, a, lane); }
        ck_bar();
    }
    const LAS unsigned char* Tn = L + CP_X;
    if (hw < 2) { const f32x16 a = ck_mm(ck_zero(), Tn, 80, L + CP_ATT + hw * 2560, 80, 2, lane); ck_stT(L + CP_WTT + hw * 2560, 80, a, lane); }
    else { const int ih = hw - 2; const f32x16 a = ck_mm(ck_zero(), Tn, 80, L + CP_AKVT + ih * 2560, 80, 2, lane); ck_stT(L + CP_U0T + ih * 2560, 80, a, lane); }
    ck_bar();
    {   const int jph = hw >> 1, jh = hw & 1;
        f32x16 a = ck_mm(ck_zero(), L + CP_BHT + jph * 2560, 80, L + CP_WTT + jh * 2560, 80, 2, lane);
        const int j = 32 * jh + col; const int pj = ck_pos(j);
#pragma unroll
        for (int r = 0; r < 16; ++r) { const int jp = 32 * jph + crow(r, hh); float x = a[r]; if (jp == j) x += *(const LAS float*)(L + CP_GC + j * 4);
            PHI[jp * 64 + pj] = (bf16_t)(pkbf_c(x, 0.f) & 0xffffu); } }
    {   const int jph = hw >> 1, ih = hw & 1;
        f32x16 a = ck_mm(ck_zero(), L + CP_BHT + jph * 2560, 80, L + CP_U0T + ih * 2560, 80, 2, lane);
        a = ck_mm(a, L + CP_KHT + jph * 2560, 80, L + CP_VT + ih * 2560, 80, 2, lane);
        const int i = 32 * ih + col;
#pragma unroll
        for (int g = 0; g < 4; ++g) *(u32x2*)(PSI + i * 64 + 32 * jph + 8 * g + 4 * hh) = (u32x2){pkbf_c(a[4 * g], a[4 * g + 1]), pkbf_c(a[4 * g + 2], a[4 * g + 3])}; }
    if (hw < 2) { const int jh = hw;
        f32x16 a;
        const int j = 32 * jh + col; const int pj = ck_pos(j);
#pragma unroll
        for (int r = 0; r < 16; ++r) a[r] = bf_1(*(const LAS bf16_t*)(L + CP_RT + crow(r, hh) * 144 + j * 2));
        a = ck_mm(a, L + CP_ARB, 80, L + CP_WTT + jh * 2560, 80, 2, lane);
#pragma unroll
        for (int r = 0; r < 16; ++r) RPo[crow(r, hh) * 64 + pj] = (bf16_t)(pkbf_c(a[r], 0.f) & 0xffffu);
    } else { const int ih = hw - 2;
        f32x16 a = ck_mm(ck_zero(), L + CP_ARB, 80, L + CP_U0T + ih * 2560, 80, 2, lane);
        a = ck_mm(a, L + CP_ARK, 80, L + CP_VT + ih * 2560, 80, 2, lane);
        const int i = 32 * ih + col;
#pragma unroll
        for (int g = 0; g < 4; ++g) *(u32x2*)(Y0T + i * 32 + 8 * g + 4 * hh) = (u32x2){pkbf_c(a[4 * g], a[4 * g + 1]), pkbf_c(a[4 * g + 2], a[4 * g + 3])};
    }
    quant_finish(P, qr0 + 1, lane, qrow);
    ck_bar();
}

typedef float f32x4v __attribute__((ext_vector_type(4)));
__device__ __forceinline__ void chunk_scan_unit4(const Frame& F, CP P, int u, LAS unsigned char* lsf, volatile LAS unsigned* cnt) {
    const int lane = F.lane, T = F.wave, bh = u >> 2, sl = u & 3, b = bh >> 4, h = bh & 15, li = lane & 15, g = lane >> 4;
    const bf16_t* PHI = (const bf16_t*)(P->ws + WS_PHI) + (size_t)bh * 128 * 4096 + (16 * T + li) * 64 + g * 8;
    const bf16_t* PSI = (const bf16_t*)(P->ws + WS_PSI) + (size_t)bh * 128 * 4096 + (16 * sl + li) * 64 + 16 * T + 4 * g;
    const bf16_t* RPi = (const bf16_t*)(P->ws + WS_RP) + (size_t)bh * 128 * 2048 + (16 * (T & 1) + li) * 64 + g * 8;
    const bf16_t* Y0T = (const bf16_t*)(P->ws + WS_Y0T) + (size_t)bh * 128 * 2048 + (16 * sl + li) * 32 + 16 * (T & 1) + 4 * g;
    float* Y = (float*)(P->ws + WS_Y) + (size_t)b * SEQ * 1024 + h * 64 + 16 * sl + li;
    const bool yw = T < 2;
    f32x4v S = (f32x4v){0.f, 0.f, 0.f, 0.f};
    bf16x8 phi[8][2], rp[8][2]; u32x2 psi[8], y0[8];
#define CS_LOAD(k, c) do { phi[k][0] = *(const bf16x8*)(PHI + (size_t)(c) * 4096); phi[k][1] = *(const bf16x8*)(PHI + (size_t)(c) * 4096 + 32); psi[k] = *(const u32x2*)(PSI + (size_t)(c) * 4096); \
        if (yw) { rp[k][0] = *(const bf16x8*)(RPi + (size_t)(c) * 2048); rp[k][1] = *(const bf16x8*)(RPi + (size_t)(c) * 2048 + 32); y0[k] = *(const u32x2*)(Y0T + (size_t)(c) * 2048); } } while (0)
#pragma unroll
    for (int k = 0; k < 8; ++k) CS_LOAD(k, k);
    LAS unsigned char* mine = lsf + (T >> 1) * 1024 + lane * 16 + (T & 1) * 8;
    for (int c0 = 0; c0 < 128; c0 += 8) {
#pragma unroll
        for (int k = 0; k < 8; ++k) { const int c = c0 + k; LAS unsigned char* img = lsf + (c & 1) * 2048;
            *(LAS u32x2*)(mine + (c & 1) * 2048) = (u32x2){pkbf_c(S[0], S[1]), pkbf_c(S[2], S[3])};
            if (lane == 0) __hip_atomic_fetch_add((LAS unsigned*)cnt, 1u, __ATOMIC_RELAXED, __HIP_MEMORY_SCOPE_WORKGROUP);
            const unsigned want = 4u * (unsigned)(c + 1);
            while (*cnt < want) { }
            const bf16x8 sf0 = *(const LAS bf16x8*)(img + lane * 16), sf1 = *(const LAS bf16x8*)(img + 1024 + lane * 16);
            if (yw) { f32x4v a = (f32x4v){bf_lo(y0[k].x), bf_hi(y0[k].x), bf_lo(y0[k].y), bf_hi(y0[k].y)};
                a = __builtin_amdgcn_mfma_f32_16x16x32_bf16(rp[k][0], sf0, a, 0, 0, 0); a = __builtin_amdgcn_mfma_f32_16x16x32_bf16(rp[k][1], sf1, a, 0, 0, 0);
#pragma unroll
                for (int r = 0; r < 4; ++r) Y[(size_t)(c * 32 + 16 * T + 4 * g + r) * 1024] = a[r]; }
            {   f32x4v a = (f32x4v){bf_lo(psi[k].x), bf_hi(psi[k].x), bf_lo(psi[k].y), bf_hi(psi[k].y)};
                a = __builtin_amdgcn_mfma_f32_16x16x32_bf16(phi[k][0], sf0, a, 0, 0, 0); a = __builtin_amdgcn_mfma_f32_16x16x32_bf16(phi[k][1], sf1, a, 0, 0, 0); S = a; }
            if (c + 8 < 128) CS_LOAD(k, c + 8);
        }
    }
#undef CS_LOAD
}
#define XB_TMO      128
#define XB_XCNT(j)  (256  + 64 * (j))
#define XB_XSUB(j)  (1280 + 64 * (j))
#define XB_XGEN(j)  (2304 + 64 * (j))
#define XB_TOP      3328
#define XB_TOPGEN   3392
#define XCD_BAR_WORDS 3456
#define XB_SPIN_CAP (1u << 18)

__device__ __forceinline__ unsigned xb_ld(unsigned* p)              { return __hip_atomic_load(p, __ATOMIC_RELAXED, __HIP_MEMORY_SCOPE_AGENT); }
__device__ __forceinline__ unsigned xb_add(unsigned* p, unsigned v) { return __hip_atomic_fetch_add(p, v, __ATOMIC_RELAXED, __HIP_MEMORY_SCOPE_AGENT); }
__device__ __forceinline__ unsigned xb_xcc_id() { return (unsigned)__builtin_amdgcn_s_getreg((3 << 11) | 20) & 0xFu; }
#define XB_SPIN(cond, bar) do { unsigned _sp = 0; while (cond) { __builtin_amdgcn_s_sleep(1); \
    if ((++_sp & 255u) == 0u) { if (xb_ld(&(bar)[XB_TMO])) break; if (_sp > XB_SPIN_CAP) { atomicAdd(&(bar)[XB_TMO], 1u); break; } } } } while (0)

struct XcdBarrier {
    unsigned* bar; unsigned x;
    volatile LAS unsigned* st;
};

__device__ __forceinline__ XcdBarrier xcd_barrier_post(unsigned* bar, volatile LAS unsigned* st) {
    XcdBarrier b; b.bar = bar; b.x = xb_xcc_id(); b.st = st;
    if (threadIdx.x == 0) (void)xb_add(&bar[XB_XCNT(b.x)], 1u);
    return b;
}
__device__ __forceinline__ void xcd_barrier_complete(unsigned* bar, unsigned x, unsigned& nloc, unsigned& nx) {
    const unsigned G = gridDim.x * gridDim.y * gridDim.z;
    unsigned sum, cnt, mine, sp = 0u;
    for (;;) {
        sum = 0u; cnt = 0u; mine = 0u;
#pragma unroll
        for (unsigned j = 0; j < 16; ++j) { const unsigned c = xb_ld(&bar[XB_XCNT(j)]); sum += c; cnt += (c > 0u) ? 1u : 0u; mine = (j == x) ? c : mine; }
        if (sum == G) break;
        __builtin_amdgcn_s_sleep(1);
        if ((++sp & 255u) == 0u) { if (xb_ld(&bar[XB_TMO])) break; if (sp > XB_SPIN_CAP) { atomicAdd(&bar[XB_TMO], 1u); break; } }
    }
    nloc = mine > 0u ? mine : 1u; nx = cnt > 0u ? cnt : 1u;
}

__device__ __forceinline__ void xcd_barrier(const XcdBarrier& b) {
    asm volatile("s_waitcnt vmcnt(0)" ::: "memory");
    __syncthreads();
    if (threadIdx.x == 0) {
        unsigned* bar = b.bar;
        __builtin_amdgcn_s_waitcnt(0);
        unsigned nloc = b.st[0], nx = b.st[1];
        if (nloc == 0u) { xcd_barrier_complete(bar, b.x, nloc, nx); b.st[0] = nloc; b.st[1] = nx; }
        const unsigned old = xb_add(&bar[XB_XSUB(b.x)], 1u);
        const unsigned gen = old / nloc;
        if (old + 1u == (gen + 1u) * nloc) {
            __builtin_amdgcn_fence(__ATOMIC_RELEASE, "agent");
            asm volatile("s_waitcnt vmcnt(0)" ::: "memory");
            const unsigned og = xb_add(&bar[XB_TOP], 1u);
            const unsigned tg = og / nx;
            if (og + 1u == (tg + 1u) * nx) xb_add(&bar[XB_TOPGEN], 1u);
            else XB_SPIN(xb_ld(&bar[XB_TOPGEN]) == tg, bar);
            __builtin_amdgcn_fence(__ATOMIC_ACQUIRE, "agent");
            xb_add(&bar[XB_XGEN(b.x)], 1u);
            asm volatile("s_waitcnt vmcnt(0)" ::: "memory");
        } else {
            XB_SPIN(xb_ld(&bar[XB_XGEN(b.x)]) == gen, bar);
            __builtin_amdgcn_fence(__ATOMIC_ACQUIRE, "agent");
            asm volatile("s_waitcnt vmcnt(0)" ::: "memory");
        }
    }
    __syncthreads();
}

#ifndef MK_ONE_LAUNCH
#define MK_ONE_LAUNCH 1
#endif
constexpr int N_PHASES = 20;
#ifndef PROBE_REP
#define PROBE_REP (-1)
#endif
#define REPS(k) for (int rep_ = 0; rep_ < ((PROBE_REP == (k)) ? 2 : 1); ++rep_)
struct Args { Ptrs p; int ph_lo, ph_hi; };

__global__ void __launch_bounds__(NTHREADS, 2) fwd_kernel(Args args) {
    extern __shared__ __attribute__((aligned(16))) unsigned char lds_raw[];
    const int tid0 = threadIdx.x;
    const CP P0 = launder((CP)__builtin_amdgcn_kernarg_segment_ptr());
    const int lo = ((const __attribute__((address_space(4))) int*)P0)[70], hi = ((const __attribute__((address_space(4))) int*)P0)[71];
#define PH_BEGIN Frame F; { int t_ = tid0; asm volatile("" : "+v"(t_)); F.lds = (LAS unsigned char*)lds_raw; F.tid = t_; F.lane = t_ & 63; F.wave = __builtin_amdgcn_readfirstlane(t_ >> 6); \
        F.G = gridDim.x; F.bid = blockIdx.x; F.gw = F.bid * NWAVES + F.wave; F.NGW = F.G * NWAVES; } const CP P = launder(P0); unsigned char* const ws = P->ws; bf16_t* const XN = (bf16_t*)(ws + WS_XN); (void)XN;
    cg::grid_group grid = cg::this_grid();
    for (int u = tid0; u < 64; u += NTHREADS) ((LAS unsigned*)((LAS unsigned char*)lds_raw + LDS_BYTES - 256))[u] = 0u;
    __syncthreads();
    const XcdBarrier bar = xcd_barrier_post((unsigned*)(P0->ws + WS_CTL) + 4096, (volatile LAS unsigned*)((LAS unsigned char*)lds_raw + LDS_BYTES - 256) + 8);
#define IN(k) (lo <= (k) && (k) < hi)
#define SEAM(k) do { if (IN(k) && IN((k) + 1)) { if ((k) == 0) grid.sync(); else xcd_barrier(bar); } } while (0)

    if (IN(0)) { PH_BEGIN REPS(0) phase_prologue(F, P); } SEAM(0);
    if (IN(1)) { PH_BEGIN
        pg8::Gemm g{XN, (const bf16_t*)(ws + WS_WT_AB), M_TOK, AB_COLS, DM}; pg8::StaticOrder S; S.init(M_TOK, AB_COLS, F.G, F.bid);
        EpiAB E{(bf16_t*)(ws + WS_PA), (bf16_t*)(ws + WS_Z)};
        REPS(1) pg8::gemm_phase<EpiAB, pg8::StaticOrder, true, true>(F.lds, g, S, E);
    } SEAM(1);
    if (IN(2)) { PH_BEGIN phase_row_a(F, P); } SEAM(2);
    if (IN(3)) { PH_BEGIN
        int kl = 256; asm volatile("" : "+s"(kl));
        pg8::Gemm g{(const bf16_t*)(ws + WS_ALORA), (const bf16_t*)(ws + WS_BT_LORA), M_TOK, 3072, kl}; pg8::StaticOrder S; S.init(M_TOK, 3072, F.G, F.bid);
        EpiLora E{(bf16_t*)(ws + WS_DLOG), P->in[5], P->in[7]};
        REPS(3) pg8::gemm_phase<EpiLora, pg8::StaticOrder, true, true>(F.lds, g, S, E);
    } SEAM(3);
    if (IN(5)) { PH_BEGIN
        {   const int ppb = (4096 + F.G - 1) / F.G, p0 = F.bid * ppb, pend = (p0 + ppb < 4096) ? p0 + ppb : 4096; int cur_head = -1;
            u32x4 raw[8]; if (p0 < pend) chunk_prep_fetch(P, p0, F.wave, F.tid, raw);
            for (int pr = p0; pr < pend; ++pr) {
                const int hd = (pr >> 6) & 15;
                if (hd != cur_head) { __syncthreads(); cur_head = hd;
                    if (F.tid < 384) { const int arr = F.tid >> 6, ch = F.tid & 63; const float* src = arr < 3 ? P->in[4] + arr * 1024 : P->in[7 + arr];
                        ((LAS float*)(F.lds + CP_PAR))[F.tid] = src[hd * 64 + ch]; }
                    __syncthreads(); }
                chunk_prep_pair<0>(F, P, pr, pr + 1 < pend ? pr + 1 : -1, raw);
            } }
        REPS(25) for (int t = F.bid; t < 1024; t += F.G) sgu_tile(F, P, t);
        xcd_barrier(bar);
        {   volatile LAS unsigned* cnt = (volatile LAS unsigned*)(F.lds + 4096);
            REPS(55) for (int u = F.bid; u < 256; u += F.G) {
                if (F.tid == 0) *cnt = 0u;
                __syncthreads();
                if (F.wave < 4) chunk_scan_unit4(F, P, u, F.lds, cnt);
                else if (u == F.bid) { const int hw = F.bid * 4 + (F.wave - 4), NHW = F.G * 4;
                    for (int it = hw; it < 14336; it += NHW) late_transpose_item(P, it, (LAS float*)(F.lds + 8192 + (F.wave - 4) * 8448), F.lane); }
                __syncthreads();
            } }
    } SEAM(5);
    if (IN(6)) { PH_BEGIN REPS(6) phase_gn(F, P); } SEAM(6);
    if (IN(7)) { PH_BEGIN
        pg8::Gemm g{(const bf16_t*)(ws + WS_YAB), (const bf16_t*)(ws + WS_WT_ABO), M_TOK, DM, DM}; pg8::StaticOrder S; S.init(M_TOK, DM, F.G, F.bid);
        EpiRes E{P->in[0], P->out};
        REPS(7) pg8::gemm_phase<EpiRes, pg8::StaticOrder, true, true>(F.lds, g, S, E);
    } SEAM(7);
#define PEER_BLOCK(layer, pb) \
    if (IN(pb)) { PH_BEGIN REPS(pb) phase_rmsnorm(F, P->out, P->in[2] + (layer) * DM, XN); } SEAM(pb); \
    if (IN((pb) + 1)) { PH_BEGIN \
        pg8::Gemm g{XN, (const bf16_t*)(ws + WS_WT_Q + (size_t)(layer) * 8 * MiB), M_TOK, DM, DM}; pg8::StaticOrder S; S.init(M_TOK, DM, F.G, F.bid); \
        pg8::EpiBf16<0> E{(bf16_t*)(ws + WS_QP), DM, nullptr, 0, 0, 1.f}; \
        REPS((pb) + 1) pg8::gemm_phase<pg8::EpiBf16<0>, pg8::StaticOrder, true, true>(F.lds, g, S, E); \
    } SEAM((pb) + 1); \
    if (IN((pb) + 2)) { PH_BEGIN REPS((pb) + 2) for (int u = F.bid; u < 512; u += F.G) peer_topk_unit(F, P, (layer), u); } SEAM((pb) + 2); \
    if (IN((pb) + 3)) { PH_BEGIN if (PROBE_REP == (pb) + 3) phase_experts<(layer) == 0 ? L0_FMT : 4>(F, P, (layer), nullptr, (float*)(ws + WS_Y)); if (PROBE_REP == (pb) + 43) phase_experts<(layer) == 0 ? L0_FMT : 4, 2>(F, P, (layer), nullptr, (float*)(ws + WS_Y)); phase_experts<(layer) == 0 ? L0_FMT : 4>(F, P, (layer), (layer) == 0 ? P->in[1] + DM : nullptr, P->out); }
    PEER_BLOCK(0, 8) SEAM(11);
    if (IN(12)) { PH_BEGIN
        pg8::Gemm g{XN, (const bf16_t*)(ws + WS_WT_C), M_TOK, C_COLS, DM}; pg8::StaticOrder S; S.init(M_TOK, C_COLS, F.G, F.bid);
        pg8::EpiBf16<0> E{(bf16_t*)(ws + WS_QKV), C_COLS, nullptr, 0, 0, 1.f};
        REPS(12) pg8::gemm_phase<pg8::EpiBf16<0>, pg8::StaticOrder, true, true>(F.lds, g, S, E);
    } SEAM(12);
    if (IN(13)) { PH_BEGIN   phase_qknorm(F, P); } SEAM(13);
    if (IN(14)) { PH_BEGIN
        float lam;
        {   const float a = (F.lane < 64) ? P->in[23][F.lane] * P->in[24][F.lane] : 0.f, b2 = P->in[25][F.lane] * P->in[26][F.lane];
            lam = __expf(wave_sum(a)) - __expf(wave_sum(b2)) + LAMBDA_INIT; }
#define ATT_PASS(V) for (int u = F.bid; u < 2048; u += F.G) { const int c = u & 255, i = u >> 8, s = c & 3; const int qb = (i & 1) ? (8 * (i >> 1) + 7 - s) : (8 * (i >> 1) + s); attn_unit<V>(F, P, c >> 2, qb, lam); }
        if (PROBE_REP == 14) { ATT_PASS(5) } if (PROBE_REP == 141) { ATT_PASS(1) } if (PROBE_REP == 142) { ATT_PASS(2) } if (PROBE_REP == 143) { ATT_PASS(3) } if (PROBE_REP == 144) { ATT_PASS(4) }
        ATT_PASS(0)
#undef ATT_PASS
    } SEAM(14);
    if (IN(15)) { PH_BEGIN
        pg8::Gemm g{(const bf16_t*)(ws + WS_OB), (const bf16_t*)(ws + WS_WT_CO), M_TOK, DM, DM}; pg8::StaticOrder S; S.init(M_TOK, DM, F.G, F.bid);
        EpiRes E{P->out, P->out};
        pg8::gemm_phase<EpiRes, pg8::StaticOrder, true, true>(F.lds, g, S, E);
    } SEAM(15);
    PEER_BLOCK(1, 16)
#undef PEER_BLOCK
#undef IN
#undef SEAM
}

extern "C" void kernel_launch(void* const* d_in, const int* in_sizes, int n_in, void* d_out, int out_size, void* d_ws, size_t ws_size, hipStream_t stream) {
    static int grid = 0;
    if (grid == 0) {
        if (n_in != 33 || out_size != M_TOK * DM || ws_size < WS_END) { fprintf(stderr, "kernel_launch: unexpected problem (n_in %d out %d ws %zu)\n", n_in, out_size, ws_size); grid = -1; return; }
        int dev = 0, cus = 0, per_cu = 0;
        hipGetDevice(&dev); hipDeviceGetAttribute(&cus, hipDeviceAttributeMultiprocessorCount, dev);
        if (hipFuncSetAttribute((const void*)fwd_kernel, hipFuncAttributeMaxDynamicSharedMemorySize, LDS_BYTES) != hipSuccess) { fprintf(stderr, "kernel_launch: hipFuncSetAttribute failed\n"); grid = -1; return; }
        if (hipOccupancyMaxActiveBlocksPerMultiprocessor(&per_cu, (const void*)fwd_kernel, NTHREADS, LDS_BYTES) != hipSuccess || per_cu < 1) { fprintf(stderr, "kernel_launch: occupancy query says %d\n", per_cu); per_cu = 1; }
        (void)hipGetLastError();
        grid = cus * 1;
        fprintf(stderr, "kernel_launch: grid %d (cus %d, per_cu %d)\n", grid, cus, per_cu);
    }
    if (grid < 0) return;
    if (hipMemsetAsync((char*)d_ws + WS_CTL, 0, 65536, stream) != hipSuccess) { fprintf(stderr, "kernel_launch: memset failed\n"); return; }
    Args a{};
    for (int i = 0; i < 33; ++i) a.p.in[i] = (const float*)d_in[i];
    a.p.out = (float*)d_out; a.p.ws = (unsigned char*)d_ws;
#if MK_ONE_LAUNCH
    a.ph_lo = 0; a.ph_hi = N_PHASES;
    void* kargs[] = {&a};
    hipError_t e = hipLaunchCooperativeKernel((const void*)fwd_kernel, dim3(grid), dim3(NTHREADS), kargs, LDS_BYTES, stream);
    if (e != hipSuccess) fprintf(stderr, "kernel_launch: cooperative launch failed: %s\n", hipGetErrorString(e));
#else
    for (int ph = 0; ph < N_PHASES; ++ph) {
        a.ph_lo = ph; a.ph_hi = ph + 1;
        hipLaunchKernelGGL(fwd_kernel, dim3(grid), dim3(NTHREADS), LDS_BYTES, stream, a);
    }
#endif
}
```

```cpp
#include <hip/hip_runtime.h>
#include <hip/hip_cooperative_groups.h>
#include <cstdio>
#include <cstdint>
namespace cg = cooperative_groups;
namespace pg8 {
#define PG8_LAS __attribute__((address_space(3)))
typedef unsigned short bf16_t;
typedef short bf16x8 __attribute__((ext_vector_type(8)));
typedef float f32x4 __attribute__((ext_vector_type(4)));
typedef unsigned u32x4 __attribute__((ext_vector_type(4)));
constexpr int BM = 256, BK = 64, HALF = 128, HTB = HALF * BK * 2  , STAGE_BYTES = 8 * HTB, NXCD = 8, WGM = 8;

__host__ __device__ __forceinline__ int lds_byte(int r, int c) { const int st = (r >> 4) * 2 + (c >> 5), rr = r & 15, cc = c & 31, ob = rr * 64 + cc * 2; return st * 1024 + (ob ^ (((ob >> 9) & 1) << 5)); }
__host__ __device__ __forceinline__ void stage_rc(int b, int& R, int& C) { const int st = b / 1024, sb = b % 1024, swz = sb ^ (((sb >> 9) & 1) << 5); R = (st >> 1) * 16 + swz / 64; C = (st & 1) * 32 + (swz % 64) / 2; }
__host__ __device__ __forceinline__ int perm32(int rho) { const int n = rho >> 4, i = rho & 15; return 8 * (i >> 2) + 4 * n + (i & 3); }

struct Unit { int pm, pn; };
struct Gemm { const bf16_t* A; const bf16_t* Bt; int M, N, K; int ntc = 0; };

struct StaticOrder {
    int nM, nN, nwg, G, c;
    __host__ __device__ void init(int M, int N, int G_, int c_) { nM = M / BM; nN = N / BM; nwg = nM * nN; G = G_; c = c_; }
    __host__ __device__ bool next(int i, Unit& u) const {
        const long L = (long)i * G + c; if (L >= nwg) return false;
        int wgid = (int)L; { const int q = nwg / NXCD, r = nwg % NXCD, xcd = wgid % NXCD, off = wgid / NXCD; wgid = (xcd < r ? xcd * (q + 1) : r * (q + 1) + (xcd - r) * q) + off; }
        const int nig = WGM * nN, gid = wgid / nig, fm = gid * WGM, gsz = (nM - fm) < WGM ? (nM - fm) : WGM;
        u.pm = fm + ((wgid % nig) % gsz); u.pn = (wgid % nig) / gsz; return true;
    }
    __device__ __forceinline__ void a_ready(const Unit&) const {}
    __device__ __forceinline__ void done(const Unit&) const {}
};

__device__ __forceinline__ unsigned cvt_pk_bf16(float lo, float hi) { unsigned r; asm volatile("v_cvt_pk_bf16_f32 %0, %1, %2" : "=v"(r) : "v"(lo), "v"(hi)); return r; }
typedef float f32x2 __attribute__((ext_vector_type(2)));
__device__ __forceinline__ f32x2 gelu_pk(f32x2 v) {
    const f32x2 av = __builtin_elementwise_abs(v), d = av * 0.2316418882f + 1.0f;
    f32x2 t; t.x = __builtin_amdgcn_rcpf(d.x); t.y = __builtin_amdgcn_rcpf(d.y);
    f32x2 q = t * 0.5307027145f + (-0.7265760135f); q = q * t + 0.7107068705f; q = q * t + (-0.142248368f); q = q * t + 0.127414796f; q = q * t;
    const f32x2 s = (v * v) * (-0.72134752044f);
    f32x2 e; e.x = __builtin_amdgcn_exp2f(s.x); e.y = __builtin_amdgcn_exp2f(s.y);
    const f32x2 m = v * (q * e), r = v - m;
    f32x2 o; o.x = v.x < 0.f ? m.x : r.x; o.y = v.y < 0.f ? m.y : r.y; return o;
}

template <int ACT  > struct EpiBf16 {
    static constexpr bool PERM = true, AFTER_DRAIN = false; static_assert(ACT == 0 || ACT == 1, "EpiBf16: ACT is 0 (none) or 1 (gelu_pk)");
    bf16_t* O; int ldc; const float* bias; int split_cols; size_t split_stride; float scale0;
    __device__ __forceinline__ void operator()(const f32x4 (&acc)[2][2][4][2], const Unit& u, int wr, int wc, int fr, int fq) const {
        const int row0 = u.pm * BM + wr * 64 + fr; int colt = u.pn * BM; bf16_t* base = O;
        float sc = 1.f; if (split_cols) { const int t = colt / split_cols; base += (size_t)t * split_stride; colt -= t * split_cols; if (t == 0) sc = scale0; }
        const int col0 = colt + wc * 32 + 8 * fq, bcol0 = u.pn * BM + wc * 32 + 8 * fq;
        f32x4 bv[2][2];
#pragma unroll
        for (int bj = 0; bj < 2; ++bj)
#pragma unroll
            for (int n = 0; n < 2; ++n) bv[bj][n] = bias ? *(const f32x4*)(bias + bcol0 + bj * HALF + 4 * n) : (f32x4){0.f, 0.f, 0.f, 0.f};
#pragma unroll
        for (int ai = 0; ai < 2; ++ai)
#pragma unroll
            for (int m = 0; m < 4; ++m) { bf16_t* rowp = base + (size_t)(row0 + ai * HALF + m * 16) * ldc + col0;
#pragma unroll
                for (int bj = 0; bj < 2; ++bj) { f32x4 v0 = acc[ai][bj][m][0] + bv[bj][0], v1 = acc[ai][bj][m][1] + bv[bj][1];
                    if (ACT == 1) { f32x2 a = gelu_pk((f32x2){v0[0], v0[1]}), b = gelu_pk((f32x2){v0[2], v0[3]}), c = gelu_pk((f32x2){v1[0], v1[1]}), d = gelu_pk((f32x2){v1[2], v1[3]});
                        v0 = (f32x4){a.x, a.y, b.x, b.y}; v1 = (f32x4){c.x, c.y, d.x, d.y}; }
                    v0 = v0 * sc; v1 = v1 * sc; u32x4 w; w.x = cvt_pk_bf16(v0[0], v0[1]); w.y = cvt_pk_bf16(v0[2], v0[3]); w.z = cvt_pk_bf16(v1[0], v1[1]); w.w = cvt_pk_bf16(v1[2], v1[3]);
                    *(u32x4*)(rowp + bj * HALF) = w; } }
    }
};
template <class Epi, class Sched, bool ALIGN_EPI = false, bool SP2 = false>
__device__ __forceinline__ void gemm_phase(PG8_LAS unsigned char* lds, const Gemm g, const Sched& S, const Epi& E) {
    const int tid = threadIdx.x, wid = __builtin_amdgcn_readfirstlane(tid >> 6), lane = tid & 63, wr = wid >> 2, wc = wid & 3, fr = lane & 15, fq = lane >> 4;
    const int K = g.K, nt = g.ntc ? g.ntc : K / BK;
    unsigned voffA[2], voffB[2];
#pragma unroll
    for (int i = 0; i < 2; ++i) { int R, C; stage_rc(tid * 16 + i * 8192, R, C); const int Rb = Epi::PERM ? ((R & ~31) + perm32(R & 31)) : R;
        voffA[i] = (unsigned)(R * K + C) * 2u; voffB[i] = (unsigned)(Rb * K + C) * 2u; }
    const size_t kstep = (size_t)(BK * 2);
    const size_t hstep = (size_t)HALF * K * 2;
    const size_t tstep = 2 * hstep;
    const unsigned ldsw = (unsigned)wid * 1024u;
    const int aoff = lds_byte(wr * 64 + fr, fq * 8), boff = lds_byte(wc * 32 + fr, fq * 8);
#define PG8_SA(b, h) (((b) * 2 + (h)) * HTB)
#define PG8_SB(b, h) ((4 + (b) * 2 + (h)) * HTB)
#define PG8_STAGE(bufoff, gbase, voff) do { _Pragma("unroll") for (int _i = 0; _i < 2; ++_i) \
        __builtin_amdgcn_global_load_lds((const unsigned*)((const char*)(gbase) + (voff)[_i]), (PG8_LAS unsigned*)(lds + (bufoff) + ldsw + _i * 8192), 16, 0, 0); } while (0)
#define PG8_LDA(dst, b, h) do { _Pragma("unroll") for (int m = 0; m < 4; ++m) _Pragma("unroll") for (int k = 0; k < 2; ++k) dst[m][k] = *(const PG8_LAS bf16x8*)(lds + PG8_SA(b, h) + aoff + m * 2048 + k * 1024); } while (0)
#define PG8_LDB(dst, b, h) do { _Pragma("unroll") for (int n = 0; n < 2; ++n) _Pragma("unroll") for (int k = 0; k < 2; ++k) dst[n][k] = *(const PG8_LAS bf16x8*)(lds + PG8_SB(b, h) + boff + n * 2048 + k * 1024); } while (0)
#define PG8_MMA(ai, bj, At, Bt) do { __builtin_amdgcn_s_setprio(1); _Pragma("unroll") for (int m = 0; m < 4; ++m) _Pragma("unroll") for (int n = 0; n < 2; ++n) _Pragma("unroll") for (int k = 0; k < 2; ++k) \
        acc[ai][bj][m][n] = __builtin_amdgcn_mfma_f32_16x16x32_bf16(Bt[n][k], At[m][k], acc[ai][bj][m][n], 0, 0, 0); __builtin_amdgcn_s_setprio(0); } while (0)
#define PG8_WAIT_V(n) asm volatile("s_waitcnt vmcnt(" #n ")" ::: "memory")
#define PG8_WAIT_L(n) asm volatile("s_waitcnt lgkmcnt(" #n ")" ::: "memory")
#define PG8_BAR __builtin_amdgcn_s_barrier()
#define PG8_SCHED __builtin_amdgcn_sched_barrier(0)
    Unit cur, nxt; int ui = 0;
    if (!S.next(0, cur)) return;
    f32x4 acc[2][2][4][2];
#pragma unroll
    for (int a = 0; a < 2; ++a)
#pragma unroll
        for (int b = 0; b < 2; ++b)
#pragma unroll
            for (int m = 0; m < 4; ++m)
#pragma unroll
                for (int n = 0; n < 2; ++n) acc[a][b][m][n] = (f32x4){0.f, 0.f, 0.f, 0.f};
    bf16x8 At[4][2], B0[2][2], B1[2][2];
    const char* cA = (const char*)g.A + (size_t)cur.pm * tstep; const char* cB = (const char*)g.Bt + (size_t)cur.pn * tstep;
    S.a_ready(cur);
    if constexpr (SP2) {
        PG8_STAGE(PG8_SB(0, 0), cB, voffB); PG8_STAGE(PG8_SB(0, 1), cB + hstep, voffB); PG8_STAGE(PG8_SA(0, 0), cA, voffA); PG8_STAGE(PG8_SA(0, 1), cA + hstep, voffA);
        if (wr == 1) PG8_BAR;
        PG8_WAIT_V(2); PG8_BAR;
        PG8_STAGE(PG8_SB(1, 0), cB + kstep, voffB); PG8_STAGE(PG8_SA(1, 0), cA + kstep, voffA); PG8_STAGE(PG8_SB(1, 1), cB + hstep + kstep, voffB);
        PG8_WAIT_V(6); PG8_BAR;
    } else {
        PG8_STAGE(PG8_SB(0, 0), cB, voffB); PG8_STAGE(PG8_SA(0, 0), cA, voffA); PG8_STAGE(PG8_SB(0, 1), cB + hstep, voffB); PG8_STAGE(PG8_SA(0, 1), cA + hstep, voffA);
        if (wr == 1) PG8_BAR;
        PG8_WAIT_V(4); PG8_BAR;
        PG8_STAGE(PG8_SB(1, 0), cB + kstep, voffB); PG8_STAGE(PG8_SA(1, 0), cA + kstep, voffA); PG8_STAGE(PG8_SB(1, 1), cB + hstep + kstep, voffB);
        PG8_WAIT_V(6); PG8_BAR;
    }
    for (;;) {
        const bool has_next = S.next(ui + 1, nxt);
        const char* nA = has_next ? (const char*)g.A + (size_t)nxt.pm * tstep : cA; const char* nB = has_next ? (const char*)g.Bt + (size_t)nxt.pn * tstep : cB;
        for (int t = 0; t < nt; t += 2) {
            const bool last = (t == nt - 2);
            const char* a1 = cA + (size_t)(t + 1) * kstep;
            const char* a2 = last ? nA : cA + (size_t)(t + 2) * kstep; const char* b2 = last ? nB : cB + (size_t)(t + 2) * kstep;
            const char* a3 = a2 + kstep; const char* b3 = b2 + kstep;
            if (last && has_next) S.a_ready(nxt);
            if constexpr (SP2) {
            PG8_LDB(B0, 0, 0); PG8_LDB(B1, 0, 1); PG8_SCHED; PG8_LDA(At, 0, 0); PG8_STAGE(PG8_SA(1, 1), a1 + hstep, voffA);
            PG8_WAIT_V(8); PG8_WAIT_L(0); PG8_BAR; PG8_MMA(0, 0, At, B0); PG8_MMA(0, 1, At, B1); PG8_BAR; PG8_SCHED;
            PG8_LDA(At, 0, 1); PG8_STAGE(PG8_SB(0, 0), b2, voffB); PG8_STAGE(PG8_SB(0, 1), b2 + hstep, voffB); PG8_STAGE(PG8_SA(0, 0), a2, voffA);
            PG8_WAIT_V(8); PG8_WAIT_L(0); PG8_BAR; PG8_MMA(1, 0, At, B0); PG8_MMA(1, 1, At, B1); PG8_BAR; PG8_SCHED;
            PG8_LDB(B0, 1, 0); PG8_LDB(B1, 1, 1); PG8_SCHED; PG8_LDA(At, 1, 0); PG8_STAGE(PG8_SA(0, 1), a2 + hstep, voffA);
            PG8_WAIT_V(8); PG8_WAIT_L(0); PG8_BAR; PG8_MMA(0, 0, At, B0); PG8_MMA(0, 1, At, B1); PG8_BAR; PG8_SCHED;
            PG8_LDA(At, 1, 1); PG8_STAGE(PG8_SB(1, 0), b3, voffB); PG8_STAGE(PG8_SB(1, 1), b3 + hstep, voffB); PG8_STAGE(PG8_SA(1, 0), a3, voffA);
            PG8_WAIT_V(8); PG8_WAIT_L(0); PG8_BAR; PG8_MMA(1, 0, At, B0); PG8_MMA(1, 1, At, B1); PG8_BAR; PG8_SCHED;
            } else {
            PG8_LDB(B0, 0, 0); PG8_SCHED; PG8_LDA(At, 0, 0); PG8_STAGE(PG8_SA(1, 1), a1 + hstep, voffA);
            PG8_WAIT_L(8); PG8_BAR; PG8_WAIT_L(0); PG8_MMA(0, 0, At, B0); PG8_BAR; PG8_SCHED;
            PG8_LDB(B1, 0, 1); PG8_STAGE(PG8_SB(0, 0), b2, voffB);
            PG8_BAR; PG8_WAIT_L(0); PG8_MMA(0, 1, At, B1); PG8_BAR;
            PG8_LDA(At, 0, 1); PG8_STAGE(PG8_SA(0, 0), a2, voffA);
            PG8_BAR; PG8_WAIT_L(0); PG8_MMA(1, 0, At, B0); PG8_BAR; PG8_SCHED;
            PG8_STAGE(PG8_SB(0, 1), b2 + hstep, voffB);
            PG8_WAIT_V(6); PG8_BAR; PG8_MMA(1, 1, At, B1); PG8_BAR;
            PG8_LDB(B0, 1, 0); PG8_SCHED; PG8_LDA(At, 1, 0); PG8_STAGE(PG8_SA(0, 1), a2 + hstep, voffA);
            PG8_WAIT_L(8); PG8_BAR; PG8_WAIT_L(0); PG8_MMA(0, 0, At, B0); PG8_BAR; PG8_SCHED;
            PG8_LDB(B1, 1, 1); PG8_STAGE(PG8_SB(1, 0), b3, voffB);
            PG8_BAR; PG8_WAIT_L(0); PG8_MMA(0, 1, At, B1); PG8_BAR;
            PG8_LDA(At, 1, 1); PG8_STAGE(PG8_SA(1, 0), a3, voffA);
            PG8_BAR; PG8_WAIT_L(0); PG8_MMA(1, 0, At, B0); PG8_BAR; PG8_SCHED;
            PG8_STAGE(PG8_SB(1, 1), b3 + hstep, voffB);
            PG8_WAIT_V(6); PG8_BAR; PG8_MMA(1, 1, At, B1); PG8_BAR;
            }
        }
        if constexpr (ALIGN_EPI) { if (wr == 0) PG8_BAR; }
        if constexpr (!Epi::AFTER_DRAIN) { E(acc, cur, wr, wc, fr, fq); S.done(cur); }
        if (!has_next) break;
#pragma unroll
        for (int a = 0; a < 2; ++a)
#pragma unroll
            for (int b = 0; b < 2; ++b)
#pragma unroll
                for (int m = 0; m < 4; ++m)
#pragma unroll
                    for (int n = 0; n < 2; ++n) acc[a][b][m][n] = (f32x4){0.f, 0.f, 0.f, 0.f};
        cur = nxt; cA = nA; cB = nB; ++ui;
        if constexpr (ALIGN_EPI) { if (wr == 1) PG8_BAR; }
    }
    PG8_WAIT_V(0);
    if constexpr (!ALIGN_EPI) { if (wr == 0) PG8_BAR; }
    PG8_BAR;
    if constexpr (Epi::AFTER_DRAIN) { E.fused(acc, cur, wr, wc, fr, fq, lds, wid, lane); S.done(cur); }
#undef PG8_SA
#undef PG8_SB
#undef PG8_STAGE
#undef PG8_LDA
#undef PG8_LDB
#undef PG8_MMA
#undef PG8_WAIT_V
#undef PG8_WAIT_L
#undef PG8_BAR
#undef PG8_SCHED
}
}
constexpr int M_TOK = 16384, DM = 2048, SEQ = 4096;
constexpr int NWAVES = 8, NTHREADS = 512;
constexpr int A_COLS = 3328, AB_COLS = 5376, C_COLS = 6144;
constexpr float DECAY_SCALE = 0.6065306597126334f;
constexpr float LAMBDA_INIT = 0.35550906759096316f;
constexpr float QSCALE = 0.125f * 1.4426950408889634f;

#define LAS __attribute__((address_space(3)))
typedef unsigned short bf16_t;
typedef short bf16x8 __attribute__((ext_vector_type(8)));
typedef short s16x4 __attribute__((ext_vector_type(4)));
typedef float f32x4 __attribute__((ext_vector_type(4)));
typedef float f32x2 __attribute__((ext_vector_type(2)));
typedef float f32x16 __attribute__((ext_vector_type(16)));
typedef unsigned u32x4 __attribute__((ext_vector_type(4)));
typedef unsigned u32x2 __attribute__((ext_vector_type(2)));
typedef unsigned u32x6 __attribute__((ext_vector_type(6)));
typedef float f32x32 __attribute__((ext_vector_type(32)));
#ifndef FP6_INTERLEAVED
#define FP6_INTERLEAVED 1
#endif
#ifndef L0_FMT
#define L0_FMT 4
#endif
#define FP6_IDX_A(i) (i)
#define FP6_IDX_B(i) (16 + (i))
#if FP6_INTERLEAVED
#define FP6_OUT_A(i) (2 * (i))
#define FP6_OUT_B(i) (2 * (i) + 1)
#else
#define FP6_OUT_A(i) (i)
#define FP6_OUT_B(i) (16 + (i))
#endif

constexpr size_t MiB = 1u << 20;
constexpr size_t WS_CTL = 0;
constexpr size_t WS_WT_AB = 2 * MiB, WS_WT_ABO = 23 * MiB, WS_WT_C = 31 * MiB, WS_WT_CO = 55 * MiB, WS_WT_Q = 63 * MiB  ;
constexpr size_t WS_BT_LORA = 79 * MiB, WS_KEYS = 81 * MiB, WS_ROPE = 82 * MiB, WS_SCALE = 83 * MiB;
constexpr size_t WS_UT = 84 * MiB, WS_VT = 212 * MiB, WS_XN = 340 * MiB;
constexpr size_t WS_PA = 404 * MiB, WS_Z = 508 * MiB, WS_ALORA = 572 * MiB, WS_DLOG = 580 * MiB, WS_ICLR = 612 * MiB, WS_GATE = 644 * MiB;
constexpr size_t WS_BONUS = 868 * MiB, WS_Y = 869 * MiB, WS_YAB = 933 * MiB, WS_END = 997 * MiB;
constexpr size_t WS_XB = WS_Y;
constexpr size_t WS_QP = 404 * MiB, WS_EIDX = 468 * MiB, WS_EGATE = 476 * MiB;
constexpr size_t WS_QKV = 508 * MiB, WS_OB = 700 * MiB;
constexpr int LDS_BYTES = 147456;

__device__ __forceinline__ float bf_lo(unsigned w) { return __uint_as_float(w << 16); }
__device__ __forceinline__ float bf_hi(unsigned w) { return __uint_as_float(w & 0xffff0000u); }
__device__ __forceinline__ float bf_1(unsigned short w) { return __uint_as_float(((unsigned)w) << 16); }
__device__ __forceinline__ unsigned pkbf(float lo, float hi) { return pg8::cvt_pk_bf16(lo, hi); }
typedef __bf16 bf16x2_t __attribute__((ext_vector_type(2)));
__device__ __forceinline__ unsigned pkbf_c(float lo, float hi) { const f32x2 v = {lo, hi}; const bf16x2_t b = __builtin_convertvector(v, bf16x2_t); return __builtin_bit_cast(unsigned, b); }
__device__ __forceinline__ void unpack8(const u32x4 a, float (&o)[8]) {
    o[0] = bf_lo(a.x); o[1] = bf_hi(a.x); o[2] = bf_lo(a.y); o[3] = bf_hi(a.y); o[4] = bf_lo(a.z); o[5] = bf_hi(a.z); o[6] = bf_lo(a.w); o[7] = bf_hi(a.w);
}
__device__ __forceinline__ u32x4 pack8(const float (&o)[8]) { u32x4 r; r.x = pkbf(o[0], o[1]); r.y = pkbf(o[2], o[3]); r.z = pkbf(o[4], o[5]); r.w = pkbf(o[6], o[7]); return r; }
__device__ __forceinline__ void ld16bf(const bf16_t* p, float (&o)[16]) {
    const u32x4 a = *(const u32x4*)p, b = *(const u32x4*)(p + 8); float t[8];
    unpack8(a, t);
#pragma unroll
    for (int i = 0; i < 8; ++i) o[i] = t[i];
    unpack8(b, t);
#pragma unroll
    for (int i = 0; i < 8; ++i) o[8 + i] = t[i];
}
__device__ __forceinline__ void st16bf(bf16_t* p, const float (&o)[16]) {
    u32x4 a, b; a.x = pkbf(o[0], o[1]); a.y = pkbf(o[2], o[3]); a.z = pkbf(o[4], o[5]); a.w = pkbf(o[6], o[7]);
    b.x = pkbf(o[8], o[9]); b.y = pkbf(o[10], o[11]); b.z = pkbf(o[12], o[13]); b.w = pkbf(o[14], o[15]);
    *(u32x4*)p = a; *(u32x4*)(p + 8) = b;
}
__device__ __forceinline__ void ld16f(const float* p, float (&o)[16]) {
#pragma unroll
    for (int i = 0; i < 4; ++i) { const f32x4 v = *(const f32x4*)(p + 4 * i); o[4 * i] = v.x; o[4 * i + 1] = v.y; o[4 * i + 2] = v.z; o[4 * i + 3] = v.w; }
}
__device__ __forceinline__ float sigmoidf_(float x) { return __builtin_amdgcn_rcpf(1.0f + __expf(-x)); }

template <int CTRL> __device__ __forceinline__ float dpp_mov(float x) { return __int_as_float(__builtin_amdgcn_update_dpp(0, __float_as_int(x), CTRL, 0xf, 0xf, true)); }
__device__ __forceinline__ float quad_sum(float x) { x += dpp_mov<0xB1>(x); x += dpp_mov<0x4E>(x); return x; }
__device__ __forceinline__ float oct_sum(float x) { x = quad_sum(x); x += dpp_mov<0x141>(x); return x; }
__device__ __forceinline__ float row16_sum(float x) { x = oct_sum(x); x += dpp_mov<0x140>(x); return x; }
__device__ __forceinline__ float wave_sum(float x) { x = row16_sum(x); x += __shfl_xor(x, 16); x += __shfl_xor(x, 32); return x; }
__device__ __forceinline__ float row16_max(float x) {
    x = fmaxf(x, dpp_mov<0xB1>(x)); x = fmaxf(x, dpp_mov<0x4E>(x)); x = fmaxf(x, dpp_mov<0x141>(x)); x = fmaxf(x, dpp_mov<0x140>(x)); return x;
}
__device__ __forceinline__ float wave_max(float x) { x = row16_max(x); x = fmaxf(x, __shfl_xor(x, 16)); x = fmaxf(x, __shfl_xor(x, 32)); return x; }

__device__ __forceinline__ unsigned fkey(float f) { const unsigned u = __float_as_uint(f); return u ^ ((unsigned)((int)u >> 31) | 0x80000000u); }
__device__ __forceinline__ int crow(int r, int hi) { return (r & 3) + 8 * (r >> 2) + 4 * hi; }
__device__ __forceinline__ s16x4 vtr(LAS unsigned char* p) { typedef short v4i16_t __attribute__((ext_vector_type(4))); return __builtin_bit_cast(s16x4, __builtin_amdgcn_ds_read_tr16_b64_v4i16((LAS v4i16_t*)p)); }
__device__ __forceinline__ float gelu1(float v) { pg8::f32x2 r = pg8::gelu_pk((pg8::f32x2){v, v}); return r.x; }

struct EpiAB {
    static constexpr bool PERM = true, AFTER_DRAIN = false;
    bf16_t* PA; bf16_t* Z;
    __device__ __forceinline__ void operator()(const pg8::f32x4 (&acc)[2][2][4][2], const pg8::Unit& u, int wr, int wc, int fr, int fq) const {
        const int row0 = u.pm * 256 + wr * 64 + fr;
        const bool isz = u.pn >= 13;
        bf16_t* base = isz ? Z : PA; const int ldc = isz ? 2048 : A_COLS; const int colt = isz ? (u.pn - 13) * 256 : u.pn * 256;
        const int col0 = colt + wc * 32 + 8 * fq;
#pragma unroll
        for (int ai = 0; ai < 2; ++ai)
#pragma unroll
            for (int m = 0; m < 4; ++m) { bf16_t* rowp = base + (size_t)(row0 + ai * 128 + m * 16) * ldc + col0;
#pragma unroll
                for (int bj = 0; bj < 2; ++bj) { pg8::f32x4 v0 = acc[ai][bj][m][0], v1 = acc[ai][bj][m][1];
                    if (isz) { pg8::f32x2 a = pg8::gelu_pk((pg8::f32x2){v0[0], v0[1]}), b = pg8::gelu_pk((pg8::f32x2){v0[2], v0[3]}), c = pg8::gelu_pk((pg8::f32x2){v1[0], v1[1]}), d = pg8::gelu_pk((pg8::f32x2){v1[2], v1[3]});
                        v0 = (pg8::f32x4){a.x, a.y, b.x, b.y}; v1 = (pg8::f32x4){c.x, c.y, d.x, d.y}; }
                    u32x4 w; w.x = pkbf(v0[0], v0[1]); w.y = pkbf(v0[2], v0[3]); w.z = pkbf(v1[0], v1[1]); w.w = pkbf(v1[2], v1[3]);
                    *(u32x4*)(rowp + bj * 128) = w; } }
    }
};
struct EpiLora {
    static constexpr bool PERM = true, AFTER_DRAIN = false;
    bf16_t* base3; const float *dbias, *ibias;
    __device__ __forceinline__ void operator()(const pg8::f32x4 (&acc)[2][2][4][2], const pg8::Unit& u, int wr, int wc, int fr, int fq) const {
        const int row0 = u.pm * 256 + wr * 64 + fr;
        const int kind = u.pn >> 2; const int colt = (u.pn & 3) * 256;
        bf16_t* base = base3 + (size_t)kind * (size_t)(16 * MiB);
        const float* bias = kind == 0 ? dbias : ibias;
        const int col0 = colt + wc * 32 + 8 * fq;
#pragma unroll
        for (int bj = 0; bj < 2; ++bj) {
            pg8::f32x4 b0 = (pg8::f32x4){0.f, 0.f, 0.f, 0.f}, b1 = b0;
            if (kind < 2) { b0 = *(const pg8::f32x4*)(bias + col0 + bj * 128); b1 = *(const pg8::f32x4*)(bias + col0 + bj * 128 + 4); }
#pragma unroll
            for (int ai = 0; ai < 2; ++ai)
#pragma unroll
                for (int m = 0; m < 4; ++m) { bf16_t* rowp = base + (size_t)(row0 + ai * 128 + m * 16) * 1024 + col0;
                    pg8::f32x4 v0 = acc[ai][bj][m][0] + b0, v1 = acc[ai][bj][m][1] + b1;
                    if (kind < 2) { const float sc = kind == 0 ? DECAY_SCALE : 1.0f;
#pragma unroll
                        for (int i = 0; i < 4; ++i) { v0[i] = sc * sigmoidf_(v0[i]); v1[i] = sc * sigmoidf_(v1[i]); } }
                    u32x4 w; w.x = pkbf(v0[0], v0[1]); w.y = pkbf(v0[2], v0[3]); w.z = pkbf(v1[0], v1[1]); w.w = pkbf(v1[2], v1[3]);
                    *(u32x4*)(rowp + bj * 128) = w; } }
    }
};
template <bool RES_F32> struct EpiRes {
    static constexpr bool PERM = true, AFTER_DRAIN = false;
    const void* res; bf16_t* out;
    __device__ __forceinline__ void operator()(const pg8::f32x4 (&acc)[2][2][4][2], const pg8::Unit& u, int wr, int wc, int fr, int fq) const {
        const int row0 = u.pm * 256 + wr * 64 + fr; const int col0 = u.pn * 256 + wc * 32 + 8 * fq;
#pragma unroll
        for (int ai = 0; ai < 2; ++ai)
#pragma unroll
            for (int m = 0; m < 4; ++m) { const size_t off = (size_t)(row0 + ai * 128 + m * 16) * DM + col0;
#pragma unroll
                for (int bj = 0; bj < 2; ++bj) { pg8::f32x4 r0, r1;
                    if (RES_F32) { r0 = *(const pg8::f32x4*)((const float*)res + off + bj * 128); r1 = *(const pg8::f32x4*)((const float*)res + off + bj * 128 + 4); }
                    else { const u32x4 w = *(const u32x4*)((const bf16_t*)res + off + bj * 128); r0 = (pg8::f32x4){bf_lo(w.x), bf_hi(w.x), bf_lo(w.y), bf_hi(w.y)}; r1 = (pg8::f32x4){bf_lo(w.z), bf_hi(w.z), bf_lo(w.w), bf_hi(w.w)}; }
                    r0 = r0 + acc[ai][bj][m][0]; r1 = r1 + acc[ai][bj][m][1];
                    *(u32x4*)(out + off + bj * 128) = (u32x4){pkbf(r0[0], r0[1]), pkbf(r0[2], r0[3]), pkbf(r1[0], r1[1]), pkbf(r1[2], r1[3])}; } }
    }
};

struct Frame {
    LAS unsigned char* lds;
    int tid, lane, wave, G, bid;
    int gw, NGW;
};

__device__ __forceinline__ void rms_row_to_bf16(const float* xrow, const float* g, bf16_t* orow, int lane) {
    const f32x4* xr = (const f32x4*)xrow + lane; f32x4 v[8]; float s = 0.f;
#pragma unroll
    for (int j = 0; j < 8; ++j) { v[j] = xr[64 * j]; s += (v[j].x * v[j].x + v[j].y * v[j].y) + (v[j].z * v[j].z + v[j].w * v[j].w); }
    const float rstd = rsqrtf(wave_sum(s) * (1.0f / DM) + 1e-6f);
    const f32x4* gr = (const f32x4*)g + lane; u32x2* o8 = (u32x2*)orow + lane;
#pragma unroll
    for (int j = 0; j < 8; ++j) { const f32x4 gv = gr[64 * j]; u32x2 w; w.x = pkbf(v[j].x * rstd * gv.x, v[j].y * rstd * gv.y); w.y = pkbf(v[j].z * rstd * gv.z, v[j].w * rstd * gv.w); o8[64 * j] = w; }
}

__device__ __forceinline__ void p0_transpose_item(const float* W, int K, int N, bf16_t* WT, int row_off, LAS float* scr, int item, int lane) {
    const int nblk = N / 32, kb = item / nblk, nb = item % nblk, k0 = 64 * kb, n0 = 32 * nb;
#pragma unroll 8
    for (int i = 0; i < 32; ++i) { const int kk = 2 * i + (lane >> 5); scr[kk * 33 + (lane & 31)] = W[(size_t)(k0 + kk) * N + n0 + (lane & 31)]; }
    asm volatile("s_waitcnt lgkmcnt(0)" ::: "memory");
    const int c = lane & 7;
#pragma unroll
    for (int j = 0; j < 4; ++j) { const int n = (lane >> 3) + 8 * j; const LAS float* s = scr + (8 * c) * 33 + n;
        u32x4 o; o.x = pkbf(s[0 * 33], s[1 * 33]); o.y = pkbf(s[2 * 33], s[3 * 33]); o.z = pkbf(s[4 * 33], s[5 * 33]); o.w = pkbf(s[6 * 33], s[7 * 33]);
        *(u32x4*)(WT + (size_t)(row_off + n0 + n) * K + k0 + 8 * c) = o; }
    asm volatile("s_waitcnt lgkmcnt(0)" ::: "memory");
}

struct Ptrs {
    const float* in[33];
    float* out;
    unsigned char* ws;
};
typedef const __attribute__((address_space(4))) Ptrs* CP;
__device__ __forceinline__ CP launder(CP p) { asm volatile("" : "+s"(p)); return p; }

__device__ __forceinline__ void quant_load(CP P, int r, int lane, f32x4 (&x)[8]) {
    const int rr = r & 32767; const bool isv = r >= 32768;
    const float* src = (isv ? P->in[32] : P->in[31]) + (size_t)rr * DM + 4 * lane;
#pragma unroll
    for (int k = 0; k < 8; ++k) x[k] = *(const f32x4*)(src + 256 * k);
}
__device__ __forceinline__ void quant_finish(CP P, int r, int lane, const f32x4 (&x)[8]) {
    unsigned char* ws = P->ws; float* SC = (float*)(ws + WS_SCALE);
    const int rr = r & 32767; const bool isv = r >= 32768; const int layer = rr >> 14, e = rr & 16383;
    unsigned char* tab = ws + (isv ? WS_VT : WS_UT);
    float v[32]; float am = 0.f;
#pragma unroll
    for (int k = 0; k < 8; ++k) { v[4 * k] = x[k].x; v[4 * k + 1] = x[k].y; v[4 * k + 2] = x[k].z; v[4 * k + 3] = x[k].w;
        am = fmaxf(am, fmaxf(fmaxf(fabsf(x[k].x), fabsf(x[k].y)), fmaxf(fabsf(x[k].z), fabsf(x[k].w)))); }
    am = wave_max(am); const bool f6 = (layer == 0 && L0_FMT == 6); const float sc = fmaxf(am, 1e-30f) * (f6 ? (1.0f / 7.5f) : (1.0f / 6.0f)), inv = 1.0f / sc;
#pragma unroll
    for (int i = 0; i < 32; ++i) v[i] *= inv;
    if (f6) {
        f32x16 a, b;
#pragma unroll
        for (int i = 0; i < 16; ++i) { a[i] = v[FP6_IDX_A(i)]; b[i] = v[FP6_IDX_B(i)]; }
        const u32x6 q = __builtin_amdgcn_cvt_scalef32_2xpk16_fp6_f32(a, b, 1.0f);
        unsigned char* dst = tab + (size_t)e * 1536;
        *(u32x4*)(dst + 16 * lane) = (u32x4){q[0], q[1], q[2], q[3]}; *(u32x2*)(dst + 1024 + 8 * lane) = (u32x2){q[4], q[5]};
    } else {
        u32x4 q;
#pragma unroll
        for (int d = 0; d < 4; ++d) { unsigned w = 0u;
            w = __builtin_amdgcn_cvt_scalef32_pk_fp4_f32(w, v[8 * d + 0], v[8 * d + 1], 1.0f, 0); w = __builtin_amdgcn_cvt_scalef32_pk_fp4_f32(w, v[8 * d + 2], v[8 * d + 3], 1.0f, 1);
            w = __builtin_amdgcn_cvt_scalef32_pk_fp4_f32(w, v[8 * d + 4], v[8 * d + 5], 1.0f, 2); w = __builtin_amdgcn_cvt_scalef32_pk_fp4_f32(w, v[8 * d + 6], v[8 * d + 7], 1.0f, 3); q[d] = w; }
        *(u32x4*)(tab + (size_t)layer * 32 * MiB + (size_t)e * 1024 + 16 * lane) = q;
    }
    if (lane == 0) SC[r] = sc;
}

__device__ __forceinline__ void late_transpose_item(CP P, int item, LAS float* scr, int lane) {
    unsigned char* ws = P->ws; constexpr int I_SQ = 32 * 64, I_C = 32 * (C_COLS / 32);
    int r = item;
    if (r < I_SQ) { p0_transpose_item(P->in[19], DM, DM, (bf16_t*)(ws + WS_WT_ABO), 0, scr, r, lane); return; } r -= I_SQ;
    if (r < I_C) { p0_transpose_item(P->in[20], DM, C_COLS, (bf16_t*)(ws + WS_WT_C), 0, scr, r, lane); return; } r -= I_C;
    if (r < I_SQ) { p0_transpose_item(P->in[28], DM, DM, (bf16_t*)(ws + WS_WT_CO), 0, scr, r, lane); return; } r -= I_SQ;
    if (r < I_SQ) { p0_transpose_item(P->in[29], DM, DM, (bf16_t*)(ws + WS_WT_Q), 0, scr, r, lane); return; } r -= I_SQ;
    p0_transpose_item(P->in[29] + (size_t)DM * DM, DM, DM, (bf16_t*)(ws + WS_WT_Q + 8 * MiB), 0, scr, r, lane);
}

__device__ __forceinline__ void phase_prologue(const Frame& F, CP P) {
    unsigned char* ws = P->ws;
    LAS float* scr = (LAS float*)(F.lds + F.wave * 16384);
    constexpr int I_AB = 32 * (AB_COLS / 32), I_SQ = 32 * 64;
    for (int it = F.gw; it < I_AB; it += F.NGW) p0_transpose_item(P->in[3], DM, AB_COLS, (bf16_t*)(ws + WS_WT_AB), 0, scr, it, F.lane);
    const int gt = F.bid * NTHREADS + F.tid, NGT = F.G * NTHREADS;
    {   bf16_t* BT = (bf16_t*)(ws + WS_BT_LORA);
        for (int it = gt; it < 3072 * 32; it += NGT) {
            const int kg = it / 3072, n = it % 3072, k0 = kg * 8; float v[8];
#pragma unroll
            for (int i = 0; i < 8; ++i) { const int k = k0 + i; float x = 0.f;
                if (n < 1024) { if (k < 64) x = P->in[6][(size_t)k * 1024 + n]; }
                else if (n < 2048) { if (k >= 64 && k < 128) x = P->in[8][(size_t)(k - 64) * 1024 + (n - 1024)]; }
                else { if (k >= 128) x = P->in[9][(size_t)(k - 128) * 1024 + (n - 2048)]; }
                v[i] = x; }
            *(u32x4*)(BT + (size_t)n * 256 + k0) = pack8(v);
        } }
    {   const f32x4* src = (const f32x4*)P->in[30]; u32x4* dst = (u32x4*)(ws + WS_KEYS);
        for (int it = gt; it < 65536; it += NGT) { const f32x4 a = src[2 * it], b = src[2 * it + 1]; u32x4 o; o.x = pkbf(a.x, a.y); o.y = pkbf(a.z, a.w); o.z = pkbf(b.x, b.y); o.w = pkbf(b.z, b.w); dst[it] = o; } }
    {   f32x2* rt = (f32x2*)(ws + WS_ROPE);
        for (int it = gt; it < 4096 * 8; it += NGT) { const int pos = it >> 3, i = it & 7; const float inv = powf(500000.0f, -(float)i * 0.125f); const float ang = (float)pos * inv; rt[it] = (f32x2){cosf(ang), sinf(ang)}; } }
    for (int m = F.gw; m < M_TOK; m += F.NGW) rms_row_to_bf16(P->in[0] + (size_t)m * DM, P->in[1], (bf16_t*)(ws + WS_XN) + (size_t)m * DM, F.lane);
}

__device__ __forceinline__ void phase_row_a(const Frame& F, CP P) {
    const bf16_t* PA = (const bf16_t*)(P->ws + WS_PA); bf16_t* Z = (bf16_t*)(P->ws + WS_Z); bf16_t* AL = (bf16_t*)(P->ws + WS_ALORA);
    const float* mu = P->in[4] + 3072; const float* lnw = P->in[15]; const float* lnb = P->in[16];
    const int lane = F.lane;
    for (int t = F.gw; t < M_TOK; t += F.NGW) {
        {   const int c = 4 * lane;
            const u32x2 cu = *(const u32x2*)(PA + (size_t)t * A_COLS + 3072 + c);
            u32x2 pv = (u32x2){0u, 0u}; if ((t & (SEQ - 1)) != 0) pv = *(const u32x2*)(PA + (size_t)(t - 1) * A_COLS + 3072 + c);
            const f32x4 m4 = *(const f32x4*)(mu + c);
            float cur[4] = {bf_lo(cu.x), bf_hi(cu.x), bf_lo(cu.y), bf_hi(cu.y)}, prv[4] = {bf_lo(pv.x), bf_hi(pv.x), bf_lo(pv.y), bf_hi(pv.y)}, mm[4] = {m4.x, m4.y, m4.z, m4.w}, o[4];
#pragma unroll
            for (int i = 0; i < 4; ++i) { const float v = cur[i] + (prv[i] - cur[i]) * mm[i]; o[i] = (c < 64) ? tanhf(v) : ((c < 128) ? v : sigmoidf_(v)); }
            u32x2 w; w.x = pkbf(o[0], o[1]); w.y = pkbf(o[2], o[3]); *(u32x2*)(AL + (size_t)t * 256 + c) = w; }
        {   bf16_t* zr = Z + (size_t)t * 2048 + 1024; float v[16]; float t8[8];
            unpack8(*(const u32x4*)(zr + 8 * lane), t8);
#pragma unroll
            for (int i = 0; i < 8; ++i) v[i] = t8[i];
            unpack8(*(const u32x4*)(zr + 512 + 8 * lane), t8);
#pragma unroll
            for (int i = 0; i < 8; ++i) v[8 + i] = t8[i];
            float s = 0.f;
#pragma unroll
            for (int i = 0; i < 16; ++i) s += v[i];
            const float mean = wave_sum(s) * (1.0f / 1024.0f); float q = 0.f;
#pragma unroll
            for (int i = 0; i < 16; ++i) { v[i] -= mean; q += v[i] * v[i]; }
            const float rstd = rsqrtf(wave_sum(q) * (1.0f / 1024.0f) + 1e-5f);
#pragma unroll
            for (int j = 0; j < 2; ++j) { const int c = 512 * j + 8 * lane; float o[8];
                const f32x4 w0 = *(const f32x4*)(lnw + c), w1 = *(const f32x4*)(lnw + c + 4), b0 = *(const f32x4*)(lnb + c), b1 = *(const f32x4*)(lnb + c + 4);
                const float ww[8] = {w0.x, w0.y, w0.z, w0.w, w1.x, w1.y, w1.z, w1.w}, bb[8] = {b0.x, b0.y, b0.z, b0.w, b1.x, b1.y, b1.z, b1.w};
#pragma unroll
                for (int i = 0; i < 8; ++i) o[i] = v[8 * j + i] * rstd * ww[i] + bb[i];
                *(u32x4*)(zr + c) = pack8(o); } }
    }
}

__device__ __forceinline__ void sgu_tile(const Frame& F, CP P, int tile) {
    const int tid = F.tid, wave = F.wave, lane = F.lane, q31 = lane & 31, hh = lane >> 5; const int cch = tile >> 3, g = tile & 7, t0 = cch * 128;
    const bf16_t* Z = (const bf16_t*)(P->ws + WS_Z); bf16_t* YAB = (bf16_t*)(P->ws + WS_YAB);
    const float* Wg = P->in[17] + (size_t)g * 16384; const float* bs = P->in[18] + g * 128;
    LAS unsigned char* Wl = F.lds;
    LAS unsigned char* Vl = F.lds + 34816;
#pragma unroll
    for (int i = 0; i < 8; ++i) { const int p = tid + 512 * i, t = p >> 5, s4 = (p & 31) * 4; f32x4 w = *(const f32x4*)(Wg + t * 128 + s4);
        if (s4 + 0 > t) w.x = 0.f; if (s4 + 1 > t) w.y = 0.f; if (s4 + 2 > t) w.z = 0.f; if (s4 + 3 > t) w.w = 0.f;
        *(LAS u32x2*)(Wl + t * 272 + s4 * 2) = (u32x2){pkbf(w.x, w.y), pkbf(w.z, w.w)}; }
#pragma unroll
    for (int i = 0; i < 4; ++i) { const int p = tid + 512 * i, s = p >> 4, d8 = (p & 15) * 8;
        *(LAS u32x4*)(Vl + s * 320 + d8 * 2) = *(const u32x4*)(Z + (size_t)(t0 + s) * 2048 + 1024 + g * 128 + d8); }
    __syncthreads();
    const int dt = wave & 3, tiA = (wave >> 2) ? 1 : 0, tiB = (wave >> 2) ? 2 : 3;
    f32x16 accA, accB;
#pragma unroll
    for (int r = 0; r < 16; ++r) { accA[r] = 0.f; accB[r] = 0.f; }
    LAS unsigned char* Vb = Vl + (8 * hh + ((lane >> 2) & 3)) * 320 + (32 * dt + 16 * ((lane >> 4) & 1) + 4 * (lane & 3)) * 2;
    const LAS unsigned char* WbA = Wl + (32 * tiA + q31) * 272 + hh * 16; const LAS unsigned char* WbB = Wl + (32 * tiB + q31) * 272 + hh * 16;
    const int nA = 2 * tiA + 2, nB = 2 * tiB + 2;
    for (int ks = 0; ks < nB; ++ks) {
        const s16x4 lo = vtr(Vb + (16 * ks) * 320), hi = vtr(Vb + (16 * ks + 4) * 320);
        const bf16x8 vf = (bf16x8){lo[0], lo[1], lo[2], lo[3], hi[0], hi[1], hi[2], hi[3]};
        const bf16x8 wb = *(const LAS bf16x8*)(WbB + ks * 32);
        accB = __builtin_amdgcn_mfma_f32_32x32x16_bf16(vf, wb, accB, 0, 0, 0);
        if (ks < nA) { const bf16x8 wa = *(const LAS bf16x8*)(WbA + ks * 32); accA = __builtin_amdgcn_mfma_f32_32x32x16_bf16(vf, wa, accA, 0, 0, 0); }
    }
#pragma unroll
    for (int which = 0; which < 2; ++which) { const int ti = which ? tiB : tiA; const int t = 32 * ti + q31; const float bias = bs[t];
        const bf16_t* up = Z + (size_t)(t0 + t) * 2048 + g * 128 + 32 * dt + 4 * hh; bf16_t* op = YAB + (size_t)(t0 + t) * 2048 + 1024 + g * 128 + 32 * dt + 4 * hh;
#pragma unroll
        for (int g4 = 0; g4 < 4; ++g4) { const u32x2 uu = *(const u32x2*)(up + 8 * g4);
            const float a0 = which ? accB[4 * g4 + 0] : accA[4 * g4 + 0], a1 = which ? accB[4 * g4 + 1] : accA[4 * g4 + 1], a2 = which ? accB[4 * g4 + 2] : accA[4 * g4 + 2], a3 = which ? accB[4 * g4 + 3] : accA[4 * g4 + 3];
            *(u32x2*)(op + 8 * g4) = (u32x2){pkbf(bf_lo(uu.x) * (a0 + bias), bf_hi(uu.x) * (a1 + bias)), pkbf(bf_lo(uu.y) * (a2 + bias), bf_hi(uu.y) * (a3 + bias))}; } }
    __syncthreads();
}

__device__ __forceinline__ void phase_gn(const Frame& F, CP P) {
    const float* Y = (const float*)(P->ws + WS_Y); const float* BON = (const float*)(P->ws + WS_BONUS);
    const bf16_t* GT = (const bf16_t*)(P->ws + WS_GATE); bf16_t* YAB = (bf16_t*)(P->ws + WS_YAB);
    const float* gnw = P->in[13]; const float* gnb = P->in[14];
    const int lane = F.lane, c = 16 * lane, h = lane >> 2, q = lane & 3;
    for (int t = F.gw; t < M_TOK; t += F.NGW) {
        float y[16], tmp[16], tb[16], o[16];
        ld16f(Y + (size_t)t * 1024 + c, y); float s = 0.f;
#pragma unroll
        for (int i = 0; i < 16; ++i) s += y[i];
        const float mean = quad_sum(s) * (1.0f / 64.0f); float qq = 0.f;
#pragma unroll
        for (int i = 0; i < 16; ++i) { y[i] -= mean; qq += y[i] * y[i]; }
        const float rstd = rsqrtf(quad_sum(qq) * (1.0f / 64.0f) + 64e-5f);
        ld16f(gnw + c, tmp); ld16f(gnb + c, tb);
#pragma unroll
        for (int i = 0; i < 16; ++i) y[i] = y[i] * rstd * tmp[i] + tb[i];
        const float bon = BON[(size_t)t * 16 + h];
        {   const bf16_t* PA = (const bf16_t*)(P->ws + WS_PA); float vp[16], mv[16];
            ld16bf(PA + (size_t)t * A_COLS + 2048 + c, tmp); ld16f(P->in[4] + 2048 + c, mv);
            if ((t & (SEQ - 1)) != 0) { ld16bf(PA + (size_t)(t - 1) * A_COLS + 2048 + c, vp);
#pragma unroll
                for (int i = 0; i < 16; ++i) tmp[i] += (vp[i] - tmp[i]) * mv[i]; }
            else {
#pragma unroll
                for (int i = 0; i < 16; ++i) tmp[i] -= tmp[i] * mv[i]; } }
        ld16bf(GT + (size_t)t * 1024 + c, tb);
#pragma unroll
        for (int i = 0; i < 16; ++i) o[i] = (y[i] + bon * tmp[i]) * tb[i];
        st16bf(YAB + (size_t)t * 2048 + c, o);
    }
}

__device__ __forceinline__ void phase_rmsnorm(const Frame& F, const bf16_t* XB, const float* g, bf16_t* XN) {
    const int lane = F.lane;
    for (int m = F.gw; m < M_TOK; m += F.NGW) {
        float v[4][8]; float s = 0.f;
#pragma unroll
        for (int j = 0; j < 4; ++j) { unpack8(*(const u32x4*)(XB + (size_t)m * DM + 512 * j + 8 * lane), v[j]);
#pragma unroll
            for (int i = 0; i < 8; i += 2) s += v[j][i] * v[j][i] + v[j][i + 1] * v[j][i + 1]; }
        const float rstd = rsqrtf(wave_sum(s) * (1.0f / DM) + 1e-6f);
#pragma unroll
        for (int j = 0; j < 4; ++j) { const f32x4 g0 = *(const f32x4*)(g + 512 * j + 8 * lane), g1 = *(const f32x4*)(g + 512 * j + 8 * lane + 4);
            const float o[8] = {v[j][0] * rstd * g0.x, v[j][1] * rstd * g0.y, v[j][2] * rstd * g0.z, v[j][3] * rstd * g0.w, v[j][4] * rstd * g1.x, v[j][5] * rstd * g1.y, v[j][6] * rstd * g1.z, v[j][7] * rstd * g1.w};
            *(u32x4*)(XN + (size_t)m * DM + 512 * j + 8 * lane) = pack8(o); }
    }
}

constexpr int TK_WAVE_BYTES = 17024;
__device__ __forceinline__ void peer_topk_unit(const Frame& F, CP P, int layer, int u) {
    const int wave = F.wave, lane = F.lane, lr = lane & 15, lg = lane >> 4;
    const int h = u & 7, tg = u >> 3;
    const bf16_t* KEYS = (const bf16_t*)(P->ws + WS_KEYS) + (size_t)((layer * 8 + h) * 2) * 16384;
    const bf16_t* QP = (const bf16_t*)(P->ws + WS_QP);
    int* EIDX = (int*)(P->ws + WS_EIDX); float* EGATE = (float*)(P->ws + WS_EGATE);
    LAS float* sc = (LAS float*)(F.lds + wave * TK_WAVE_BYTES);
    LAS float* rv = sc + 2176; LAS int* ri = (LAS int*)(rv + 1024); LAS float* fvs = rv + 2048; LAS int* cds = (LAS int*)(rv + 2064);
    const int t0 = tg * 256 + wave * 32;
#pragma unroll 1
    for (int p = 0; p < 2; ++p) {
        bf16x8 kb[8][4];
#pragma unroll
        for (int nt = 0; nt < 8; ++nt)
#pragma unroll
            for (int ks = 0; ks < 4; ++ks) kb[nt][ks] = *(const bf16x8*)(KEYS + (size_t)(p * 128 + 16 * nt + lr) * 128 + 32 * ks + 8 * lg);
#pragma unroll 1
        for (int bt = 0; bt < 2; ++bt) {
            bf16x8 qa[4];
#pragma unroll
            for (int ks = 0; ks < 4; ++ks) qa[ks] = *(const bf16x8*)(QP + (size_t)(t0 + 16 * bt + lr) * 2048 + h * 256 + p * 128 + 32 * ks + 8 * lg);
            f32x4 acc[8];
#pragma unroll
            for (int nt = 0; nt < 8; ++nt) { acc[nt] = (f32x4){0.f, 0.f, 0.f, 0.f};
#pragma unroll
                for (int ks = 0; ks < 4; ++ks) acc[nt] = __builtin_amdgcn_mfma_f32_16x16x32_bf16(qa[ks], kb[nt][ks], acc[nt], 0, 0, 0); }
#pragma unroll
            for (int nt = 0; nt < 8; ++nt)
#pragma unroll
                for (int r = 0; r < 4; ++r) sc[(4 * lg + r) * 132 + 16 * nt + lr] = acc[nt][r];
#pragma unroll 1
            for (int tk = 0; tk < 16; ++tk) {
                const float a0 = sc[tk * 132 + lane], a1 = sc[tk * 132 + 64 + lane]; const unsigned k0 = fkey(a0), k1 = fkey(a1); unsigned thr = 0u;
                for (int bit = 31; bit >= 0; --bit) { const unsigned cd = thr | (1u << bit);
                    const int cnt = __popcll(__ballot(k0 >= cd)) + __popcll(__ballot(k1 >= cd));
                    if (cnt >= 16) { thr = cd; if (cnt == 16) break; } }
                const unsigned long long b0 = __ballot(k0 >= thr), b1 = __ballot(k1 >= thr);
                const int s0 = __builtin_amdgcn_mbcnt_hi((unsigned)(b0 >> 32), __builtin_amdgcn_mbcnt_lo((unsigned)b0, 0u));
                const int s1 = __popcll(b0) + __builtin_amdgcn_mbcnt_hi((unsigned)(b1 >> 32), __builtin_amdgcn_mbcnt_lo((unsigned)b1, 0u));
                const int ro = (p * 32 + 16 * bt + tk) * 16;
                if (k0 >= thr && s0 < 16) { rv[ro + s0] = a0; ri[ro + s0] = lane; }
                if (k1 >= thr && s1 < 16) { rv[ro + s1] = a1; ri[ro + s1] = lane + 64; } }
        }
    }
#pragma unroll 1
    for (int tk = 0; tk < 32; ++tk) {
        const int t = t0 + tk; const LAS float* sv0 = rv + tk * 16; const LAS float* sv1 = rv + (32 + tk) * 16;
        float cand[4]; unsigned ck[4];
        {   const float s0 = sv0[lane >> 2]; const f32x4 s1 = *(const LAS f32x4*)(sv1 + (lane & 3) * 4);
            cand[0] = s0 + s1.x; cand[1] = s0 + s1.y; cand[2] = s0 + s1.z; cand[3] = s0 + s1.w;
#pragma unroll
            for (int m = 0; m < 4; ++m) ck[m] = fkey(cand[m]); }
        {   unsigned thr = 0u;
            for (int bit = 31; bit >= 0; --bit) { const unsigned cd = thr | (1u << bit);
                const int cnt = (__popcll(__ballot(ck[0] >= cd)) + __popcll(__ballot(ck[1] >= cd))) + (__popcll(__ballot(ck[2] >= cd)) + __popcll(__ballot(ck[3] >= cd)));
                if (cnt >= 16) { thr = cd; if (cnt == 16) break; } }
            int base = 0;
#pragma unroll
            for (int m = 0; m < 4; ++m) { const unsigned long long bm = __ballot(ck[m] >= thr);
                const int sl = base + __builtin_amdgcn_mbcnt_hi((unsigned)(bm >> 32), __builtin_amdgcn_mbcnt_lo((unsigned)bm, 0u));
                if (ck[m] >= thr && sl < 16) { fvs[sl] = cand[m]; cds[sl] = lane * 4 + m; }
                base += __popcll(bm); } }
        {   const float fv = (lane < 16) ? fvs[lane] : -3.0e38f; const int code = (lane < 16) ? cds[lane] : 0;
            const float mx = row16_max(fv); const float e = (lane < 16) ? __expf(fv - mx) : 0.f; const float sum = row16_sum(e);
            if (lane < 16) { const int e0 = ri[tk * 16 + (code >> 4)], e1 = ri[(32 + tk) * 16 + (code & 15)];
                EIDX[((size_t)t * 8 + h) * 16 + lane] = e0 * 128 + e1; EGATE[((size_t)t * 8 + h) * 16 + lane] = e / sum; } }
    }
}

__device__ __forceinline__ float wave_sum_u(float x) {
    x = row16_sum(x); const int xi = __float_as_int(x);
    return (__int_as_float(__builtin_amdgcn_readlane(xi, 0)) + __int_as_float(__builtin_amdgcn_readlane(xi, 16))) + (__int_as_float(__builtin_amdgcn_readlane(xi, 32)) + __int_as_float(__builtin_amdgcn_readlane(xi, 48)));
}
template <int FMT> struct RowQ { u32x4 a; u32x2 b; };
template <int FMT> __device__ __forceinline__ constexpr int rowq_elem(int j) { return (FMT == 6 && FP6_INTERLEAVED) ? ((j & 1) ? 16 + (j >> 1) : (j >> 1)) : j; }
template <int FMT> __device__ __forceinline__ void rowq_load(RowQ<FMT>& q, const unsigned char* tab, int eid, int lane) {
    if (FMT == 6) { const unsigned char* row = tab + (size_t)eid * 1536; q.a = *(const u32x4*)(row + 16 * lane); q.b = *(const u32x2*)(row + 1024 + 8 * lane); }
    else { q.a = *(const u32x4*)(tab + (size_t)eid * 1024 + 16 * lane); }
}
template <int FMT> __device__ __forceinline__ void rowq_deq(const RowQ<FMT>& q, f32x2 (&o)[16]) {
    if (FMT == 6) { const u32x6 s = (u32x6){q.a[0], q.a[1], q.a[2], q.a[3], q.b[0], q.b[1]}; const f32x32 r = __builtin_amdgcn_cvt_scalef32_pk32_f32_fp6(s, 1.0f);
#pragma unroll
        for (int k = 0; k < 16; ++k) o[k] = (f32x2){r[2 * k], r[2 * k + 1]}; }
    else {
#pragma unroll
        for (int d = 0; d < 4; ++d) { o[4 * d] = __builtin_amdgcn_cvt_scalef32_pk_f32_fp4(q.a[d], 1.0f, 0); o[4 * d + 1] = __builtin_amdgcn_cvt_scalef32_pk_f32_fp4(q.a[d], 1.0f, 1);
            o[4 * d + 2] = __builtin_amdgcn_cvt_scalef32_pk_f32_fp4(q.a[d], 1.0f, 2); o[4 * d + 3] = __builtin_amdgcn_cvt_scalef32_pk_f32_fp4(q.a[d], 1.0f, 3); } }
}
template <int FMT, int DIAG = 0, bool FINAL = false>
__device__ __forceinline__ void phase_experts(const Frame& F, CP P, int layer, const float* gnext, const bf16_t* XB, void* Xo) {
    const bf16_t* XN = (const bf16_t*)(P->ws + WS_XN); bf16_t* XNo = (bf16_t*)(P->ws + WS_XN);
    const unsigned char* UT = P->ws + WS_UT + (size_t)layer * 32 * MiB; const unsigned char* VT = P->ws + WS_VT + (size_t)layer * 32 * MiB;
    const float* SCU = (const float*)(P->ws + WS_SCALE) + layer * 16384; const float* SCV = SCU + 32768;
    const int* EIDX = (const int*)(P->ws + WS_EIDX); const float* EGATE = (const float*)(P->ws + WS_EGATE);
    const int lane = F.lane;
    for (int t = F.gw; t < M_TOK; t += F.NGW) {
        f32x2 hx[16];
        {   float hn[32];
#pragma unroll
            for (int j = 0; j < 8; ++j) { const u32x2 w = *(const u32x2*)(XN + (size_t)t * DM + 256 * j + 4 * lane); hn[4 * j] = bf_lo(w.x); hn[4 * j + 1] = bf_hi(w.x); hn[4 * j + 2] = bf_lo(w.y); hn[4 * j + 3] = bf_hi(w.y); }
#pragma unroll
            for (int k = 0; k < 16; ++k) hx[k] = (f32x2){hn[rowq_elem<FMT>(2 * k)], hn[rowq_elem<FMT>(2 * k + 1)]}; }
        int i0 = EIDX[(size_t)t * 128 + lane], i1 = EIDX[(size_t)t * 128 + 64 + lane]; if (DIAG == 2) { i0 &= 255; i1 &= 255; }
        const float g0 = EGATE[(size_t)t * 128 + lane], g1 = EGATE[(size_t)t * 128 + 64 + lane];
        float a0 = 0.f, a1 = 0.f;
        const float sc0 = SCU[i0], sc1 = SCU[i1];
#pragma unroll
        for (int half = 0; half < 2; ++half) {
            const int iv = half ? i1 : i0;
            for (int e8 = 0; e8 < 64; e8 += 8) {
                RowQ<FMT> ld[8];
#pragma unroll
                for (int x = 0; x < 8; ++x) { const int eid = __builtin_amdgcn_readlane(iv, e8 + x); rowq_load<FMT>(ld[x], UT, eid, lane); }
                float pv = 0.f;
#pragma unroll
                for (int x = 0; x < 8; ++x) { f32x2 r[16]; rowq_deq<FMT>(ld[x], r); f32x2 s2 = r[0] * hx[0];
#pragma unroll
                    for (int k = 1; k < 16; ++k) s2 = r[k] * hx[k] + s2;
                    const float r16 = row16_sum(s2.x + s2.y); pv = ((lane & 15) == ((e8 + x) & 15)) ? r16 : pv; }
                pv += __shfl_xor(pv, 16); pv += __shfl_xor(pv, 32);
                const float act = gelu1(pv * (half ? sc1 : sc0)) * (half ? g1 : g0);
                if (lane >= e8 && lane < e8 + 8) { if (half) a1 = act; else a0 = act; }
            }
        }
        f32x2 out2[16];
#pragma unroll
        for (int k = 0; k < 16; ++k) out2[k] = (f32x2){0.f, 0.f};
#pragma unroll
        for (int half = 0; half < 2; ++half) {
            const int iv = half ? i1 : i0; const float av = half ? a1 * SCV[i1] : a0 * SCV[i0];
            for (int e8 = 0; e8 < 64; e8 += 8) {
                RowQ<FMT> ld[8]; float ac[8];
#pragma unroll
                for (int x = 0; x < 8; ++x) { const int eid = __builtin_amdgcn_readlane(iv, e8 + x); rowq_load<FMT>(ld[x], VT, eid, lane);
                    ac[x] = __int_as_float(__builtin_amdgcn_readlane(__float_as_int(av), e8 + x)); }
#pragma unroll
                for (int x = 0; x < 8; ++x) { f32x2 r[16]; rowq_deq<FMT>(ld[x], r); const f32x2 a2 = (f32x2){ac[x], ac[x]};
#pragma unroll
                    for (int k = 0; k < 16; ++k) out2[k] = a2 * r[k] + out2[k]; }
            }
        }
        float out[32];
#pragma unroll
        for (int k = 0; k < 16; ++k) { out[rowq_elem<FMT>(2 * k)] = out2[k].x; out[rowq_elem<FMT>(2 * k + 1)] = out2[k].y; }
        const bf16_t* xr = XB + (size_t)t * DM + 4 * lane; float ss = 0.f;
#pragma unroll
        for (int k = 0; k < 8; ++k) { const u32x2 xw = *(const u32x2*)(xr + 256 * k); f32x4 a = (f32x4){bf_lo(xw.x), bf_hi(xw.x), bf_lo(xw.y), bf_hi(xw.y)};
            a.x += out[4 * k + 0]; a.y += out[4 * k + 1]; a.z += out[4 * k + 2]; a.w += out[4 * k + 3];
            if (FINAL) *(f32x4*)((float*)Xo + (size_t)t * DM + 4 * lane + 256 * k) = a;
            else *(u32x2*)((bf16_t*)Xo + (size_t)t * DM + 4 * lane + 256 * k) = (u32x2){pkbf(a.x, a.y), pkbf(a.z, a.w)};
            out[4 * k + 0] = a.x; out[4 * k + 1] = a.y; out[4 * k + 2] = a.z; out[4 * k + 3] = a.w;
            ss += (a.x * a.x + a.y * a.y) + (a.z * a.z + a.w * a.w); }
        if (gnext) { const float rstd = rsqrtf(wave_sum(ss) * (1.0f / DM) + 1e-6f);
#pragma unroll
            for (int k = 0; k < 8; ++k) { const f32x4 g4 = *(const f32x4*)(gnext + 256 * k + 4 * lane);
                *(u32x2*)(XNo + (size_t)t * DM + 256 * k + 4 * lane) = (u32x2){pkbf(out[4 * k] * rstd * g4.x, out[4 * k + 1] * rstd * g4.y), pkbf(out[4 * k + 2] * rstd * g4.z, out[4 * k + 3] * rstd * g4.w)}; } }
    }
}

__device__ __forceinline__ void phase_qknorm(const Frame& F, CP P) {
    bf16_t* QKV = (bf16_t*)(P->ws + WS_QKV); const f32x2* rope = (const f32x2*)(P->ws + WS_ROPE);
    const float* qn = P->in[21]; const float* kn = P->in[22]; const int lane = F.lane, d0 = 8 * (lane & 7), sub = lane & 7;
    for (int t = F.gw; t < M_TOK; t += F.NGW) {
        const int pos = t & (SEQ - 1);
#pragma unroll
        for (int j = 0; j < 8; ++j) {
            bf16_t* p = QKV + (size_t)t * C_COLS + 512 * j + 8 * lane; float v[8]; unpack8(*(const u32x4*)p, v);
            float ss = 0.f;
#pragma unroll
            for (int i = 0; i < 8; ++i) ss += v[i] * v[i];
            ss = oct_sum(ss); const float rstd = rsqrtf(ss * (1.0f / 64.0f) + 1e-6f);
            const float* wn = (j < 4) ? qn : kn; const f32x4 w0 = *(const f32x4*)(wn + d0), w1 = *(const f32x4*)(wn + d0 + 4);
            const float ww[8] = {w0.x, w0.y, w0.z, w0.w, w1.x, w1.y, w1.z, w1.w};
#pragma unroll
            for (int i = 0; i < 8; ++i) v[i] = v[i] * rstd * ww[i];
            float o[8];
#pragma unroll
            for (int i = 0; i < 8; ++i) { const float pr = dpp_mov<0xB1>(v[i]); const f32x2 cs = rope[pos * 8 + i];
                const float rot = (sub == 0) ? (v[i] * cs.x - pr * cs.y) : (v[i] * cs.x + pr * cs.y);
                o[i] = (sub < 2) ? rot : v[i]; }
            if (j < 4) {
#pragma unroll
                for (int i = 0; i < 8; ++i) o[i] *= QSCALE; }
            *(u32x4*)p = pack8(o);
        }
    }
}

constexpr int AT_KB = 9216, AT_BUF = 38912;
__device__ __forceinline__ float max3f(float a, float b, float c) { return __builtin_fmaxf(__builtin_fmaxf(a, b), c); }
template <int VAR>
__device__ __forceinline__ void attn_tile(LAS unsigned char* buf, int kv0, int q0w, int map, int lane, int q31, int hh, int qpos, bool first, const bf16x8 (&qf)[4],
                                          f32x16 (&O)[4], f32x16& negm, float& mref, float& lsum, LAS float* wsc) {
    LAS unsigned char* Kb = buf + map * AT_KB;
    f32x16 p0 = negm, p1 = negm;
#pragma unroll
    for (int ks = 0; ks < 4; ++ks) {
        const bf16x8 a0 = *(LAS bf16x8*)(Kb + q31 * 144 + ks * 32 + hh * 16);
        const bf16x8 a1 = *(LAS bf16x8*)(Kb + (32 + q31) * 144 + ks * 32 + hh * 16);
        if (VAR != 3) { p0 = __builtin_amdgcn_mfma_f32_32x32x16_bf16(a0, qf[ks], p0, 0, 0, 0);
        p1 = __builtin_amdgcn_mfma_f32_32x32x16_bf16(a1, qf[ks], p1, 0, 0, 0); } else { p0[ks] += __builtin_bit_cast(float, (int)a0[0]) ; p1[ks] += __builtin_bit_cast(float, (int)a1[1]); }
    }
    if (kv0 + 63 > q0w) {
#pragma unroll
        for (int r = 0; r < 16; ++r) { const int kv = kv0 + crow(r, hh); if (kv > qpos) p0[r] = -1.0e30f; if (kv + 32 > qpos) p1[r] = -1.0e30f; } }
    if (VAR != 2) {
    float ma = max3f(p0[0], p0[1], p1[0]), mb = max3f(p0[2], p0[3], p1[1]); ma = max3f(ma, p1[2], p1[3]);
#pragma unroll
    for (int r = 4; r < 16; r += 4) { ma = max3f(ma, p0[r], p0[r + 1]); mb = max3f(mb, p0[r + 2], p0[r + 3]); ma = max3f(ma, p1[r], p1[r + 1]); mb = max3f(mb, p1[r + 2], p1[r + 3]); }
    float mx = __builtin_fmaxf(ma, mb);
    {   const auto rr = __builtin_amdgcn_permlane32_swap(__float_as_uint(mx), __float_as_uint(mx), false, false); mx = __builtin_fmaxf(__uint_as_float(rr[0]), __uint_as_float(rr[1])); }
    if (first || __any(mx > 0.f)) {
        const float dl = first ? mx : __builtin_fmaxf(mx, 0.f); mref += dl;
#pragma unroll
        for (int r = 0; r < 16; ++r) { p0[r] -= dl; p1[r] -= dl; negm[r] = -mref; }
        if (first) lsum = 0.f;
        else { const float alpha = __builtin_amdgcn_exp2f(-dl); lsum *= alpha;
            if (hh == 0) wsc[q31] = alpha;
#pragma unroll
            for (int g = 0; g < 4; ++g) { const f32x4 al = *(LAS f32x4*)(wsc + 8 * g + 4 * hh);
#pragma unroll
                for (int d = 0; d < 4; ++d) { O[d][4 * g + 0] *= al.x; O[d][4 * g + 1] *= al.y; O[d][4 * g + 2] *= al.z; O[d][4 * g + 3] *= al.w; } } }
    }
    float ps0 = 0.f, ps1 = 0.f;
#pragma unroll
    for (int r = 0; r < 16; ++r) { p0[r] = __builtin_amdgcn_exp2f(p0[r]); p1[r] = __builtin_amdgcn_exp2f(p1[r]); ps0 += p0[r]; ps1 += p1[r]; }
    lsum += ps0 + ps1;
    }
    bf16x8 pa[4];
#pragma unroll
    for (int s = 0; s < 2; ++s) {
        u32x4 w0, w1;
        w0.x = pkbf(p0[8 * s + 0], p0[8 * s + 1]); w0.y = pkbf(p0[8 * s + 2], p0[8 * s + 3]); w0.z = pkbf(p0[8 * s + 4], p0[8 * s + 5]); w0.w = pkbf(p0[8 * s + 6], p0[8 * s + 7]);
        w1.x = pkbf(p1[8 * s + 0], p1[8 * s + 1]); w1.y = pkbf(p1[8 * s + 2], p1[8 * s + 3]); w1.z = pkbf(p1[8 * s + 4], p1[8 * s + 5]); w1.w = pkbf(p1[8 * s + 6], p1[8 * s + 7]);
        pa[s] = __builtin_bit_cast(bf16x8, w0); pa[2 + s] = __builtin_bit_cast(bf16x8, w1); }
    LAS unsigned char* Vb = buf + 2 * AT_KB + (4 * hh + ((lane >> 2) & 3)) * 320 + (16 * ((lane >> 4) & 1) + 4 * (lane & 3)) * 2;
#pragma unroll
    for (int kst = 0; kst < 4; ++kst)
#pragma unroll
        for (int d = 0; d < 4; ++d) {
            if (VAR == 1) { O[d][kst] += __builtin_bit_cast(float, (int)pa[kst][d]); continue; }
            const s16x4 lo = vtr(Vb + (16 * kst) * 320 + d * 64), hi = vtr(Vb + (16 * kst + 8) * 320 + d * 64);
            const bf16x8 vf = (bf16x8){lo[0], lo[1], lo[2], lo[3], hi[0], hi[1], hi[2], hi[3]};
            O[d] = __builtin_amdgcn_mfma_f32_32x32x16_bf16(pa[kst], vf, O[d], 0, 0, 0);
        }
}
template <int VAR = 0>
__device__ __forceinline__ void attn_unit(const Frame& F, CP P, int bh, int qb, float lam) {
    const int tid = F.tid, wave = F.wave, lane = F.lane, map = wave >> 2, wq = wave & 3, q31 = lane & 31, hh = lane >> 5;
    const int b = bh >> 4, h = bh & 15, q0 = qb * 128;
    const bf16_t* QKV = (const bf16_t*)(P->ws + WS_QKV) + (size_t)b * SEQ * C_COLS; bf16_t* OB = (bf16_t*)(P->ws + (VAR ? WS_PA : WS_OB));
    const float* subln = P->in[27];
    LAS unsigned char* lds = F.lds; LAS float* wsc = (LAS float*)(lds + 2 * AT_BUF) + wave * 32;
    bf16x8 qf[4];
    {   const bf16_t* qp = QKV + (size_t)(q0 + 32 * wq + q31) * C_COLS + h * 128 + map * 64 + 8 * hh;
#pragma unroll
        for (int ks = 0; ks < 4; ++ks) qf[ks] = *(const bf16x8*)(qp + 16 * ks); }
    const int NT = 2 * qb + 2;
    const int krow = tid >> 3, kc8 = tid & 7;
    const unsigned koff = (unsigned)((krow * C_COLS + 2048 + h * 128 + kc8 * 8) * 2), voff = (unsigned)(((tid >> 4) * C_COLS + 4096 + h * 128 + (tid & 15) * 8) * 2);
    const unsigned char* qkvb = (const unsigned char*)QKV;
    const int kdst = krow * 144 + kc8 * 16, vdst = 2 * AT_KB + (tid >> 4) * 320 + (tid & 15) * 16;
    u32x4 pfA[4], pfB[4];
#define AT_LOAD(pf, tt) do { const unsigned char* tb = qkvb + (size_t)(tt) * (64 * C_COLS * 2); pf[0] = *(const u32x4*)(tb + koff); pf[1] = *(const u32x4*)(tb + koff + 128); \
        pf[2] = *(const u32x4*)(tb + voff); pf[3] = *(const u32x4*)(tb + voff + 32 * C_COLS * 2); } while (0)
#define AT_STORE(pf, bufp) do { *(LAS u32x4*)((bufp) + kdst) = pf[0]; *(LAS u32x4*)((bufp) + AT_KB + kdst) = pf[1]; *(LAS u32x4*)((bufp) + vdst) = pf[2]; *(LAS u32x4*)((bufp) + vdst + 32 * 320) = pf[3]; } while (0)
    AT_LOAD(pfA, 0); AT_LOAD(pfB, 1); AT_STORE(pfA, lds); __syncthreads();
    asm volatile("" :: "v"(qf[0]), "v"(qf[1]), "v"(qf[2]), "v"(qf[3]));
    f32x16 O[4];
#pragma unroll
    for (int d = 0; d < 4; ++d)
#pragma unroll
        for (int r = 0; r < 16; ++r) O[d][r] = 0.f;
    float mrow = 0.f, lsum = 0.f; f32x16 negm;
#pragma unroll
    for (int r = 0; r < 16; ++r) negm[r] = 0.f;
    const int qpos = q0 + 32 * wq + q31, q0w = q0 + 32 * wq;
    for (int tt = 0; tt < NT; tt += 2) {
        if (VAR != 4 && tt + 2 < NT) AT_LOAD(pfA, tt + 2);
        if (tt * 64 <= q0w + 31) attn_tile<VAR>(lds, tt * 64, q0w, map, lane, q31, hh, qpos, tt == 0, qf, O, negm, mrow, lsum, wsc);
        if (VAR != 4) AT_STORE(pfB, lds + AT_BUF);
        __syncthreads();
        if (VAR != 4 && tt + 3 < NT) AT_LOAD(pfB, tt + 3);
        if ((tt + 1) * 64 <= q0w + 31) attn_tile<VAR>(lds + AT_BUF, (tt + 1) * 64, q0w, map, lane, q31, hh, qpos, false, qf, O, negm, mrow, lsum, wsc);
        if (VAR != 4 && tt + 2 < NT) AT_STORE(pfA, lds);
        __syncthreads();
    }
#undef AT_LOAD
#undef AT_STORE
    {   const float lt = lsum + __shfl_xor(lsum, 32); if (hh == 0) wsc[q31] = 1.0f / lt;
#pragma unroll
        for (int g = 0; g < 4; ++g) { const f32x4 al = *(LAS f32x4*)(wsc + 8 * g + 4 * hh);
#pragma unroll
            for (int d = 0; d < 4; ++d) { O[d][4 * g + 0] *= al.x; O[d][4 * g + 1] *= al.y; O[d][4 * g + 2] *= al.z; O[d][4 * g + 3] *= al.w; } } }
    LAS float* xch = (LAS float*)lds;
    if (map == 1) {
#pragma unroll
        for (int d = 0; d < 4; ++d)
#pragma unroll
            for (int r = 0; r < 16; ++r) xch[(wq * 64 + d * 16 + r) * 64 + lane] = O[d][r]; }
    __syncthreads();
    if (map == 0) {
        float ss[16];
#pragma unroll
        for (int r = 0; r < 16; ++r) ss[r] = 0.f;
#pragma unroll
        for (int d = 0; d < 4; ++d)
#pragma unroll
            for (int r = 0; r < 16; ++r) { const float o = O[d][r] - lam * xch[(wq * 64 + d * 16 + r) * 64 + lane]; O[d][r] = o; ss[r] += o * o; }
        float sl[4];
#pragma unroll
        for (int d = 0; d < 4; ++d) sl[d] = subln[d * 32 + q31];
#pragma unroll
        for (int r = 0; r < 16; ++r) { float s = row16_sum(ss[r]); s += __shfl_xor(s, 16); const float rs = rsqrtf(s * (1.0f / 128.0f) + 1e-5f) * (1.0f - LAMBDA_INIT);
            const size_t tok = (size_t)b * SEQ + q0 + 32 * wq + crow(r, hh);
#pragma unroll
            for (int d = 0; d < 4; ++d) OB[tok * DM + h * 128 + d * 32 + q31] = (bf16_t)(pkbf(O[d][r] * rs * sl[d], 0.f) & 0xffffu); }
    }
    __syncthreads();
}

constexpr int CK_C = 32;
constexpr size_t WS_PHI = 132 * MiB  , WS_RP = 260 * MiB  , WS_Y0T = 292 * MiB  , WS_PSI = 676 * MiB  ;
constexpr int CP_SZ = 67584;
constexpr int CP_RT = 0, CP_AT = 4608, CP_BT = 9216, CP_KT = 13824, CP_WTT = 4608  , CP_U0T = 9728  ;
constexpr int CP_ATT = 18432, CP_BHT = 23552, CP_KHT = 28672, CP_VT = 33792, CP_AKVT = 38912;
constexpr int CP_PW = 44032  , CP_X = 54272  , CP_AAK = 59392, CP_ARB = 61952, CP_ARK = 64512, CP_D = 44032  , CP_GC = 67072  ;
__device__ __forceinline__ int ck_pos(int j) { return (j >> 5) * 32 + ((j >> 2) & 3) * 8 + ((j >> 4) & 1) * 4 + (j & 3); }
__device__ __forceinline__ f32x16 ck_mm(f32x16 acc, const LAS unsigned char* A, int pa, const LAS unsigned char* Bt, int pb, int nks, int lane) {
    const LAS unsigned char* ap = A + (lane & 31) * pa + (lane >> 5) * 16; const LAS unsigned char* bp = Bt + (lane & 31) * pb + (lane >> 5) * 16;
    for (int ks = 0; ks < nks; ++ks) acc = __builtin_amdgcn_mfma_f32_32x32x16_bf16(*(const LAS bf16x8*)(ap + ks * 32), *(const LAS bf16x8*)(bp + ks * 32), acc, 0, 0, 0);
    return acc;
}
__device__ __forceinline__ f32x16 ck_zero() { f32x16 z; for (int r = 0; r < 16; ++r) z[r] = 0.f; return z; }
__device__ __forceinline__ void ck_st(LAS unsigned char* dst, int pitch, const f32x16& a, int lane) {
    const int col = lane & 31, hh = lane >> 5;
#pragma unroll
    for (int r = 0; r < 16; ++r) *(LAS bf16_t*)(dst + crow(r, hh) * pitch + col * 2) = (bf16_t)(pkbf_c(a[r], 0.f) & 0xffffu);
}
__device__ __forceinline__ void ck_stT(LAS unsigned char* dst, int pitch, const f32x16& a, int lane) {
    const int col = lane & 31, hh = lane >> 5;
#pragma unroll
    for (int g = 0; g < 4; ++g) *(LAS u32x2*)(dst + col * pitch + (8 * g + 4 * hh) * 2) = (u32x2){pkbf_c(a[4 * g], a[4 * g + 1]), pkbf_c(a[4 * g + 2], a[4 * g + 3])};
}
__device__ __forceinline__ void ck_bar() { asm volatile("s_waitcnt lgkmcnt(0)" ::: "memory"); __syncthreads(); }

__device__ __forceinline__ void chunk_prep_fetch(CP P, int pair, int wave, int tid, u32x4 (&raw)[8]) {
    const int hf = wave >> 2, htid = tid & 255, item = 2 * pair + hf, bh = item >> 7, cc = item & 127, t = htid >> 3, j8 = (htid & 7) * 8, tt = cc * 32 + t, hc = (bh & 15) * 64 + j8;
    const size_t tg = (size_t)(bh >> 4) * SEQ + tt; const bf16_t* row = (const bf16_t*)(P->ws + WS_PA) + tg * A_COLS + hc; const u32x4 z4 = (u32x4){0u, 0u, 0u, 0u};
    raw[0] = *(const u32x4*)row; raw[1] = *(const u32x4*)(row + 1024); raw[2] = *(const u32x4*)(row + 2048);
    raw[3] = tt ? *(const u32x4*)(row - A_COLS) : z4; raw[4] = tt ? *(const u32x4*)(row - A_COLS + 1024) : z4; raw[5] = tt ? *(const u32x4*)(row - A_COLS + 2048) : z4;
    raw[6] = *(const u32x4*)((const bf16_t*)(P->ws + WS_ICLR) + tg * 1024 + hc); raw[7] = *(const u32x4*)((const bf16_t*)(P->ws + WS_DLOG) + tg * 1024 + hc);
}
constexpr int CP_PAR = 2 * CP_SZ;
template <int ABL = 0>
__device__ __forceinline__ void chunk_prep_pair(const Frame& F, CP P, int pair, int next_pair, u32x4 (&raw)[8]) {
    const int hf = F.wave >> 2, hw = F.wave & 3, htid = F.tid & 255, lane = F.lane; const int item = 2 * pair + hf;
    f32x4 qrow[8]; const int qr0 = (pair * 8 + F.wave) * 2; quant_load(P, qr0, lane, qrow);
    LAS unsigned char* L = F.lds + hf * CP_SZ;
    const int bh = item >> 7, cc = item & 127, bb_ = bh >> 4, hd = bh & 15;
    bf16_t* PHI = (bf16_t*)(P->ws + WS_PHI) + (size_t)item * 4096; bf16_t* RPo = (bf16_t*)(P->ws + WS_RP) + (size_t)item * 2048;
    bf16_t* Y0T = (bf16_t*)(P->ws + WS_Y0T) + (size_t)item * 2048; bf16_t* PSI = (bf16_t*)(P->ws + WS_PSI) + (size_t)item * 4096;
    {   const int t = htid >> 3, j8 = (htid & 7) * 8, tt = cc * 32 + t; const size_t tg = (size_t)bb_ * SEQ + tt;
        float rr[8], dd[8], kf[8], vv[8], kq[8], bb[8], tp[8];
        const LAS float* par = (const LAS float*)(F.lds + CP_PAR) + j8; float pp[8];
#define CK_PAR(a_) do { const f32x4 x_ = *(const LAS f32x4*)(par + (a_) * 64), y_ = *(const LAS f32x4*)(par + (a_) * 64 + 4); pp[0] = x_.x; pp[1] = x_.y; pp[2] = x_.z; pp[3] = x_.w; pp[4] = y_.x; pp[5] = y_.y; pp[6] = y_.z; pp[7] = y_.w; } while (0)
#define CK_SHIFT(x, ri) do { unpack8(raw[ri], x); unpack8(raw[(ri) + 3], tp); CK_PAR(ri); _Pragma("unroll") for (int i = 0; i < 8; ++i) x[i] += (tp[i] - x[i]) * pp[i]; } while (0)
        CK_SHIFT(rr, 0); CK_SHIFT(kf, 1); CK_SHIFT(vv, 2);
        float ic[8]; unpack8(raw[6], ic); unpack8(raw[7], dd);
        if (next_pair >= 0) chunk_prep_fetch(P, next_pair, F.wave, F.tid, raw);
        float ss_ = 0.f;
        CK_PAR(3);
#pragma unroll
        for (int i = 0; i < 8; ++i) { kq[i] = kf[i] * pp[i]; ss_ += kq[i] * kq[i]; }
        ss_ = oct_sum(ss_); const float rn_ = rsqrtf(fmaxf(ss_, 1e-12f));
        CK_PAR(4);
#pragma unroll
        for (int i = 0; i < 8; ++i) { kq[i] *= rn_; kf[i] = kf[i] * (1.0f + (ic[i] - 1.0f) * pp[i]); bb[i] = kq[i] * ic[i]; }
        float bs_ = 0.f;
        CK_PAR(5);
#pragma unroll
        for (int i = 0; i < 8; ++i) bs_ += rr[i] * kf[i] * pp[i];
        bs_ = oct_sum(bs_);
        if ((htid & 7) == 0) ((float*)(P->ws + WS_BONUS))[tg * 16 + hd] = bs_;
#undef CK_SHIFT
#undef CK_PAR
        *(LAS f32x4*)(L + CP_D + (t * 64 + j8) * 4) = (f32x4){dd[0], dd[1], dd[2], dd[3]}; *(LAS f32x4*)(L + CP_D + (t * 64 + j8 + 4) * 4) = (f32x4){dd[4], dd[5], dd[6], dd[7]};
        ck_bar();
        f32x4 a0 = (f32x4){0.f, 0.f, 0.f, 0.f}, a1 = a0, m0 = a0, m1 = a0, t0 = a0, t1 = a0;
        for (int s = 0; s < CK_C; ++s) { if (s == t) { m0 = a0; m1 = a1; } a0 += *(const LAS f32x4*)(L + CP_D + (s * 64 + j8) * 4); a1 += *(const LAS f32x4*)(L + CP_D + (s * 64 + j8 + 4) * 4); if (s == t) { t0 = a0; t1 = a1; } }
        const float Dm1[8] = {m0[0], m0[1], m0[2], m0[3], m1[0], m1[1], m1[2], m1[3]}, Dt[8] = {t0[0], t0[1], t0[2], t0[3], t1[0], t1[1], t1[2], t1[3]}, DC[8] = {a0[0], a0[1], a0[2], a0[3], a1[0], a1[1], a1[2], a1[3]};
        ck_bar();
        float at[8], rt[8], bt[8], kt[8], bh[8], kh[8];
#pragma unroll
        for (int q = 0; q < 8; ++q) { const float em1 = __expf(-Dm1[q]), e0 = __expf(-Dt[q]), ep = __expf(Dt[q]), ec = __expf(Dt[q] - DC[q]);
            at[q] = -kq[q] * em1; rt[q] = rr[q] * e0; bt[q] = bb[q] * ep; kt[q] = kf[q] * ep; bh[q] = bb[q] * ec; kh[q] = kf[q] * ec; }
        *(LAS u32x4*)(L + CP_AT + t * 144 + j8 * 2) = (u32x4){pkbf(at[0], at[1]), pkbf(at[2], at[3]), pkbf(at[4], at[5]), pkbf(at[6], at[7])};
        *(LAS u32x4*)(L + CP_RT + t * 144 + j8 * 2) = (u32x4){pkbf(rt[0], rt[1]), pkbf(rt[2], rt[3]), pkbf(rt[4], rt[5]), pkbf(rt[6], rt[7])};
        *(LAS u32x4*)(L + CP_BT + t * 144 + j8 * 2) = (u32x4){pkbf(bt[0], bt[1]), pkbf(bt[2], bt[3]), pkbf(bt[4], bt[5]), pkbf(bt[6], bt[7])};
        *(LAS u32x4*)(L + CP_KT + t * 144 + j8 * 2) = (u32x4){pkbf(kt[0], kt[1]), pkbf(kt[2], kt[3]), pkbf(kt[4], kt[5]), pkbf(kt[6], kt[7])};
#pragma unroll
        for (int q = 0; q < 8; ++q) { const int o = (j8 + q) * 80 + t * 2;
            *(LAS bf16_t*)(L + CP_ATT + o) = (bf16_t)(pkbf(at[q], 0.f) & 0xffffu); *(LAS bf16_t*)(L + CP_BHT + o) = (bf16_t)(pkbf(bh[q], 0.f) & 0xffffu);
            *(LAS bf16_t*)(L + CP_KHT + o) = (bf16_t)(pkbf(kh[q], 0.f) & 0xffffu); *(LAS bf16_t*)(L + CP_VT + o) = (bf16_t)(pkbf(vv[q], 0.f) & 0xffffu);
            if (t == CK_C - 1) *(LAS float*)(L + CP_GC + (j8 + q) * 4) = __expf(-DC[q]); }
    }
    ck_bar();
    if (ABL == 2) { quant_finish(P, qr0, lane, qrow); return; }
    const int col = lane & 31, hh = lane >> 5;
    {   const int pi = hw >> 1, qi = hw & 1;
        f32x16 a = ck_mm(ck_zero(), L + (pi ? CP_RT : CP_AT), 144, L + (qi ? CP_KT : CP_BT), 144, 4, lane);
#pragma unroll
        for (int r = 0; r < 16; ++r) { const int t = crow(r, hh); if (pi == 0 ? (col >= t) : (col > t)) a[r] = 0.f; }
        if (hw == 0) { ck_st(L + CP_PW, 80, a, lane); ck_stT(L + CP_PW + 2560, 80, a, lane);
#pragma unroll
            for (int r = 0; r < 16; ++r) if (crow(r, hh) == col) a[r] += 1.0f;
            ck_st(L + CP_X, 80, a, lane);
            asm volatile("s_waitcnt lgkmcnt(0)" ::: "memory");
            const f32x16 q = ck_mm(ck_zero(), L + CP_PW, 80, L + CP_PW + 2560, 80, 2, lane); ck_st(L + CP_PW + 5120, 80, q, lane); ck_stT(L + CP_PW + 5120 + 2560, 80, q, lane); }
        else ck_st(L + (hw == 1 ? CP_AAK : (hw == 2 ? CP_ARB : CP_ARK)), 80, a, lane);
    }
    quant_finish(P, qr0, lane, qrow); quant_load(P, qr0 + 1, lane, qrow);
    ck_bar();
    for (int r = 2; r <= (ABL == 1 ? 2 : 5); ++r) {
        const LAS unsigned char* pc = L + CP_PW + ((r - 1) & 1) * 5120; LAS unsigned char* pn = L + CP_PW + (r & 1) * 5120;
        if (hw == 0 && r <= 4) { const f32x16 a = ck_mm(ck_zero(), pc, 80, pc + 2560, 80, 2, lane); ck_st(pn, 80, a, lane); ck_stT(pn + 2560, 80, a, lane); }
        if (hw == 1 && r >= 2) {
            const LAS unsigned char* xc = L + CP_X + (r & 1) * 2560; LAS unsigned char* xn = L + CP_X + ((r + 1) & 1) * 2560;
            f32x16 a;
#pragma unroll
            for (int q = 0; q < 16; ++q) a[q] = bf_1(*(const LAS bf16_t*)(xc + crow(q, hh) * 80 + col * 2));
            a = ck_mm(a, xc, 80, pc + 2560, 80, 2, lane); ck_st(xn, 80, a, lane); }
        if (r == 2 && hw >= 2) { const int ih = hw - 2;
            const f32x16 a = ck_mm(ck_zero(), L + CP_AAK, 80, L + CP_VT + ih * 2560, 80, 2, lane); ck_stT(L + CP_AKVT + ih * 2560, 80, a, lane); }
        ck_bar();
    }
    const LAS unsigned char* Tn = L + CP_X;
    if (hw < 2) { const f32x16 a = ck_mm(ck_zero(), Tn, 80, L + CP_ATT + hw * 2560, 80, 2, lane); ck_stT(L + CP_WTT + hw * 2560, 80, a, lane); }
    else { const int ih = hw - 2; const f32x16 a = ck_mm(ck_zero(), Tn, 80, L + CP_AKVT + ih * 2560, 80, 2, lane); ck_stT(L + CP_U0T + ih * 2560, 80, a, lane); }
    ck_bar();
    {   const int jph = hw >> 1, jh = hw & 1;
        f32x16 a = ck_mm(ck_zero(), L + CP_BHT + jph * 2560, 80, L + CP_WTT + jh * 2560, 80, 2, lane);
        const int j = 32 * jh + col; const int pj = ck_pos(j);
#pragma unroll
        for (int r = 0; r < 16; ++r) { const int jp = 32 * jph + crow(r, hh); float x = a[r]; if (jp == j) x += *(const LAS float*)(L + CP_GC + j * 4);
            PHI[jp * 64 + pj] = (bf16_t)(pkbf_c(x, 0.f) & 0xffffu); } }
    {   const int jph = hw >> 1, ih = hw & 1;
        f32x16 a = ck_mm(ck_zero(), L + CP_BHT + jph * 2560, 80, L + CP_U0T + ih * 2560, 80, 2, lane);
        a = ck_mm(a, L + CP_KHT + jph * 2560, 80, L + CP_VT + ih * 2560, 80, 2, lane);
        const int i = 32 * ih + col;
#pragma unroll
        for (int g = 0; g < 4; ++g) *(u32x2*)(PSI + i * 64 + 32 * jph + 8 * g + 4 * hh) = (u32x2){pkbf_c(a[4 * g], a[4 * g + 1]), pkbf_c(a[4 * g + 2], a[4 * g + 3])}; }
    if (hw < 2) { const int jh = hw;
        f32x16 a;
        const int j = 32 * jh + col; const int pj = ck_pos(j);
#pragma unroll
        for (int r = 0; r < 16; ++r) a[r] = bf_1(*(const LAS bf16_t*)(L + CP_RT + crow(r, hh) * 144 + j * 2));
        a = ck_mm(a, L + CP_ARB, 80, L + CP_WTT + jh * 2560, 80, 2, lane);
#pragma unroll
        for (int r = 0; r < 16; ++r) RPo[crow(r, hh) * 64 + pj] = (bf16_t)(pkbf_c(a[r], 0.f) & 0xffffu);
    } else { const int ih = hw - 2;
        f32x16 a = ck_mm(ck_zero(), L + CP_ARB, 80, L + CP_U0T + ih * 2560, 80, 2, lane);
        a = ck_mm(a, L + CP_ARK, 80, L + CP_VT + ih * 2560, 80, 2, lane);
        const int i = 32 * ih + col;
#pragma unroll
        for (int g = 0; g < 4; ++g) *(u32x2*)(Y0T + i * 32 + 8 * g + 4 * hh) = (u32x2){pkbf_c(a[4 * g], a[4 * g + 1]), pkbf_c(a[4 * g + 2], a[4 * g + 3])};
    }
    quant_finish(P, qr0 + 1, lane, qrow);
    ck_bar();
}

typedef float f32x4v __attribute__((ext_vector_type(4)));
__device__ __forceinline__ void chunk_scan_unit4(const Frame& F, CP P, int u, LAS unsigned char* lsf, volatile LAS unsigned* cnt) {
    const int lane = F.lane, T = F.wave, bh = u >> 2, sl = u & 3, b = bh >> 4, h = bh & 15, li = lane & 15, g = lane >> 4;
    const bf16_t* PHI = (const bf16_t*)(P->ws + WS_PHI) + (size_t)bh * 128 * 4096 + (16 * T + li) * 64 + g * 8;
    const bf16_t* PSI = (const bf16_t*)(P->ws + WS_PSI) + (size_t)bh * 128 * 4096 + (16 * sl + li) * 64 + 16 * T + 4 * g;
    const bf16_t* RPi = (const bf16_t*)(P->ws + WS_RP) + (size_t)bh * 128 * 2048 + (16 * (T & 1) + li) * 64 + g * 8;
    const bf16_t* Y0T = (const bf16_t*)(P->ws + WS_Y0T) + (size_t)bh * 128 * 2048 + (16 * sl + li) * 32 + 16 * (T & 1) + 4 * g;
    float* Y = (float*)(P->ws + WS_Y) + (size_t)b * SEQ * 1024 + h * 64 + 16 * sl + li;
    const bool yw = T < 2;
    f32x4v S = (f32x4v){0.f, 0.f, 0.f, 0.f};
    bf16x8 phi[8][2], rp[8][2]; u32x2 psi[8], y0[8];
#define CS_LOAD(k, c) do { phi[k][0] = *(const bf16x8*)(PHI + (size_t)(c) * 4096); phi[k][1] = *(const bf16x8*)(PHI + (size_t)(c) * 4096 + 32); psi[k] = *(const u32x2*)(PSI + (size_t)(c) * 4096); \
        if (yw) { rp[k][0] = *(const bf16x8*)(RPi + (size_t)(c) * 2048); rp[k][1] = *(const bf16x8*)(RPi + (size_t)(c) * 2048 + 32); y0[k] = *(const u32x2*)(Y0T + (size_t)(c) * 2048); } } while (0)
#pragma unroll
    for (int k = 0; k < 8; ++k) CS_LOAD(k, k);
    LAS unsigned char* mine = lsf + (T >> 1) * 1024 + lane * 16 + (T & 1) * 8;
    for (int c0 = 0; c0 < 128; c0 += 8) {
#pragma unroll
        for (int k = 0; k < 8; ++k) { const int c = c0 + k; LAS unsigned char* img = lsf + (c & 1) * 2048;
            *(LAS u32x2*)(mine + (c & 1) * 2048) = (u32x2){pkbf_c(S[0], S[1]), pkbf_c(S[2], S[3])};
            if (lane == 0) __hip_atomic_fetch_add((LAS unsigned*)cnt, 1u, __ATOMIC_RELAXED, __HIP_MEMORY_SCOPE_WORKGROUP);
            const unsigned want = 4u * (unsigned)(c + 1);
            while (*cnt < want) { }
            const bf16x8 sf0 = *(const LAS bf16x8*)(img + lane * 16), sf1 = *(const LAS bf16x8*)(img + 1024 + lane * 16);
            if (yw) { f32x4v a = (f32x4v){bf_lo(y0[k].x), bf_hi(y0[k].x), bf_lo(y0[k].y), bf_hi(y0[k].y)};
                a = __builtin_amdgcn_mfma_f32_16x16x32_bf16(rp[k][0], sf0, a, 0, 0, 0); a = __builtin_amdgcn_mfma_f32_16x16x32_bf16(rp[k][1], sf1, a, 0, 0, 0);
#pragma unroll
                for (int r = 0; r < 4; ++r) Y[(size_t)(c * 32 + 16 * T + 4 * g + r) * 1024] = a[r]; }
            {   f32x4v a = (f32x4v){bf_lo(psi[k].x), bf_hi(psi[k].x), bf_lo(psi[k].y), bf_hi(psi[k].y)};
                a = __builtin_amdgcn_mfma_f32_16x16x32_bf16(phi[k][0], sf0, a, 0, 0, 0); a = __builtin_amdgcn_mfma_f32_16x16x32_bf16(phi[k][1], sf1, a, 0, 0, 0); S = a; }
            if (c + 8 < 128) CS_LOAD(k, c + 8);
        }
    }
#undef CS_LOAD
}
#define XB_TMO      128
#define XB_XCNT(j)  (256  + 64 * (j))
#define XB_XSUB(j)  (1280 + 64 * (j))
#define XB_XGEN(j)  (2304 + 64 * (j))
#define XB_TOP      3328
#define XB_TOPGEN   3392
#define XCD_BAR_WORDS 3456
#define XB_SPIN_CAP (1u << 18)

__device__ __forceinline__ unsigned xb_ld(unsigned* p)              { return __hip_atomic_load(p, __ATOMIC_RELAXED, __HIP_MEMORY_SCOPE_AGENT); }
__device__ __forceinline__ unsigned xb_add(unsigned* p, unsigned v) { return __hip_atomic_fetch_add(p, v, __ATOMIC_RELAXED, __HIP_MEMORY_SCOPE_AGENT); }
__device__ __forceinline__ unsigned xb_xcc_id() { return (unsigned)__builtin_amdgcn_s_getreg((3 << 11) | 20) & 0xFu; }
#define XB_SPIN(cond, bar) do { unsigned _sp = 0; while (cond) { __builtin_amdgcn_s_sleep(1); \
    if ((++_sp & 255u) == 0u) { if (xb_ld(&(bar)[XB_TMO])) break; if (_sp > XB_SPIN_CAP) { atomicAdd(&(bar)[XB_TMO], 1u); break; } } } } while (0)

struct XcdBarrier {
    unsigned* bar; unsigned x;
    volatile LAS unsigned* st;
};

__device__ __forceinline__ XcdBarrier xcd_barrier_post(unsigned* bar, volatile LAS unsigned* st) {
    XcdBarrier b; b.bar = bar; b.x = xb_xcc_id(); b.st = st;
    if (threadIdx.x == 0) (void)xb_add(&bar[XB_XCNT(b.x)], 1u);
    return b;
}
__device__ __forceinline__ void xcd_barrier_complete(unsigned* bar, unsigned x, unsigned& nloc, unsigned& nx) {
    const unsigned G = gridDim.x * gridDim.y * gridDim.z;
    unsigned sum, cnt, mine, sp = 0u;
    for (;;) {
        sum = 0u; cnt = 0u; mine = 0u;
#pragma unroll
        for (unsigned j = 0; j < 16; ++j) { const unsigned c = xb_ld(&bar[XB_XCNT(j)]); sum += c; cnt += (c > 0u) ? 1u : 0u; mine = (j == x) ? c : mine; }
        if (sum == G) break;
        __builtin_amdgcn_s_sleep(1);
        if ((++sp & 255u) == 0u) { if (xb_ld(&bar[XB_TMO])) break; if (sp > XB_SPIN_CAP) { atomicAdd(&bar[XB_TMO], 1u); break; } }
    }
    nloc = mine > 0u ? mine : 1u; nx = cnt > 0u ? cnt : 1u;
}

__device__ __forceinline__ void xcd_barrier(const XcdBarrier& b) {
    asm volatile("s_waitcnt vmcnt(0)" ::: "memory");
    __syncthreads();
    if (threadIdx.x == 0) {
        unsigned* bar = b.bar;
        __builtin_amdgcn_s_waitcnt(0);
        unsigned nloc = b.st[0], nx = b.st[1];
        if (nloc == 0u) { xcd_barrier_complete(bar, b.x, nloc, nx); b.st[0] = nloc; b.st[1] = nx; }
        const unsigned old = xb_add(&bar[XB_XSUB(b.x)], 1u);
        const unsigned gen = old / nloc;
        if (old + 1u == (gen + 1u) * nloc) {
            __builtin_amdgcn_fence(__ATOMIC_RELEASE, "agent");
            asm volatile("s_waitcnt vmcnt(0)" ::: "memory");
            const unsigned og = xb_add(&bar[XB_TOP], 1u);
            const unsigned tg = og / nx;
            if (og + 1u == (tg + 1u) * nx) xb_add(&bar[XB_TOPGEN], 1u);
            else XB_SPIN(xb_ld(&bar[XB_TOPGEN]) == tg, bar);
            __builtin_amdgcn_fence(__ATOMIC_ACQUIRE, "agent");
            xb_add(&bar[XB_XGEN(b.x)], 1u);
            asm volatile("s_waitcnt vmcnt(0)" ::: "memory");
        } else {
            XB_SPIN(xb_ld(&bar[XB_XGEN(b.x)]) == gen, bar);
            __builtin_amdgcn_fence(__ATOMIC_ACQUIRE, "agent");
            asm volatile("s_waitcnt vmcnt(0)" ::: "memory");
        }
    }
    __syncthreads();
}

#ifndef MK_ONE_LAUNCH
#define MK_ONE_LAUNCH 1
#endif
constexpr int N_PHASES = 20;
#ifndef PROBE_REP
#define PROBE_REP (-1)
#endif
#define REPS(k) for (int rep_ = 0; rep_ < ((PROBE_REP == (k)) ? 2 : 1); ++rep_)
struct Args { Ptrs p; int ph_lo, ph_hi; };

__global__ void __launch_bounds__(NTHREADS, 2) fwd_kernel(Args args) {
    extern __shared__ __attribute__((aligned(16))) unsigned char lds_raw[];
    const int tid0 = threadIdx.x;
    const CP P0 = launder((CP)__builtin_amdgcn_kernarg_segment_ptr());
    const int lo = ((const __attribute__((address_space(4))) int*)P0)[70], hi = ((const __attribute__((address_space(4))) int*)P0)[71];
#define PH_BEGIN Frame F; { int t_ = tid0; asm volatile("" : "+v"(t_)); F.lds = (LAS unsigned char*)lds_raw; F.tid = t_; F.lane = t_ & 63; F.wave = __builtin_amdgcn_readfirstlane(t_ >> 6); \
        F.G = gridDim.x; F.bid = blockIdx.x; F.gw = F.bid * NWAVES + F.wave; F.NGW = F.G * NWAVES; } const CP P = launder(P0); unsigned char* const ws = P->ws; bf16_t* const XN = (bf16_t*)(ws + WS_XN); (void)XN;
    cg::grid_group grid = cg::this_grid();
    for (int u = tid0; u < 64; u += NTHREADS) ((LAS unsigned*)((LAS unsigned char*)lds_raw + LDS_BYTES - 256))[u] = 0u;
    __syncthreads();
    const XcdBarrier bar = xcd_barrier_post((unsigned*)(P0->ws + WS_CTL) + 4096, (volatile LAS unsigned*)((LAS unsigned char*)lds_raw + LDS_BYTES - 256) + 8);
#define IN(k) (lo <= (k) && (k) < hi)
#define SEAM(k) do { if (IN(k) && IN((k) + 1)) { if ((k) == 0) grid.sync(); else xcd_barrier(bar); } } while (0)

    if (IN(0)) { PH_BEGIN REPS(0) phase_prologue(F, P); } SEAM(0);
    if (IN(1)) { PH_BEGIN
        pg8::Gemm g{XN, (const bf16_t*)(ws + WS_WT_AB), M_TOK, AB_COLS, DM}; pg8::StaticOrder S; S.init(M_TOK, AB_COLS, F.G, F.bid);
        EpiAB E{(bf16_t*)(ws + WS_PA), (bf16_t*)(ws + WS_Z)};
        REPS(1) pg8::gemm_phase<EpiAB, pg8::StaticOrder, true, true>(F.lds, g, S, E);
    } SEAM(1);
    if (IN(2)) { PH_BEGIN phase_row_a(F, P); } SEAM(2);
    if (IN(3)) { PH_BEGIN
        int kl = 256; asm volatile("" : "+s"(kl));
        pg8::Gemm g{(const bf16_t*)(ws + WS_ALORA), (const bf16_t*)(ws + WS_BT_LORA), M_TOK, 3072, kl}; pg8::StaticOrder S; S.init(M_TOK, 3072, F.G, F.bid);
        EpiLora E{(bf16_t*)(ws + WS_DLOG), P->in[5], P->in[7]};
        REPS(3) pg8::gemm_phase<EpiLora, pg8::StaticOrder, true, true>(F.lds, g, S, E);
    } SEAM(3);
    if (IN(5)) { PH_BEGIN
        {   const int ppb = (4096 + F.G - 1) / F.G, p0 = F.bid * ppb, pend = (p0 + ppb < 4096) ? p0 + ppb : 4096; int cur_head = -1;
            u32x4 raw[8]; if (p0 < pend) chunk_prep_fetch(P, p0, F.wave, F.tid, raw);
            for (int pr = p0; pr < pend; ++pr) {
                const int hd = (pr >> 6) & 15;
                if (hd != cur_head) { __syncthreads(); cur_head = hd;
                    if (F.tid < 384) { const int arr = F.tid >> 6, ch = F.tid & 63; const float* src = arr < 3 ? P->in[4] + arr * 1024 : P->in[7 + arr];
                        ((LAS float*)(F.lds + CP_PAR))[F.tid] = src[hd * 64 + ch]; }
                    __syncthreads(); }
                chunk_prep_pair<0>(F, P, pr, pr + 1 < pend ? pr + 1 : -1, raw);
            } }
        REPS(25) for (int t = F.bid; t < 1024; t += F.G) sgu_tile(F, P, t);
        xcd_barrier(bar);
        {   volatile LAS unsigned* cnt = (volatile LAS unsigned*)(F.lds + 4096);
            REPS(55) for (int u = F.bid; u < 256; u += F.G) {
                if (F.tid == 0) *cnt = 0u;
                __syncthreads();
                if (F.wave < 4) chunk_scan_unit4(F, P, u, F.lds, cnt);
                else if (u == F.bid) { const int hw = F.bid * 4 + (F.wave - 4), NHW = F.G * 4;
                    for (int it = hw; it < 14336; it += NHW) late_transpose_item(P, it, (LAS float*)(F.lds + 8192 + (F.wave - 4) * 8448), F.lane); }
                __syncthreads();
            } }
    } SEAM(5);
    if (IN(6)) { PH_BEGIN REPS(6) phase_gn(F, P); } SEAM(6);
    if (IN(7)) { PH_BEGIN
        pg8::Gemm g{(const bf16_t*)(ws + WS_YAB), (const bf16_t*)(ws + WS_WT_ABO), M_TOK, DM, DM}; pg8::StaticOrder S; S.init(M_TOK, DM, F.G, F.bid);
        EpiRes<true> E{P->in[0], (bf16_t*)(ws + WS_XB)};
        if (PROBE_REP == 77) { pg8::Gemm g2 = g; g2.ntc = 2; pg8::gemm_phase<EpiRes<true>, pg8::StaticOrder, true, true>(F.lds, g2, S, E); }
        REPS(7) pg8::gemm_phase<EpiRes<true>, pg8::StaticOrder, true, true>(F.lds, g, S, E);
    } SEAM(7);
#define PEER_BLOCK(layer, pb) \
    if (IN(pb)) { PH_BEGIN REPS(pb) phase_rmsnorm(F, (const bf16_t*)(ws + WS_XB), P->in[2] + (layer) * DM, XN); } SEAM(pb); \
    if (IN((pb) + 1)) { PH_BEGIN \
        pg8::Gemm g{XN, (const bf16_t*)(ws + WS_WT_Q + (size_t)(layer) * 8 * MiB), M_TOK, DM, DM}; pg8::StaticOrder S; S.init(M_TOK, DM, F.G, F.bid); \
        pg8::EpiBf16<0> E{(bf16_t*)(ws + WS_QP), DM, nullptr, 0, 0, 1.f}; \
        if (PROBE_REP == (pb) + 71) { pg8::Gemm g2 = g; g2.ntc = 2; pg8::gemm_phase<pg8::EpiBf16<0>, pg8::StaticOrder, true, true>(F.lds, g2, S, E); } \
        REPS((pb) + 1) pg8::gemm_phase<pg8::EpiBf16<0>, pg8::StaticOrder, true, true>(F.lds, g, S, E); \
    } SEAM((pb) + 1); \
    if (IN((pb) + 2)) { PH_BEGIN REPS((pb) + 2) for (int u = F.bid; u < 512; u += F.G) peer_topk_unit(F, P, (layer), u); } SEAM((pb) + 2); \
    if (IN((pb) + 3)) { PH_BEGIN const bf16_t* XBp = (const bf16_t*)(ws + WS_XB); if (PROBE_REP == (pb) + 3) phase_experts<(layer) == 0 ? L0_FMT : 4>(F, P, (layer), nullptr, XBp, ws + WS_PHI); if (PROBE_REP == (pb) + 43) phase_experts<(layer) == 0 ? L0_FMT : 4, 2>(F, P, (layer), nullptr, XBp, ws + WS_PHI); \
        if ((layer) == 0) phase_experts<L0_FMT, 0, false>(F, P, 0, P->in[1] + DM, XBp, ws + WS_XB); else phase_experts<4, 0, true>(F, P, 1, nullptr, XBp, P->out); }
    PEER_BLOCK(0, 8) SEAM(11);
    if (IN(12)) { PH_BEGIN
        pg8::Gemm g{XN, (const bf16_t*)(ws + WS_WT_C), M_TOK, C_COLS, DM}; pg8::StaticOrder S; S.init(M_TOK, C_COLS, F.G, F.bid);
        pg8::EpiBf16<0> E{(bf16_t*)(ws + WS_QKV), C_COLS, nullptr, 0, 0, 1.f};
        REPS(12) pg8::gemm_phase<pg8::EpiBf16<0>, pg8::StaticOrder, true, true>(F.lds, g, S, E);
    } SEAM(12);
    if (IN(13)) { PH_BEGIN   phase_qknorm(F, P); } SEAM(13);
    if (IN(14)) { PH_BEGIN
        float lam;
        {   const float a = (F.lane < 64) ? P->in[23][F.lane] * P->in[24][F.lane] : 0.f, b2 = P->in[25][F.lane] * P->in[26][F.lane];
            lam = __expf(wave_sum(a)) - __expf(wave_sum(b2)) + LAMBDA_INIT; }
#define ATT_PASS(V) for (int u = F.bid; u < 2048; u += F.G) { const int c = u & 255, i = u >> 8, s = c & 3; const int qb = (i & 1) ? (8 * (i >> 1) + 7 - s) : (8 * (i >> 1) + s); attn_unit<V>(F, P, c >> 2, qb, lam); }
        if (PROBE_REP == 14) { ATT_PASS(5) } if (PROBE_REP == 141) { ATT_PASS(1) } if (PROBE_REP == 142) { ATT_PASS(2) } if (PROBE_REP == 143) { ATT_PASS(3) } if (PROBE_REP == 144) { ATT_PASS(4) }
        ATT_PASS(0)
#undef ATT_PASS
    } SEAM(14);
    if (IN(15)) { PH_BEGIN
        pg8::Gemm g{(const bf16_t*)(ws + WS_OB), (const bf16_t*)(ws + WS_WT_CO), M_TOK, DM, DM}; pg8::StaticOrder S; S.init(M_TOK, DM, F.G, F.bid);
        EpiRes<false> E{ws + WS_XB, (bf16_t*)(ws + WS_XB)};
        pg8::gemm_phase<EpiRes<false>, pg8::StaticOrder, true, true>(F.lds, g, S, E);
    } SEAM(15);
    PEER_BLOCK(1, 16)
#undef PEER_BLOCK
#undef IN
#undef SEAM
}

extern "C" void kernel_launch(void* const* d_in, const int* in_sizes, int n_in, void* d_out, int out_size, void* d_ws, size_t ws_size, hipStream_t stream) {
    static int grid = 0;
    if (grid == 0) {
        if (n_in != 33 || out_size != M_TOK * DM || ws_size < WS_END) { fprintf(stderr, "kernel_launch: unexpected problem (n_in %d out %d ws %zu)\n", n_in, out_size, ws_size); grid = -1; return; }
        int dev = 0, cus = 0, per_cu = 0;
        hipGetDevice(&dev); hipDeviceGetAttribute(&cus, hipDeviceAttributeMultiprocessorCount, dev);
        if (hipFuncSetAttribute((const void*)fwd_kernel, hipFuncAttributeMaxDynamicSharedMemorySize, LDS_BYTES) != hipSuccess) { fprintf(stderr, "kernel_launch: hipFuncSetAttribute failed\n"); grid = -1; return; }
        if (hipOccupancyMaxActiveBlocksPerMultiprocessor(&per_cu, (const void*)fwd_kernel, NTHREADS, LDS_BYTES) != hipSuccess || per_cu < 1) { fprintf(stderr, "kernel_launch: occupancy query says %d\n", per_cu); per_cu = 1; }
        (void)hipGetLastError();
        grid = cus * 1;
        fprintf(stderr, "kernel_launch: grid %d (cus %d, per_cu %d)\n", grid, cus, per_cu);
    }
    if (grid < 0) return;
    if (hipMemsetAsync((char*)d_ws + WS_CTL, 0, 65536, stream) != hipSuccess) { fprintf(stderr, "kernel_launch: memset failed\n"); return; }
    Args a{};
    for (int i = 0; i < 33; ++i) a.p.in[i] = (const float*)d_in[i];
    a.p.out = (float*)d_out; a.p.ws = (unsigned char*)d_ws;
#if MK_ONE_LAUNCH
    a.ph_lo = 0; a.ph_hi = N_PHASES;
    void* kargs[] = {&a};
    hipError_t e = hipLaunchCooperativeKernel((const void*)fwd_kernel, dim3(grid), dim3(NTHREADS), kargs, LDS_BYTES, stream);
    if (e != hipSuccess) fprintf(stderr, "kernel_launch: cooperative launch failed: %s\n", hipGetErrorString(e));
#else
    for (int ph = 0; ph < N_PHASES; ++ph) {
        a.ph_lo = ph; a.ph_hi = ph + 1;
        hipLaunchKernelGGL(fwd_kernel, dim3(grid), dim3(NTHREADS), LDS_BYTES, stream, a);
    }
#endif
}
```

```cpp
#include <hip/hip_runtime.h>
#include <hip/hip_cooperative_groups.h>
#include <cstdio>
#include <cstdint>
namespace cg = cooperative_groups;
namespace pg8 {
#define PG8_LAS __attribute__((address_space(3)))
typedef unsigned short bf16_t;
typedef short bf16x8 __attribute__((ext_vector_type(8)));
typedef float f32x4 __attribute__((ext_vector_type(4)));
typedef unsigned u32x4 __attribute__((ext_vector_type(4)));
constexpr int BM = 256, BK = 64, HALF = 128, HTB = HALF * BK * 2  , STAGE_BYTES = 8 * HTB, NXCD = 8, WGM = 8;

__host__ __device__ __forceinline__ int lds_byte(int r, int c) { const int st = (r >> 4) * 2 + (c >> 5), rr = r & 15, cc = c & 31, ob = rr * 64 + cc * 2; return st * 1024 + (ob ^ (((ob >> 9) & 1) << 5)); }
__host__ __device__ __forceinline__ void stage_rc(int b, int& R, int& C) { const int st = b / 1024, sb = b % 1024, swz = sb ^ (((sb >> 9) & 1) << 5); R = (st >> 1) * 16 + swz / 64; C = (st & 1) * 32 + (swz % 64) / 2; }
__host__ __device__ __forceinline__ int perm32(int rho) { const int n = rho >> 4, i = rho & 15; return 8 * (i >> 2) + 4 * n + (i & 3); }

struct Unit { int pm, pn; };
struct Gemm { const bf16_t* A; const bf16_t* Bt; int M, N, K; int ntc = 0; };

struct StaticOrder {
    int nM, nN, nwg, G, c;
    __host__ __device__ void init(int M, int N, int G_, int c_) { nM = M / BM; nN = N / BM; nwg = nM * nN; G = G_; c = c_; }
    __host__ __device__ bool next(int i, Unit& u) const {
        const long L = (long)i * G + c; if (L >= nwg) return false;
        int wgid = (int)L; { const int q = nwg / NXCD, r = nwg % NXCD, xcd = wgid % NXCD, off = wgid / NXCD; wgid = (xcd < r ? xcd * (q + 1) : r * (q + 1) + (xcd - r) * q) + off; }
        const int nig = WGM * nN, gid = wgid / nig, fm = gid * WGM, gsz = (nM - fm) < WGM ? (nM - fm) : WGM;
        u.pm = fm + ((wgid % nig) % gsz); u.pn = (wgid % nig) / gsz; return true;
    }
    __device__ __forceinline__ void a_ready(const Unit&) const {}
    __device__ __forceinline__ void done(const Unit&) const {}
};

__device__ __forceinline__ unsigned cvt_pk_bf16(float lo, float hi) { unsigned r; asm volatile("v_cvt_pk_bf16_f32 %0, %1, %2" : "=v"(r) : "v"(lo), "v"(hi)); return r; }
typedef float f32x2 __attribute__((ext_vector_type(2)));
__device__ __forceinline__ f32x2 gelu_pk(f32x2 v) {
    const f32x2 av = __builtin_elementwise_abs(v), d = av * 0.2316418882f + 1.0f;
    f32x2 t; t.x = __builtin_amdgcn_rcpf(d.x); t.y = __builtin_amdgcn_rcpf(d.y);
    f32x2 q = t * 0.5307027145f + (-0.7265760135f); q = q * t + 0.7107068705f; q = q * t + (-0.142248368f); q = q * t + 0.127414796f; q = q * t;
    const f32x2 s = (v * v) * (-0.72134752044f);
    f32x2 e; e.x = __builtin_amdgcn_exp2f(s.x); e.y = __builtin_amdgcn_exp2f(s.y);
    const f32x2 m = v * (q * e), r = v - m;
    f32x2 o; o.x = v.x < 0.f ? m.x : r.x; o.y = v.y < 0.f ? m.y : r.y; return o;
}

template <int ACT  > struct EpiBf16 {
    static constexpr bool PERM = true, AFTER_DRAIN = false; static_assert(ACT == 0 || ACT == 1, "EpiBf16: ACT is 0 (none) or 1 (gelu_pk)");
    bf16_t* O; int ldc; const float* bias; int split_cols; size_t split_stride; float scale0;
    __device__ __forceinline__ void operator()(const f32x4 (&acc)[2][2][4][2], const Unit& u, int wr, int wc, int fr, int fq) const {
        const int row0 = u.pm * BM + wr * 64 + fr; int colt = u.pn * BM; bf16_t* base = O;
        float sc = 1.f; if (split_cols) { const int t = colt / split_cols; base += (size_t)t * split_stride; colt -= t * split_cols; if (t == 0) sc = scale0; }
        const int col0 = colt + wc * 32 + 8 * fq, bcol0 = u.pn * BM + wc * 32 + 8 * fq;
        f32x4 bv[2][2];
#pragma unroll
        for (int bj = 0; bj < 2; ++bj)
#pragma unroll
            for (int n = 0; n < 2; ++n) bv[bj][n] = bias ? *(const f32x4*)(bias + bcol0 + bj * HALF + 4 * n) : (f32x4){0.f, 0.f, 0.f, 0.f};
#pragma unroll
        for (int ai = 0; ai < 2; ++ai)
#pragma unroll
            for (int m = 0; m < 4; ++m) { bf16_t* rowp = base + (size_t)(row0 + ai * HALF + m * 16) * ldc + col0;
#pragma unroll
                for (int bj = 0; bj < 2; ++bj) { f32x4 v0 = acc[ai][bj][m][0] + bv[bj][0], v1 = acc[ai][bj][m][1] + bv[bj][1];
                    if (ACT == 1) { f32x2 a = gelu_pk((f32x2){v0[0], v0[1]}), b = gelu_pk((f32x2){v0[2], v0[3]}), c = gelu_pk((f32x2){v1[0], v1[1]}), d = gelu_pk((f32x2){v1[2], v1[3]});
                        v0 = (f32x4){a.x, a.y, b.x, b.y}; v1 = (f32x4){c.x, c.y, d.x, d.y}; }
                    v0 = v0 * sc; v1 = v1 * sc; u32x4 w; w.x = cvt_pk_bf16(v0[0], v0[1]); w.y = cvt_pk_bf16(v0[2], v0[3]); w.z = cvt_pk_bf16(v1[0], v1[1]); w.w = cvt_pk_bf16(v1[2], v1[3]);
                    *(u32x4*)(rowp + bj * HALF) = w; } }
    }
};
template <class Epi, class Sched, bool ALIGN_EPI = false, bool SP2 = false>
__device__ __forceinline__ void gemm_phase(PG8_LAS unsigned char* lds, const Gemm g, const Sched& S, const Epi& E) {
    const int tid = threadIdx.x, wid = __builtin_amdgcn_readfirstlane(tid >> 6), lane = tid & 63, wr = wid >> 2, wc = wid & 3, fr = lane & 15, fq = lane >> 4;
    const int K = g.K, nt = g.ntc ? g.ntc : K / BK;
    unsigned voffA[2], voffB[2];
#pragma unroll
    for (int i = 0; i < 2; ++i) { int R, C; stage_rc(tid * 16 + i * 8192, R, C); const int Rb = Epi::PERM ? ((R & ~31) + perm32(R & 31)) : R;
        voffA[i] = (unsigned)(R * K + C) * 2u; voffB[i] = (unsigned)(Rb * K + C) * 2u; }
    const size_t kstep = (size_t)(BK * 2);
    const size_t hstep = (size_t)HALF * K * 2;
    const size_t tstep = 2 * hstep;
    const unsigned ldsw = (unsigned)wid * 1024u;
    const int aoff = lds_byte(wr * 64 + fr, fq * 8), boff = lds_byte(wc * 32 + fr, fq * 8);
#define PG8_SA(b, h) (((b) * 2 + (h)) * HTB)
#define PG8_SB(b, h) ((4 + (b) * 2 + (h)) * HTB)
#define PG8_STAGE(bufoff, gbase, voff) do { _Pragma("unroll") for (int _i = 0; _i < 2; ++_i) \
        __builtin_amdgcn_global_load_lds((const unsigned*)((const char*)(gbase) + (voff)[_i]), (PG8_LAS unsigned*)(lds + (bufoff) + ldsw + _i * 8192), 16, 0, 0); } while (0)
#define PG8_LDA(dst, b, h) do { _Pragma("unroll") for (int m = 0; m < 4; ++m) _Pragma("unroll") for (int k = 0; k < 2; ++k) dst[m][k] = *(const PG8_LAS bf16x8*)(lds + PG8_SA(b, h) + aoff + m * 2048 + k * 1024); } while (0)
#define PG8_LDB(dst, b, h) do { _Pragma("unroll") for (int n = 0; n < 2; ++n) _Pragma("unroll") for (int k = 0; k < 2; ++k) dst[n][k] = *(const PG8_LAS bf16x8*)(lds + PG8_SB(b, h) + boff + n * 2048 + k * 1024); } while (0)
#define PG8_MMA(ai, bj, At, Bt) do { __builtin_amdgcn_s_setprio(1); _Pragma("unroll") for (int m = 0; m < 4; ++m) _Pragma("unroll") for (int n = 0; n < 2; ++n) _Pragma("unroll") for (int k = 0; k < 2; ++k) \
        acc[ai][bj][m][n] = __builtin_amdgcn_mfma_f32_16x16x32_bf16(Bt[n][k], At[m][k], acc[ai][bj][m][n], 0, 0, 0); __builtin_amdgcn_s_setprio(0); } while (0)
#define PG8_WAIT_V(n) asm volatile("s_waitcnt vmcnt(" #n ")" ::: "memory")
#define PG8_WAIT_L(n) asm volatile("s_waitcnt lgkmcnt(" #n ")" ::: "memory")
#define PG8_BAR __builtin_amdgcn_s_barrier()
#define PG8_SCHED __builtin_amdgcn_sched_barrier(0)
    Unit cur, nxt; int ui = 0;
    if (!S.next(0, cur)) return;
    f32x4 acc[2][2][4][2];
#pragma unroll
    for (int a = 0; a < 2; ++a)
#pragma unroll
        for (int b = 0; b < 2; ++b)
#pragma unroll
            for (int m = 0; m < 4; ++m)
#pragma unroll
                for (int n = 0; n < 2; ++n) acc[a][b][m][n] = (f32x4){0.f, 0.f, 0.f, 0.f};
    bf16x8 At[4][2], B0[2][2], B1[2][2];
    const char* cA = (const char*)g.A + (size_t)cur.pm * tstep; const char* cB = (const char*)g.Bt + (size_t)cur.pn * tstep;
    const int ktm = ((nt & (nt - 1)) == 0) ? nt - 1 : 0;
#define PG8_SK(u_) ((((u_).pm & 3) + 4 * ((u_).pn & 1)) & ktm & 7)
#define PG8_KO(sk_, t_) ((size_t)(ktm ? (((t_) + (sk_)) & ktm) : (t_)) * kstep)
    int skc = PG8_SK(cur);
    S.a_ready(cur);
    if constexpr (SP2) {
        PG8_STAGE(PG8_SB(0, 0), cB + PG8_KO(skc, 0), voffB); PG8_STAGE(PG8_SB(0, 1), cB + hstep + PG8_KO(skc, 0), voffB); PG8_STAGE(PG8_SA(0, 0), cA + PG8_KO(skc, 0), voffA); PG8_STAGE(PG8_SA(0, 1), cA + hstep + PG8_KO(skc, 0), voffA);
        if (wr == 1) PG8_BAR;
        PG8_WAIT_V(2); PG8_BAR;
        PG8_STAGE(PG8_SB(1, 0), cB + PG8_KO(skc, 1), voffB); PG8_STAGE(PG8_SA(1, 0), cA + PG8_KO(skc, 1), voffA); PG8_STAGE(PG8_SB(1, 1), cB + hstep + PG8_KO(skc, 1), voffB);
        PG8_WAIT_V(6); PG8_BAR;
    } else {
        PG8_STAGE(PG8_SB(0, 0), cB, voffB); PG8_STAGE(PG8_SA(0, 0), cA, voffA); PG8_STAGE(PG8_SB(0, 1), cB + hstep, voffB); PG8_STAGE(PG8_SA(0, 1), cA + hstep, voffA);
        if (wr == 1) PG8_BAR;
        PG8_WAIT_V(4); PG8_BAR;
        PG8_STAGE(PG8_SB(1, 0), cB + kstep, voffB); PG8_STAGE(PG8_SA(1, 0), cA + kstep, voffA); PG8_STAGE(PG8_SB(1, 1), cB + hstep + kstep, voffB);
        PG8_WAIT_V(6); PG8_BAR;
    }
    for (;;) {
        const bool has_next = S.next(ui + 1, nxt);
        const char* nA = has_next ? (const char*)g.A + (size_t)nxt.pm * tstep : cA; const char* nB = has_next ? (const char*)g.Bt + (size_t)nxt.pn * tstep : cB;
        const int skn = has_next ? PG8_SK(nxt) : skc;
        for (int t = 0; t < nt; t += 2) {
            const bool last = (t == nt - 2);
            const char* a1 = cA + PG8_KO(skc, t + 1);
            const char* a2 = last ? nA + PG8_KO(skn, 0) : cA + PG8_KO(skc, t + 2); const char* b2 = last ? nB + PG8_KO(skn, 0) : cB + PG8_KO(skc, t + 2);
            const char* a3 = last ? nA + PG8_KO(skn, 1) : cA + PG8_KO(skc, t + 3); const char* b3 = last ? nB + PG8_KO(skn, 1) : cB + PG8_KO(skc, t + 3);
            if (last && has_next) S.a_ready(nxt);
            if constexpr (SP2) {
            PG8_LDB(B0, 0, 0); PG8_LDB(B1, 0, 1); PG8_SCHED; PG8_LDA(At, 0, 0); PG8_STAGE(PG8_SA(1, 1), a1 + hstep, voffA);
            PG8_WAIT_V(8); PG8_WAIT_L(0); PG8_BAR; PG8_MMA(0, 0, At, B0); PG8_MMA(0, 1, At, B1); PG8_BAR; PG8_SCHED;
            PG8_LDA(At, 0, 1); PG8_STAGE(PG8_SB(0, 0), b2, voffB); PG8_STAGE(PG8_SB(0, 1), b2 + hstep, voffB); PG8_STAGE(PG8_SA(0, 0), a2, voffA);
            PG8_WAIT_V(8); PG8_WAIT_L(0); PG8_BAR; PG8_MMA(1, 0, At, B0); PG8_MMA(1, 1, At, B1); PG8_BAR; PG8_SCHED;
            PG8_LDB(B0, 1, 0); PG8_LDB(B1, 1, 1); PG8_SCHED; PG8_LDA(At, 1, 0); PG8_STAGE(PG8_SA(0, 1), a2 + hstep, voffA);
            PG8_WAIT_V(8); PG8_WAIT_L(0); PG8_BAR; PG8_MMA(0, 0, At, B0); PG8_MMA(0, 1, At, B1); PG8_BAR; PG8_SCHED;
            PG8_LDA(At, 1, 1); PG8_STAGE(PG8_SB(1, 0), b3, voffB); PG8_STAGE(PG8_SB(1, 1), b3 + hstep, voffB); PG8_STAGE(PG8_SA(1, 0), a3, voffA);
            PG8_WAIT_V(8); PG8_WAIT_L(0); PG8_BAR; PG8_MMA(1, 0, At, B0); PG8_MMA(1, 1, At, B1); PG8_BAR; PG8_SCHED;
            } else {
            PG8_LDB(B0, 0, 0); PG8_SCHED; PG8_LDA(At, 0, 0); PG8_STAGE(PG8_SA(1, 1), a1 + hstep, voffA);
            PG8_WAIT_L(8); PG8_BAR; PG8_WAIT_L(0); PG8_MMA(0, 0, At, B0); PG8_BAR; PG8_SCHED;
            PG8_LDB(B1, 0, 1); PG8_STAGE(PG8_SB(0, 0), b2, voffB);
            PG8_BAR; PG8_WAIT_L(0); PG8_MMA(0, 1, At, B1); PG8_BAR;
            PG8_LDA(At, 0, 1); PG8_STAGE(PG8_SA(0, 0), a2, voffA);
            PG8_BAR; PG8_WAIT_L(0); PG8_MMA(1, 0, At, B0); PG8_BAR; PG8_SCHED;
            PG8_STAGE(PG8_SB(0, 1), b2 + hstep, voffB);
            PG8_WAIT_V(6); PG8_BAR; PG8_MMA(1, 1, At, B1); PG8_BAR;
            PG8_LDB(B0, 1, 0); PG8_SCHED; PG8_LDA(At, 1, 0); PG8_STAGE(PG8_SA(0, 1), a2 + hstep, voffA);
            PG8_WAIT_L(8); PG8_BAR; PG8_WAIT_L(0); PG8_MMA(0, 0, At, B0); PG8_BAR; PG8_SCHED;
            PG8_LDB(B1, 1, 1); PG8_STAGE(PG8_SB(1, 0), b3, voffB);
            PG8_BAR; PG8_WAIT_L(0); PG8_MMA(0, 1, At, B1); PG8_BAR;
            PG8_LDA(At, 1, 1); PG8_STAGE(PG8_SA(1, 0), a3, voffA);
            PG8_BAR; PG8_WAIT_L(0); PG8_MMA(1, 0, At, B0); PG8_BAR; PG8_SCHED;
            PG8_STAGE(PG8_SB(1, 1), b3 + hstep, voffB);
            PG8_WAIT_V(6); PG8_BAR; PG8_MMA(1, 1, At, B1); PG8_BAR;
            }
        }
        if constexpr (ALIGN_EPI) { if (wr == 0) PG8_BAR; }
        if constexpr (!Epi::AFTER_DRAIN) { E(acc, cur, wr, wc, fr, fq); S.done(cur); }
        if (!has_next) break;
#pragma unroll
        for (int a = 0; a < 2; ++a)
#pragma unroll
            for (int b = 0; b < 2; ++b)
#pragma unroll
                for (int m = 0; m < 4; ++m)
#pragma unroll
                    for (int n = 0; n < 2; ++n) acc[a][b][m][n] = (f32x4){0.f, 0.f, 0.f, 0.f};
        cur = nxt; cA = nA; cB = nB; skc = skn; ++ui;
        if constexpr (ALIGN_EPI) { if (wr == 1) PG8_BAR; }
    }
    PG8_WAIT_V(0);
    if constexpr (!ALIGN_EPI) { if (wr == 0) PG8_BAR; }
    PG8_BAR;
    if constexpr (Epi::AFTER_DRAIN) { E.fused(acc, cur, wr, wc, fr, fq, lds, wid, lane); S.done(cur); }
#undef PG8_SK
#undef PG8_KO
#undef PG8_SA
#undef PG8_SB
#undef PG8_STAGE
#undef PG8_LDA
#undef PG8_LDB
#undef PG8_MMA
#undef PG8_WAIT_V
#undef PG8_WAIT_L
#undef PG8_BAR
#undef PG8_SCHED
}
}
constexpr int M_TOK = 16384, DM = 2048, SEQ = 4096;
constexpr int NWAVES = 8, NTHREADS = 512;
constexpr int A_COLS = 3328, AB_COLS = 5376, C_COLS = 6144;
constexpr float DECAY_SCALE = 0.6065306597126334f;
constexpr float LAMBDA_INIT = 0.35550906759096316f;
constexpr float QSCALE = 0.125f * 1.4426950408889634f;

#define LAS __attribute__((address_space(3)))
typedef unsigned short bf16_t;
typedef short bf16x8 __attribute__((ext_vector_type(8)));
typedef short s16x4 __attribute__((ext_vector_type(4)));
typedef float f32x4 __attribute__((ext_vector_type(4)));
typedef float f32x2 __attribute__((ext_vector_type(2)));
typedef float f32x16 __attribute__((ext_vector_type(16)));
typedef unsigned u32x4 __attribute__((ext_vector_type(4)));
typedef unsigned u32x2 __attribute__((ext_vector_type(2)));
typedef unsigned u32x6 __attribute__((ext_vector_type(6)));
typedef float f32x32 __attribute__((ext_vector_type(32)));
#ifndef FP6_INTERLEAVED
#define FP6_INTERLEAVED 1
#endif
#ifndef L0_FMT
#define L0_FMT 4
#endif
#define FP6_IDX_A(i) (i)
#define FP6_IDX_B(i) (16 + (i))
#if FP6_INTERLEAVED
#define FP6_OUT_A(i) (2 * (i))
#define FP6_OUT_B(i) (2 * (i) + 1)
#else
#define FP6_OUT_A(i) (i)
#define FP6_OUT_B(i) (16 + (i))
#endif

constexpr size_t MiB = 1u << 20;
constexpr size_t WS_CTL = 0;
constexpr size_t WS_WT_AB = 2 * MiB, WS_WT_ABO = 23 * MiB, WS_WT_C = 31 * MiB, WS_WT_CO = 55 * MiB, WS_WT_Q = 63 * MiB  ;
constexpr size_t WS_BT_LORA = 79 * MiB, WS_KEYS = 81 * MiB, WS_ROPE = 82 * MiB, WS_SCALE = 83 * MiB;
constexpr size_t WS_UT = 84 * MiB, WS_VT = 212 * MiB, WS_XN = 340 * MiB;
constexpr size_t WS_PA = 404 * MiB, WS_Z = 508 * MiB, WS_ALORA = 572 * MiB, WS_DLOG = 580 * MiB, WS_ICLR = 612 * MiB, WS_GATE = 644 * MiB;
constexpr size_t WS_BONUS = 868 * MiB, WS_Y = 869 * MiB, WS_YAB = 933 * MiB, WS_END = 997 * MiB;
constexpr size_t WS_XB = WS_Y;
constexpr size_t WS_QP = 404 * MiB, WS_EIDX = 468 * MiB, WS_EGATE = 476 * MiB;
constexpr size_t WS_QKV = 508 * MiB, WS_OB = 700 * MiB;
constexpr int LDS_BYTES = 147456;

__device__ __forceinline__ float bf_lo(unsigned w) { return __uint_as_float(w << 16); }
__device__ __forceinline__ float bf_hi(unsigned w) { return __uint_as_float(w & 0xffff0000u); }
__device__ __forceinline__ float bf_1(unsigned short w) { return __uint_as_float(((unsigned)w) << 16); }
__device__ __forceinline__ unsigned pkbf(float lo, float hi) { return pg8::cvt_pk_bf16(lo, hi); }
typedef __bf16 bf16x2_t __attribute__((ext_vector_type(2)));
__device__ __forceinline__ unsigned pkbf_c(float lo, float hi) { const f32x2 v = {lo, hi}; const bf16x2_t b = __builtin_convertvector(v, bf16x2_t); return __builtin_bit_cast(unsigned, b); }
__device__ __forceinline__ void unpack8(const u32x4 a, float (&o)[8]) {
    o[0] = bf_lo(a.x); o[1] = bf_hi(a.x); o[2] = bf_lo(a.y); o[3] = bf_hi(a.y); o[4] = bf_lo(a.z); o[5] = bf_hi(a.z); o[6] = bf_lo(a.w); o[7] = bf_hi(a.w);
}
__device__ __forceinline__ u32x4 pack8(const float (&o)[8]) { u32x4 r; r.x = pkbf(o[0], o[1]); r.y = pkbf(o[2], o[3]); r.z = pkbf(o[4], o[5]); r.w = pkbf(o[6], o[7]); return r; }
__device__ __forceinline__ void ld16bf(const bf16_t* p, float (&o)[16]) {
    const u32x4 a = *(const u32x4*)p, b = *(const u32x4*)(p + 8); float t[8];
    unpack8(a, t);
#pragma unroll
    for (int i = 0; i < 8; ++i) o[i] = t[i];
    unpack8(b, t);
#pragma unroll
    for (int i = 0; i < 8; ++i) o[8 + i] = t[i];
}
__device__ __forceinline__ void st16bf(bf16_t* p, const float (&o)[16]) {
    u32x4 a, b; a.x = pkbf(o[0], o[1]); a.y = pkbf(o[2], o[3]); a.z = pkbf(o[4], o[5]); a.w = pkbf(o[6], o[7]);
    b.x = pkbf(o[8], o[9]); b.y = pkbf(o[10], o[11]); b.z = pkbf(o[12], o[13]); b.w = pkbf(o[14], o[15]);
    *(u32x4*)p = a; *(u32x4*)(p + 8) = b;
}
__device__ __forceinline__ void ld16f(const float* p, float (&o)[16]) {
#pragma unroll
    for (int i = 0; i < 4; ++i) { const f32x4 v = *(const f32x4*)(p + 4 * i); o[4 * i] = v.x; o[4 * i + 1] = v.y; o[4 * i + 2] = v.z; o[4 * i + 3] = v.w; }
}
__device__ __forceinline__ float sigmoidf_(float x) { return __builtin_amdgcn_rcpf(1.0f + __expf(-x)); }

template <int CTRL> __device__ __forceinline__ float dpp_mov(float x) { return __int_as_float(__builtin_amdgcn_update_dpp(0, __float_as_int(x), CTRL, 0xf, 0xf, true)); }
__device__ __forceinline__ float quad_sum(float x) { x += dpp_mov<0xB1>(x); x += dpp_mov<0x4E>(x); return x; }
__device__ __forceinline__ float oct_sum(float x) { x = quad_sum(x); x += dpp_mov<0x141>(x); return x; }
__device__ __forceinline__ float row16_sum(float x) { x = oct_sum(x); x += dpp_mov<0x140>(x); return x; }
__device__ __forceinline__ float wave_sum(float x) { x = row16_sum(x); x += __shfl_xor(x, 16); x += __shfl_xor(x, 32); return x; }
__device__ __forceinline__ float row16_max(float x) {
    x = fmaxf(x, dpp_mov<0xB1>(x)); x = fmaxf(x, dpp_mov<0x4E>(x)); x = fmaxf(x, dpp_mov<0x141>(x)); x = fmaxf(x, dpp_mov<0x140>(x)); return x;
}
__device__ __forceinline__ float wave_max(float x) { x = row16_max(x); x = fmaxf(x, __shfl_xor(x, 16)); x = fmaxf(x, __shfl_xor(x, 32)); return x; }

__device__ __forceinline__ unsigned fkey(float f) { const unsigned u = __float_as_uint(f); return u ^ ((unsigned)((int)u >> 31) | 0x80000000u); }
__device__ __forceinline__ int crow(int r, int hi) { return (r & 3) + 8 * (r >> 2) + 4 * hi; }
__device__ __forceinline__ s16x4 vtr(LAS unsigned char* p) { typedef short v4i16_t __attribute__((ext_vector_type(4))); return __builtin_bit_cast(s16x4, __builtin_amdgcn_ds_read_tr16_b64_v4i16((LAS v4i16_t*)p)); }
__device__ __forceinline__ float gelu1(float v) { pg8::f32x2 r = pg8::gelu_pk((pg8::f32x2){v, v}); return r.x; }

struct EpiAB {
    static constexpr bool PERM = true, AFTER_DRAIN = false;
    bf16_t* PA; bf16_t* Z;
    __device__ __forceinline__ void operator()(const pg8::f32x4 (&acc)[2][2][4][2], const pg8::Unit& u, int wr, int wc, int fr, int fq) const {
        const int row0 = u.pm * 256 + wr * 64 + fr;
        const bool isz = u.pn >= 13;
        bf16_t* base = isz ? Z : PA; const int ldc = isz ? 2048 : A_COLS; const int colt = isz ? (u.pn - 13) * 256 : u.pn * 256;
        const int col0 = colt + wc * 32 + 8 * fq;
#pragma unroll
        for (int ai = 0; ai < 2; ++ai)
#pragma unroll
            for (int m = 0; m < 4; ++m) { bf16_t* rowp = base + (size_t)(row0 + ai * 128 + m * 16) * ldc + col0;
#pragma unroll
                for (int bj = 0; bj < 2; ++bj) { pg8::f32x4 v0 = acc[ai][bj][m][0], v1 = acc[ai][bj][m][1];
                    if (isz) { pg8::f32x2 a = pg8::gelu_pk((pg8::f32x2){v0[0], v0[1]}), b = pg8::gelu_pk((pg8::f32x2){v0[2], v0[3]}), c = pg8::gelu_pk((pg8::f32x2){v1[0], v1[1]}), d = pg8::gelu_pk((pg8::f32x2){v1[2], v1[3]});
                        v0 = (pg8::f32x4){a.x, a.y, b.x, b.y}; v1 = (pg8::f32x4){c.x, c.y, d.x, d.y}; }
                    u32x4 w; w.x = pkbf(v0[0], v0[1]); w.y = pkbf(v0[2], v0[3]); w.z = pkbf(v1[0], v1[1]); w.w = pkbf(v1[2], v1[3]);
                    *(u32x4*)(rowp + bj * 128) = w; } }
    }
};
struct EpiLora {
    static constexpr bool PERM = true, AFTER_DRAIN = false;
    bf16_t* base3; const float *dbias, *ibias;
    __device__ __forceinline__ void operator()(const pg8::f32x4 (&acc)[2][2][4][2], const pg8::Unit& u, int wr, int wc, int fr, int fq) const {
        const int row0 = u.pm * 256 + wr * 64 + fr;
        const int kind = u.pn >> 2; const int colt = (u.pn & 3) * 256;
        bf16_t* base = base3 + (size_t)kind * (size_t)(16 * MiB);
        const float* bias = kind == 0 ? dbias : ibias;
        const int col0 = colt + wc * 32 + 8 * fq;
#pragma unroll
        for (int bj = 0; bj < 2; ++bj) {
            pg8::f32x4 b0 = (pg8::f32x4){0.f, 0.f, 0.f, 0.f}, b1 = b0;
            if (kind < 2) { b0 = *(const pg8::f32x4*)(bias + col0 + bj * 128); b1 = *(const pg8::f32x4*)(bias + col0 + bj * 128 + 4); }
#pragma unroll
            for (int ai = 0; ai < 2; ++ai)
#pragma unroll
                for (int m = 0; m < 4; ++m) { bf16_t* rowp = base + (size_t)(row0 + ai * 128 + m * 16) * 1024 + col0;
                    pg8::f32x4 v0 = acc[ai][bj][m][0] + b0, v1 = acc[ai][bj][m][1] + b1;
                    if (kind < 2) { const float sc = kind == 0 ? DECAY_SCALE : 1.0f;
#pragma unroll
                        for (int i = 0; i < 4; ++i) { v0[i] = sc * sigmoidf_(v0[i]); v1[i] = sc * sigmoidf_(v1[i]); } }
                    u32x4 w; w.x = pkbf(v0[0], v0[1]); w.y = pkbf(v0[2], v0[3]); w.z = pkbf(v1[0], v1[1]); w.w = pkbf(v1[2], v1[3]);
                    *(u32x4*)(rowp + bj * 128) = w; } }
    }
};
template <bool RES_F32> struct EpiRes {
    static constexpr bool PERM = true, AFTER_DRAIN = false;
    const void* res; bf16_t* out;
    __device__ __forceinline__ void operator()(const pg8::f32x4 (&acc)[2][2][4][2], const pg8::Unit& u, int wr, int wc, int fr, int fq) const {
        const int row0 = u.pm * 256 + wr * 64 + fr; const int col0 = u.pn * 256 + wc * 32 + 8 * fq;
#pragma unroll
        for (int ai = 0; ai < 2; ++ai) {
            pg8::f32x4 rf[4][2][2]; u32x4 rb[4][2];
#pragma unroll
            for (int m = 0; m < 4; ++m) { const size_t off = (size_t)(row0 + ai * 128 + m * 16) * DM + col0;
#pragma unroll
                for (int bj = 0; bj < 2; ++bj) {
                    if (RES_F32) { rf[m][bj][0] = *(const pg8::f32x4*)((const float*)res + off + bj * 128); rf[m][bj][1] = *(const pg8::f32x4*)((const float*)res + off + bj * 128 + 4); }
                    else rb[m][bj] = *(const u32x4*)((const bf16_t*)res + off + bj * 128); } }
#pragma unroll
            for (int m = 0; m < 4; ++m) { const size_t off = (size_t)(row0 + ai * 128 + m * 16) * DM + col0;
#pragma unroll
                for (int bj = 0; bj < 2; ++bj) { pg8::f32x4 r0, r1;
                    if (RES_F32) { r0 = rf[m][bj][0]; r1 = rf[m][bj][1]; }
                    else { const u32x4 w = rb[m][bj]; r0 = (pg8::f32x4){bf_lo(w.x), bf_hi(w.x), bf_lo(w.y), bf_hi(w.y)}; r1 = (pg8::f32x4){bf_lo(w.z), bf_hi(w.z), bf_lo(w.w), bf_hi(w.w)}; }
                    r0 = r0 + acc[ai][bj][m][0]; r1 = r1 + acc[ai][bj][m][1];
                    *(u32x4*)(out + off + bj * 128) = (u32x4){pkbf(r0[0], r0[1]), pkbf(r0[2], r0[3]), pkbf(r1[0], r1[1]), pkbf(r1[2], r1[3])}; } }
        }
    }
};

struct EpiQKV {
    static constexpr bool PERM = true, AFTER_DRAIN = false;
    bf16_t* O; const float* qn; const float* kn; const f32x2* rope;
    __device__ __forceinline__ void operator()(const pg8::f32x4 (&acc)[2][2][4][2], const pg8::Unit& u, int wr, int wc, int fr, int fq) const {
        const int row0 = u.pm * 256 + wr * 64 + fr; const int cbase = u.pn * 256 + 64 * wc + 8 * fq;
        if (u.pn >= 16) {
#pragma unroll
            for (int ai = 0; ai < 2; ++ai)
#pragma unroll
                for (int m = 0; m < 4; ++m) { bf16_t* rowp = O + (size_t)(row0 + ai * 128 + m * 16) * C_COLS + cbase;
#pragma unroll
                    for (int bj = 0; bj < 2; ++bj) { const pg8::f32x4 v0 = acc[ai][bj][m][0] * 1.0f, v1 = acc[ai][bj][m][1] * 1.0f;
                        *(u32x4*)(rowp + 32 * bj) = (u32x4){pkbf(v0[0], v0[1]), pkbf(v0[2], v0[3]), pkbf(v1[0], v1[1]), pkbf(v1[2], v1[3])}; } }
            return; }
        const bool isq = u.pn < 8; const float* wn = (isq ? qn : kn) + 8 * fq; const float qs = isq ? QSCALE : 1.0f;
        float w[2][8];
#pragma unroll
        for (int bj = 0; bj < 2; ++bj) { const f32x4 a = *(const f32x4*)(wn + 32 * bj), b = *(const f32x4*)(wn + 32 * bj + 4);
            w[bj][0] = a.x * qs; w[bj][1] = a.y * qs; w[bj][2] = a.z * qs; w[bj][3] = a.w * qs; w[bj][4] = b.x * qs; w[bj][5] = b.y * qs; w[bj][6] = b.z * qs; w[bj][7] = b.w * qs; }
#pragma unroll
        for (int ai = 0; ai < 2; ++ai)
#pragma unroll
            for (int m = 0; m < 4; ++m) { const int row = row0 + ai * 128 + m * 16; const int pos = row & (SEQ - 1);
                f32x4 cs4[4];
#pragma unroll
                for (int k2 = 0; k2 < 4; ++k2) cs4[k2] = ((const f32x4*)(rope + pos * 8))[k2];
                float v[2][8]; float ss = 0.f;
#pragma unroll
                for (int bj = 0; bj < 2; ++bj)
#pragma unroll
                    for (int k = 0; k < 8; ++k) { v[bj][k] = acc[ai][bj][m][k >> 2][k & 3]; ss += v[bj][k] * v[bj][k]; }
                ss += __shfl_xor(ss, 16); ss += __shfl_xor(ss, 32);
                const float rstd = rsqrtf(ss * (1.0f / 64.0f) + 1e-6f);
#pragma unroll
                for (int bj = 0; bj < 2; ++bj)
#pragma unroll
                    for (int k = 0; k < 8; ++k) v[bj][k] = v[bj][k] * rstd * w[bj][k];
                {
#pragma unroll
                    for (int k2 = 0; k2 < 4; ++k2) { const f32x4 cs = cs4[k2];
                        const float p0 = __shfl_xor(v[0][2 * k2], 16), p1 = __shfl_xor(v[0][2 * k2 + 1], 16);
                        const float r0 = (fq == 0) ? (v[0][2 * k2] * cs.x - p0 * cs.y) : (v[0][2 * k2] * cs.x + p0 * cs.y), r1 = (fq == 0) ? (v[0][2 * k2 + 1] * cs.z - p1 * cs.w) : (v[0][2 * k2 + 1] * cs.z + p1 * cs.w);
                        v[0][2 * k2] = (fq < 2) ? r0 : v[0][2 * k2]; v[0][2 * k2 + 1] = (fq < 2) ? r1 : v[0][2 * k2 + 1]; } }
                bf16_t* rowp = O + (size_t)row * C_COLS + cbase;
#pragma unroll
                for (int bj = 0; bj < 2; ++bj) *(u32x4*)(rowp + 32 * bj) = (u32x4){pkbf(v[bj][0], v[bj][1]), pkbf(v[bj][2], v[bj][3]), pkbf(v[bj][4], v[bj][5]), pkbf(v[bj][6], v[bj][7])};
            }
    }
};

struct Frame {
    LAS unsigned char* lds;
    int tid, lane, wave, G, bid;
    int gw, NGW;
};

__device__ __forceinline__ void rms_row_to_bf16(const float* xrow, const float* g, bf16_t* orow, int lane) {
    const f32x4* xr = (const f32x4*)xrow + lane; f32x4 v[8]; float s = 0.f;
#pragma unroll
    for (int j = 0; j < 8; ++j) { v[j] = xr[64 * j]; s += (v[j].x * v[j].x + v[j].y * v[j].y) + (v[j].z * v[j].z + v[j].w * v[j].w); }
    const float rstd = rsqrtf(wave_sum(s) * (1.0f / DM) + 1e-6f);
    const f32x4* gr = (const f32x4*)g + lane; u32x2* o8 = (u32x2*)orow + lane;
#pragma unroll
    for (int j = 0; j < 8; ++j) { const f32x4 gv = gr[64 * j]; u32x2 w; w.x = pkbf(v[j].x * rstd * gv.x, v[j].y * rstd * gv.y); w.y = pkbf(v[j].z * rstd * gv.z, v[j].w * rstd * gv.w); o8[64 * j] = w; }
}

__device__ __forceinline__ void p0_transpose_item(const float* W, int K, int N, bf16_t* WT, int row_off, LAS float* scr, int item, int lane, const float* kscale = nullptr, bool remap64 = false) {
    const int nblk = N / 32, kb = item / nblk, nb = item % nblk, k0 = 64 * kb, n0 = 32 * nb;
#pragma unroll 8
    for (int i = 0; i < 32; ++i) { const int kk = 2 * i + (lane >> 5); scr[kk * 33 + (lane & 31)] = W[(size_t)(k0 + kk) * N + n0 + (lane & 31)]; }
    asm volatile("s_waitcnt lgkmcnt(0)" ::: "memory");
    const int c = lane & 7, nd0 = remap64 ? ((n0 & ~255) + 128 * ((n0 >> 5) & 1) + 32 * ((n0 >> 6) & 3)) : n0;
    f32x4 ka = (f32x4){1.f, 1.f, 1.f, 1.f}, kb4 = ka; if (kscale) { ka = *(const f32x4*)(kscale + k0 + 8 * c); kb4 = *(const f32x4*)(kscale + k0 + 8 * c + 4); }
#pragma unroll
    for (int j = 0; j < 4; ++j) { const int n = (lane >> 3) + 8 * j; const LAS float* s = scr + (8 * c) * 33 + n;
        u32x4 o; o.x = pkbf(s[0 * 33] * ka.x, s[1 * 33] * ka.y); o.y = pkbf(s[2 * 33] * ka.z, s[3 * 33] * ka.w); o.z = pkbf(s[4 * 33] * kb4.x, s[5 * 33] * kb4.y); o.w = pkbf(s[6 * 33] * kb4.z, s[7 * 33] * kb4.w);
        *(u32x4*)(WT + (size_t)(row_off + nd0 + n) * K + k0 + 8 * c) = o; }
    asm volatile("s_waitcnt lgkmcnt(0)" ::: "memory");
}

struct Ptrs {
    const float* in[33];
    float* out;
    unsigned char* ws;
};
typedef const __attribute__((address_space(4))) Ptrs* CP;
__device__ __forceinline__ CP launder(CP p) { asm volatile("" : "+s"(p)); return p; }

__device__ __forceinline__ void quant_load(CP P, int r, int lane, f32x4 (&x)[8]) {
    const int rr = r & 32767; const bool isv = r >= 32768;
    const float* src = (isv ? P->in[32] : P->in[31]) + (size_t)rr * DM + 4 * lane;
#pragma unroll
    for (int k = 0; k < 8; ++k) x[k] = *(const f32x4*)(src + 256 * k);
}
__device__ __forceinline__ void quant_finish(CP P, int r, int lane, const f32x4 (&x)[8]) {
    unsigned char* ws = P->ws; float* SC = (float*)(ws + WS_SCALE);
    const int rr = r & 32767; const bool isv = r >= 32768; const int layer = rr >> 14, e = rr & 16383;
    unsigned char* tab = ws + (isv ? WS_VT : WS_UT);
    float v[32]; float am = 0.f;
#pragma unroll
    for (int k = 0; k < 8; ++k) { const f32x4 xv = x[k];
        v[4 * k] = xv.x; v[4 * k + 1] = xv.y; v[4 * k + 2] = xv.z; v[4 * k + 3] = xv.w;
        am = fmaxf(am, fmaxf(fmaxf(fabsf(xv.x), fabsf(xv.y)), fmaxf(fabsf(xv.z), fabsf(xv.w)))); }
    am = wave_max(am); const bool f6 = (layer == 0 && L0_FMT == 6); const float sc = fmaxf(am, 1e-30f) * (f6 ? (1.0f / 7.5f) : (1.0f / 6.0f)), inv = 1.0f / sc;
#pragma unroll
    for (int i = 0; i < 32; ++i) v[i] *= inv;
    if (f6) {
        f32x16 a, b;
#pragma unroll
        for (int i = 0; i < 16; ++i) { a[i] = v[FP6_IDX_A(i)]; b[i] = v[FP6_IDX_B(i)]; }
        const u32x6 q = __builtin_amdgcn_cvt_scalef32_2xpk16_fp6_f32(a, b, 1.0f);
        unsigned char* dst = tab + (size_t)e * 1536;
        *(u32x4*)(dst + 16 * lane) = (u32x4){q[0], q[1], q[2], q[3]}; *(u32x2*)(dst + 1024 + 8 * lane) = (u32x2){q[4], q[5]};
    } else {
        u32x4 q;
#pragma unroll
        for (int d = 0; d < 4; ++d) { unsigned w = 0u;
            w = __builtin_amdgcn_cvt_scalef32_pk_fp4_f32(w, v[8 * d + 0], v[8 * d + 1], 1.0f, 0); w = __builtin_amdgcn_cvt_scalef32_pk_fp4_f32(w, v[8 * d + 2], v[8 * d + 3], 1.0f, 1);
            w = __builtin_amdgcn_cvt_scalef32_pk_fp4_f32(w, v[8 * d + 4], v[8 * d + 5], 1.0f, 2); w = __builtin_amdgcn_cvt_scalef32_pk_fp4_f32(w, v[8 * d + 6], v[8 * d + 7], 1.0f, 3); q[d] = w; }
        *(u32x4*)(tab + (size_t)layer * 32 * MiB + (size_t)e * 1024 + 16 * lane) = q;
    }
    if (lane == 0) SC[r] = sc;
}

template <int NS> __device__ __forceinline__ void quant_stream(CP P, LAS unsigned char* ring, int r0, int rstep, int n, int lane, LAS unsigned* progress = nullptr) {
    static_assert(NS == 2 || NS == 3, "ring depth");
    if (n <= 0) return;
    int si = 0, sr = 0;
#pragma unroll 1
    for (int k = 0; k < n + NS - 1; ++k) {
        {   const int r = r0 + (k < n ? k : n - 1) * rstep; const float* src = (r >= 32768 ? P->in[32] : P->in[31]) + (size_t)(r & 32767) * DM + 4 * lane;
#pragma unroll
            for (int j = 0; j < 8; ++j) __builtin_amdgcn_global_load_lds((const unsigned*)(src + 256 * j), (LAS unsigned*)(ring + si * 8192 + j * 1024), 16, 0, 0);
            si = si == NS - 1 ? 0 : si + 1; }
        if (k >= NS - 1) {
            if (NS == 3) asm volatile("s_waitcnt vmcnt(16)" ::: "memory"); else asm volatile("s_waitcnt vmcnt(8)" ::: "memory");
            f32x4 x[8];
#pragma unroll
            for (int j = 0; j < 8; ++j) x[j] = *(const LAS f32x4*)(ring + sr * 8192 + j * 1024 + lane * 16);
            quant_finish(P, r0 + (k - (NS - 1)) * rstep, lane, x); sr = sr == NS - 1 ? 0 : sr + 1;
            if (progress && lane == 0) __atomic_fetch_add(progress, 1u, __ATOMIC_RELAXED); }
    }
    asm volatile("s_waitcnt vmcnt(0)" ::: "memory");
}
constexpr int QS_P1ROWS = 18432, QS_PROWS = (65536 - QS_P1ROWS) / 256  ;

__device__ __forceinline__ void late_transpose_item(CP P, int item, LAS float* scr, int lane) {
    unsigned char* ws = P->ws; constexpr int I_SQ = 32 * 64, I_C = 32 * (C_COLS / 32);
    int r = item;
    if (r < I_SQ) { p0_transpose_item(P->in[19], DM, DM, (bf16_t*)(ws + WS_WT_ABO), 0, scr, r, lane); return; } r -= I_SQ;
    if (r < I_C) { p0_transpose_item(P->in[20], DM, C_COLS, (bf16_t*)(ws + WS_WT_C), 0, scr, r, lane, nullptr, true); return; } r -= I_C;
    if (r < I_SQ) { p0_transpose_item(P->in[28], DM, DM, (bf16_t*)(ws + WS_WT_CO), 0, scr, r, lane); return; } r -= I_SQ;
    if (r < I_SQ) { p0_transpose_item(P->in[29], DM, DM, (bf16_t*)(ws + WS_WT_Q), 0, scr, r, lane, P->in[2]); return; } r -= I_SQ;
    p0_transpose_item(P->in[29] + (size_t)DM * DM, DM, DM, (bf16_t*)(ws + WS_WT_Q + 8 * MiB), 0, scr, r, lane, P->in[2] + DM);
}

__device__ __forceinline__ void phase_prologue(const Frame& F, CP P) {
    unsigned char* ws = P->ws;
    LAS float* scr = (LAS float*)(F.lds + F.wave * 16384);
    constexpr int I_AB = 32 * (AB_COLS / 32), I_SQ = 32 * 64;
    for (int it = F.gw; it < I_AB; it += F.NGW) p0_transpose_item(P->in[3], DM, AB_COLS, (bf16_t*)(ws + WS_WT_AB), 0, scr, it, F.lane);
    const int gt = F.bid * NTHREADS + F.tid, NGT = F.G * NTHREADS;
    {   bf16_t* BT = (bf16_t*)(ws + WS_BT_LORA);
        for (int it = gt; it < 3072 * 32; it += NGT) {
            const int kg = it / 3072, n = it % 3072, k0 = kg * 8; float v[8];
#pragma unroll
            for (int i = 0; i < 8; ++i) { const int k = k0 + i; float x = 0.f;
                if (n < 1024) { if (k < 64) x = P->in[6][(size_t)k * 1024 + n]; }
                else if (n < 2048) { if (k >= 64 && k < 128) x = P->in[8][(size_t)(k - 64) * 1024 + (n - 1024)]; }
                else { if (k >= 128) x = P->in[9][(size_t)(k - 128) * 1024 + (n - 2048)]; }
                v[i] = x; }
            *(u32x4*)(BT + (size_t)n * 256 + k0) = pack8(v);
        } }
    {   const f32x4* src = (const f32x4*)P->in[30]; u32x4* dst = (u32x4*)(ws + WS_KEYS);
        for (int it = gt; it < 65536; it += NGT) { const f32x4 a = src[2 * it], b = src[2 * it + 1]; u32x4 o; o.x = pkbf(a.x, a.y); o.y = pkbf(a.z, a.w); o.z = pkbf(b.x, b.y); o.w = pkbf(b.z, b.w); dst[it] = o; } }
    {   f32x2* rt = (f32x2*)(ws + WS_ROPE);
        for (int it = gt; it < 4096 * 8; it += NGT) { const int pos = it >> 3, i = it & 7; const float inv = powf(500000.0f, -(float)i * 0.125f); const float ang = (float)pos * inv; rt[it] = (f32x2){cosf(ang), sinf(ang)}; } }
    for (int m = F.gw; m < M_TOK; m += F.NGW) rms_row_to_bf16(P->in[0] + (size_t)m * DM, P->in[1], (bf16_t*)(ws + WS_XN) + (size_t)m * DM, F.lane);
}

__device__ __forceinline__ void phase_row_a(const Frame& F, CP P) {
    const bf16_t* PA = (const bf16_t*)(P->ws + WS_PA); bf16_t* Z = (bf16_t*)(P->ws + WS_Z); bf16_t* AL = (bf16_t*)(P->ws + WS_ALORA);
    const float* mu = P->in[4] + 3072; const float* lnw = P->in[15]; const float* lnb = P->in[16];
    const int lane = F.lane;
    for (int t = F.gw; t < M_TOK; t += F.NGW) {
        {   const int c = 4 * lane;
            const u32x2 cu = *(const u32x2*)(PA + (size_t)t * A_COLS + 3072 + c);
            u32x2 pv = (u32x2){0u, 0u}; if ((t & (SEQ - 1)) != 0) pv = *(const u32x2*)(PA + (size_t)(t - 1) * A_COLS + 3072 + c);
            const f32x4 m4 = *(const f32x4*)(mu + c);
            float cur[4] = {bf_lo(cu.x), bf_hi(cu.x), bf_lo(cu.y), bf_hi(cu.y)}, prv[4] = {bf_lo(pv.x), bf_hi(pv.x), bf_lo(pv.y), bf_hi(pv.y)}, mm[4] = {m4.x, m4.y, m4.z, m4.w}, o[4];
#pragma unroll
            for (int i = 0; i < 4; ++i) { const float v = cur[i] + (prv[i] - cur[i]) * mm[i]; o[i] = (c < 64) ? tanhf(v) : ((c < 128) ? v : sigmoidf_(v)); }
            u32x2 w; w.x = pkbf(o[0], o[1]); w.y = pkbf(o[2], o[3]); *(u32x2*)(AL + (size_t)t * 256 + c) = w; }
        {   bf16_t* zr = Z + (size_t)t * 2048 + 1024; float v[16]; float t8[8];
            unpack8(*(const u32x4*)(zr + 8 * lane), t8);
#pragma unroll
            for (int i = 0; i < 8; ++i) v[i] = t8[i];
            unpack8(*(const u32x4*)(zr + 512 + 8 * lane), t8);
#pragma unroll
            for (int i = 0; i < 8; ++i) v[8 + i] = t8[i];
            float s = 0.f;
#pragma unroll
            for (int i = 0; i < 16; ++i) s += v[i];
            const float mean = wave_sum(s) * (1.0f / 1024.0f); float q = 0.f;
#pragma unroll
            for (int i = 0; i < 16; ++i) { v[i] -= mean; q += v[i] * v[i]; }
            const float rstd = rsqrtf(wave_sum(q) * (1.0f / 1024.0f) + 1e-5f);
#pragma unroll
            for (int j = 0; j < 2; ++j) { const int c = 512 * j + 8 * lane; float o[8];
                const f32x4 w0 = *(const f32x4*)(lnw + c), w1 = *(const f32x4*)(lnw + c + 4), b0 = *(const f32x4*)(lnb + c), b1 = *(const f32x4*)(lnb + c + 4);
                const float ww[8] = {w0.x, w0.y, w0.z, w0.w, w1.x, w1.y, w1.z, w1.w}, bb[8] = {b0.x, b0.y, b0.z, b0.w, b1.x, b1.y, b1.z, b1.w};
#pragma unroll
                for (int i = 0; i < 8; ++i) o[i] = v[8 * j + i] * rstd * ww[i] + bb[i];
                *(u32x4*)(zr + c) = pack8(o); } }
    }
}

__device__ __forceinline__ void sgu_tile(const Frame& F, CP P, int tile) {
    const int tid = F.tid, wave = F.wave, lane = F.lane, q31 = lane & 31, hh = lane >> 5; const int cch = tile >> 3, g = tile & 7, t0 = cch * 128;
    const bf16_t* Z = (const bf16_t*)(P->ws + WS_Z); bf16_t* YAB = (bf16_t*)(P->ws + WS_YAB);
    const float* Wg = P->in[17] + (size_t)g * 16384; const float* bs = P->in[18] + g * 128;
    LAS unsigned char* Wl = F.lds;
    LAS unsigned char* Vl = F.lds + 34816;
    f32x4 wl[8];
#pragma unroll
    for (int i = 0; i < 8; ++i) { const int p = tid + 512 * i; wl[i] = *(const f32x4*)(Wg + (p >> 5) * 128 + (p & 31) * 4); }
#pragma unroll
    for (int i = 0; i < 8; ++i) { const int p = tid + 512 * i, t = p >> 5, s4 = (p & 31) * 4; f32x4 w = wl[i];
        if (s4 + 0 > t) w.x = 0.f; if (s4 + 1 > t) w.y = 0.f; if (s4 + 2 > t) w.z = 0.f; if (s4 + 3 > t) w.w = 0.f;
        *(LAS u32x2*)(Wl + t * 272 + s4 * 2) = (u32x2){pkbf(w.x, w.y), pkbf(w.z, w.w)}; }
#pragma unroll
    for (int i = 0; i < 4; ++i) { const int p = tid + 512 * i, s = p >> 4, d8 = (p & 15) * 8;
        *(LAS u32x4*)(Vl + s * 320 + d8 * 2) = *(const u32x4*)(Z + (size_t)(t0 + s) * 2048 + 1024 + g * 128 + d8); }
    __syncthreads();
    const int dt = wave & 3, tiA = (wave >> 2) ? 1 : 0, tiB = (wave >> 2) ? 2 : 3;
    f32x16 accA, accB;
#pragma unroll
    for (int r = 0; r < 16; ++r) { accA[r] = 0.f; accB[r] = 0.f; }
    LAS unsigned char* Vb = Vl + (8 * hh + ((lane >> 2) & 3)) * 320 + (32 * dt + 16 * ((lane >> 4) & 1) + 4 * (lane & 3)) * 2;
    const LAS unsigned char* WbA = Wl + (32 * tiA + q31) * 272 + hh * 16; const LAS unsigned char* WbB = Wl + (32 * tiB + q31) * 272 + hh * 16;
    const int nA = 2 * tiA + 2, nB = 2 * tiB + 2;
    for (int ks = 0; ks < nB; ++ks) {
        const s16x4 lo = vtr(Vb + (16 * ks) * 320), hi = vtr(Vb + (16 * ks + 4) * 320);
        const bf16x8 vf = (bf16x8){lo[0], lo[1], lo[2], lo[3], hi[0], hi[1], hi[2], hi[3]};
        const bf16x8 wb = *(const LAS bf16x8*)(WbB + ks * 32);
        accB = __builtin_amdgcn_mfma_f32_32x32x16_bf16(vf, wb, accB, 0, 0, 0);
        if (ks < nA) { const bf16x8 wa = *(const LAS bf16x8*)(WbA + ks * 32); accA = __builtin_amdgcn_mfma_f32_32x32x16_bf16(vf, wa, accA, 0, 0, 0); }
    }
#pragma unroll
    for (int which = 0; which < 2; ++which) { const int ti = which ? tiB : tiA; const int t = 32 * ti + q31; const float bias = bs[t];
        const bf16_t* up = Z + (size_t)(t0 + t) * 2048 + g * 128 + 32 * dt + 4 * hh; bf16_t* op = YAB + (size_t)(t0 + t) * 2048 + 1024 + g * 128 + 32 * dt + 4 * hh;
#pragma unroll
        for (int g4 = 0; g4 < 4; ++g4) { const u32x2 uu = *(const u32x2*)(up + 8 * g4);
            const float a0 = which ? accB[4 * g4 + 0] : accA[4 * g4 + 0], a1 = which ? accB[4 * g4 + 1] : accA[4 * g4 + 1], a2 = which ? accB[4 * g4 + 2] : accA[4 * g4 + 2], a3 = which ? accB[4 * g4 + 3] : accA[4 * g4 + 3];
            *(u32x2*)(op + 8 * g4) = (u32x2){pkbf(bf_lo(uu.x) * (a0 + bias), bf_hi(uu.x) * (a1 + bias)), pkbf(bf_lo(uu.y) * (a2 + bias), bf_hi(uu.y) * (a3 + bias))}; } }
    __syncthreads();
}

__device__ __forceinline__ void phase_gn(const Frame& F, CP P) {
    const float* Y = (const float*)(P->ws + WS_Y); const float* BON = (const float*)(P->ws + WS_BONUS);
    const bf16_t* GT = (const bf16_t*)(P->ws + WS_GATE); bf16_t* YAB = (bf16_t*)(P->ws + WS_YAB);
    const float* gnw = P->in[13]; const float* gnb = P->in[14];
    const int lane = F.lane, c = 16 * lane, h = lane >> 2, q = lane & 3;
    for (int t = F.gw; t < M_TOK; t += F.NGW) {
        float y[16], tmp[16], tb[16], o[16];
        ld16f(Y + (size_t)t * 1024 + c, y); float s = 0.f;
#pragma unroll
        for (int i = 0; i < 16; ++i) s += y[i];
        const float mean = quad_sum(s) * (1.0f / 64.0f); float qq = 0.f;
#pragma unroll
        for (int i = 0; i < 16; ++i) { y[i] -= mean; qq += y[i] * y[i]; }
        const float rstd = rsqrtf(quad_sum(qq) * (1.0f / 64.0f) + 64e-5f);
        ld16f(gnw + c, tmp); ld16f(gnb + c, tb);
#pragma unroll
        for (int i = 0; i < 16; ++i) y[i] = y[i] * rstd * tmp[i] + tb[i];
        const float bon = BON[(size_t)t * 16 + h];
        {   const bf16_t* PA = (const bf16_t*)(P->ws + WS_PA); float vp[16], mv[16];
            ld16bf(PA + (size_t)t * A_COLS + 2048 + c, tmp); ld16f(P->in[4] + 2048 + c, mv);
            if ((t & (SEQ - 1)) != 0) { ld16bf(PA + (size_t)(t - 1) * A_COLS + 2048 + c, vp);
#pragma unroll
                for (int i = 0; i < 16; ++i) tmp[i] += (vp[i] - tmp[i]) * mv[i]; }
            else {
#pragma unroll
                for (int i = 0; i < 16; ++i) tmp[i] -= tmp[i] * mv[i]; } }
        ld16bf(GT + (size_t)t * 1024 + c, tb);
#pragma unroll
        for (int i = 0; i < 16; ++i) o[i] = (y[i] + bon * tmp[i]) * tb[i];
        st16bf(YAB + (size_t)t * 2048 + c, o);
    }
}

__device__ __forceinline__ void phase_rmsnorm(const Frame& F, const bf16_t* XB, const float* g, bf16_t* XN) {
    const int lane = F.lane;
    for (int m = F.gw; m < M_TOK; m += F.NGW) {
        float v[4][8]; float s = 0.f;
#pragma unroll
        for (int j = 0; j < 4; ++j) { unpack8(*(const u32x4*)(XB + (size_t)m * DM + 512 * j + 8 * lane), v[j]);
#pragma unroll
            for (int i = 0; i < 8; i += 2) s += v[j][i] * v[j][i] + v[j][i + 1] * v[j][i + 1]; }
        const float rstd = rsqrtf(wave_sum(s) * (1.0f / DM) + 1e-6f);
#pragma unroll
        for (int j = 0; j < 4; ++j) { const f32x4 g0 = *(const f32x4*)(g + 512 * j + 8 * lane), g1 = *(const f32x4*)(g + 512 * j + 8 * lane + 4);
            const float o[8] = {v[j][0] * rstd * g0.x, v[j][1] * rstd * g0.y, v[j][2] * rstd * g0.z, v[j][3] * rstd * g0.w, v[j][4] * rstd * g1.x, v[j][5] * rstd * g1.y, v[j][6] * rstd * g1.z, v[j][7] * rstd * g1.w};
            *(u32x4*)(XN + (size_t)m * DM + 512 * j + 8 * lane) = pack8(o); }
    }
}

constexpr int TK_WAVE_BYTES = 17024;
__device__ __forceinline__ void peer_topk_wave(const Frame& F, CP P, int layer, int h, int t0) {
    const int wave = F.wave, lane = F.lane, lr = lane & 15, lg = lane >> 4;
    const bf16_t* KEYS = (const bf16_t*)(P->ws + WS_KEYS) + (size_t)((layer * 8 + h) * 2) * 16384;
    const bf16_t* QP = (const bf16_t*)(P->ws + WS_QP);
    int* EIDX = (int*)(P->ws + WS_EIDX); float* EGATE = (float*)(P->ws + WS_EGATE);
    LAS float* sc = (LAS float*)(F.lds + wave * TK_WAVE_BYTES);
    LAS float* rv = sc + 2176; LAS int* ri = (LAS int*)(rv + 1024); LAS float* fvs = rv + 2048; LAS int* cds = (LAS int*)(rv + 2064);
    bf16x8 kb[8][4];
    bf16x8 qa[4];
#pragma unroll
    for (int nt = 0; nt < 8; ++nt)
#pragma unroll
        for (int ks = 0; ks < 4; ++ks) kb[nt][ks] = *(const bf16x8*)(KEYS + (size_t)(16 * nt + lr) * 128 + 32 * ks + 8 * lg);
#pragma unroll
    for (int ks = 0; ks < 4; ++ks) qa[ks] = *(const bf16x8*)(QP + (size_t)(t0 + lr) * 2048 + h * 256 + 32 * ks + 8 * lg);
#pragma unroll 1
    for (int st = 0; st < 4; ++st) { const int p = st >> 1, bt = st & 1;
        {
            f32x4 acc[8];
#pragma unroll
            for (int nt = 0; nt < 8; ++nt) { acc[nt] = (f32x4){0.f, 0.f, 0.f, 0.f};
#pragma unroll
                for (int ks = 0; ks < 4; ++ks) acc[nt] = __builtin_amdgcn_mfma_f32_16x16x32_bf16(qa[ks], kb[nt][ks], acc[nt], 0, 0, 0); }
            if (st < 3) { const int pn = (st + 1) >> 1, btn = (st + 1) & 1;
#pragma unroll
                for (int ks = 0; ks < 4; ++ks) qa[ks] = *(const bf16x8*)(QP + (size_t)(t0 + 16 * btn + lr) * 2048 + h * 256 + pn * 128 + 32 * ks + 8 * lg);
                if (st == 1) {
#pragma unroll
                    for (int nt = 0; nt < 8; ++nt)
#pragma unroll
                        for (int ks = 0; ks < 4; ++ks) kb[nt][ks] = *(const bf16x8*)(KEYS + (size_t)(128 + 16 * nt + lr) * 128 + 32 * ks + 8 * lg); } }
#pragma unroll
            for (int nt = 0; nt < 8; ++nt)
#pragma unroll
                for (int r = 0; r < 4; ++r) sc[(4 * lg + r) * 132 + 16 * nt + lr] = acc[nt][r];
#pragma unroll 1
            for (int tk = 0; tk < 16; ++tk) {
                const float a0 = sc[tk * 132 + lane], a1 = sc[tk * 132 + 64 + lane]; const unsigned k0 = fkey(a0), k1 = fkey(a1); unsigned thr = 0u;
                for (int bit = 31; bit >= 0; --bit) { const unsigned cd = thr | (1u << bit);
                    const int cnt = __popcll(__ballot(k0 >= cd)) + __popcll(__ballot(k1 >= cd));
                    if (cnt >= 16) { thr = cd; if (cnt == 16) break; } }
                const unsigned long long b0 = __ballot(k0 >= thr), b1 = __ballot(k1 >= thr);
                const int s0 = __builtin_amdgcn_mbcnt_hi((unsigned)(b0 >> 32), __builtin_amdgcn_mbcnt_lo((unsigned)b0, 0u));
                const int s1 = __popcll(b0) + __builtin_amdgcn_mbcnt_hi((unsigned)(b1 >> 32), __builtin_amdgcn_mbcnt_lo((unsigned)b1, 0u));
                const int ro = (p * 32 + 16 * bt + tk) * 16;
                if (k0 >= thr && s0 < 16) { rv[ro + s0] = a0; ri[ro + s0] = lane; }
                if (k1 >= thr && s1 < 16) { rv[ro + s1] = a1; ri[ro + s1] = lane + 64; } }
        }
    }
#pragma unroll 1
    for (int tk = 0; tk < 32; ++tk) {
        const int t = t0 + tk; const LAS float* sv0 = rv + tk * 16; const LAS float* sv1 = rv + (32 + tk) * 16;
        float cand[4]; unsigned ck[4];
        {   const float s0 = sv0[lane >> 2]; const f32x4 s1 = *(const LAS f32x4*)(sv1 + (lane & 3) * 4);
            cand[0] = s0 + s1.x; cand[1] = s0 + s1.y; cand[2] = s0 + s1.z; cand[3] = s0 + s1.w;
#pragma unroll
            for (int m = 0; m < 4; ++m) ck[m] = fkey(cand[m]); }
        {   unsigned thr = 0u;
            for (int bit = 31; bit >= 0; --bit) { const unsigned cd = thr | (1u << bit);
                const int cnt = (__popcll(__ballot(ck[0] >= cd)) + __popcll(__ballot(ck[1] >= cd))) + (__popcll(__ballot(ck[2] >= cd)) + __popcll(__ballot(ck[3] >= cd)));
                if (cnt >= 16) { thr = cd; if (cnt == 16) break; } }
            int base = 0;
#pragma unroll
            for (int m = 0; m < 4; ++m) { const unsigned long long bm = __ballot(ck[m] >= thr);
                const int sl = base + __builtin_amdgcn_mbcnt_hi((unsigned)(bm >> 32), __builtin_amdgcn_mbcnt_lo((unsigned)bm, 0u));
                if (ck[m] >= thr && sl < 16) { fvs[sl] = cand[m]; cds[sl] = lane * 4 + m; }
                base += __popcll(bm); } }
        if (lane < 16) { const float fv = fvs[lane]; const int code = cds[lane];
            const int e0 = ri[tk * 16 + (code >> 4)], e1 = ri[(32 + tk) * 16 + (code & 15)];
            EIDX[((size_t)t * 8 + h) * 16 + lane] = e0 * 128 + e1; EGATE[((size_t)t * 8 + h) * 16 + lane] = fv; }
    }
}

__device__ __forceinline__ float wave_sum_u(float x) {
    x = row16_sum(x); const int xi = __float_as_int(x);
    return (__int_as_float(__builtin_amdgcn_readlane(xi, 0)) + __int_as_float(__builtin_amdgcn_readlane(xi, 16))) + (__int_as_float(__builtin_amdgcn_readlane(xi, 32)) + __int_as_float(__builtin_amdgcn_readlane(xi, 48)));
}
template <int FMT> struct RowQ { u32x4 a; u32x2 b; };
template <int FMT> __device__ __forceinline__ constexpr int rowq_elem(int j) { return (FMT == 6 && FP6_INTERLEAVED) ? ((j & 1) ? 16 + (j >> 1) : (j >> 1)) : j; }
template <int FMT> __device__ __forceinline__ void rowq_load(RowQ<FMT>& q, const unsigned char* tab, int eid, int lane) {
    if (FMT == 6) { const unsigned char* row = tab + (size_t)eid * 1536; q.a = *(const u32x4*)(row + 16 * lane); q.b = *(const u32x2*)(row + 1024 + 8 * lane); }
    else { q.a = *(const u32x4*)(tab + (size_t)eid * 1024 + 16 * lane); }
}
template <int FMT> __device__ __forceinline__ void rowq_deq(const RowQ<FMT>& q, f32x2 (&o)[16]) {
    if (FMT == 6) { const u32x6 s = (u32x6){q.a[0], q.a[1], q.a[2], q.a[3], q.b[0], q.b[1]}; const f32x32 r = __builtin_amdgcn_cvt_scalef32_pk32_f32_fp6(s, 1.0f);
#pragma unroll
        for (int k = 0; k < 16; ++k) o[k] = (f32x2){r[2 * k], r[2 * k + 1]}; }
    else {
#pragma unroll
        for (int d = 0; d < 4; ++d) { o[4 * d] = __builtin_amdgcn_cvt_scalef32_pk_f32_fp4(q.a[d], 1.0f, 0); o[4 * d + 1] = __builtin_amdgcn_cvt_scalef32_pk_f32_fp4(q.a[d], 1.0f, 1);
            o[4 * d + 2] = __builtin_amdgcn_cvt_scalef32_pk_f32_fp4(q.a[d], 1.0f, 2); o[4 * d + 3] = __builtin_amdgcn_cvt_scalef32_pk_f32_fp4(q.a[d], 1.0f, 3); } }
}
typedef int v8i_t __attribute__((ext_vector_type(8)));
constexpr int PEER_E_LDS = 4 * TK_WAVE_BYTES;
#ifndef PEER_U_MFMA
#define PEER_U_MFMA 1
#endif
template <int FMT, int DIAG = 0, bool FINAL = false>
__device__ __forceinline__ void phase_experts(const Frame& F, CP P, int layer, const float* gnext, const bf16_t* XB, void* Xo, int tb, int te, int ts) {
    const bf16_t* XN = (const bf16_t*)(P->ws + WS_XN); bf16_t* XNo = (bf16_t*)(P->ws + WS_XN);
    const unsigned char* UT = P->ws + WS_UT + (size_t)layer * 32 * MiB; const unsigned char* VT = P->ws + WS_VT + (size_t)layer * 32 * MiB;
    const float* SCU = (const float*)(P->ws + WS_SCALE) + layer * 16384; const float* SCV = SCU + 32768;
    const int* EIDX = (const int*)(P->ws + WS_EIDX); const float* EGATE = (const float*)(P->ws + WS_EGATE);
    const int lane = F.lane; const float* gffn = P->in[2] + layer * DM;
    constexpr bool UMF = (FMT == 4 && DIAG == 0 && PEER_U_MFMA);
    if (UMF) { *(LAS u32x4*)(F.lds + PEER_E_LDS + F.wave * 8192 + 4096 + lane * 32) = (u32x4){0u, 0u, 0u, 0u}; *(LAS u32x4*)(F.lds + PEER_E_LDS + F.wave * 8192 + 4096 + lane * 32 + 16) = (u32x4){0u, 0u, 0u, 0u}; }
#pragma unroll 1
    for (int t = tb; t < te; t += ts) {
        f32x2 hx[16]; float rstd; u32x2 xw8[8];
        {   float hn[32]; float ss = 0.f;
#pragma unroll
            for (int j = 0; j < 8; ++j) { const u32x2 w = *(const u32x2*)(XB + (size_t)t * DM + 256 * j + 4 * lane); xw8[j] = w; hn[4 * j] = bf_lo(w.x); hn[4 * j + 1] = bf_hi(w.x); hn[4 * j + 2] = bf_lo(w.y); hn[4 * j + 3] = bf_hi(w.y);
                ss += (hn[4 * j] * hn[4 * j] + hn[4 * j + 1] * hn[4 * j + 1]) + (hn[4 * j + 2] * hn[4 * j + 2] + hn[4 * j + 3] * hn[4 * j + 3]); }
            rstd = rsqrtf(wave_sum(ss) * (1.0f / DM) + 1e-6f);
#pragma unroll
            for (int j = 0; j < 8; ++j) { const f32x4 g4 = *(const f32x4*)(gffn + 256 * j + 4 * lane); hn[4 * j] *= g4.x; hn[4 * j + 1] *= g4.y; hn[4 * j + 2] *= g4.z; hn[4 * j + 3] *= g4.w; }
#pragma unroll
            for (int k = 0; k < 16; ++k) hx[k] = (f32x2){hn[rowq_elem<FMT>(2 * k)], hn[rowq_elem<FMT>(2 * k + 1)]};
            if (UMF) {
                LAS unsigned char* wl = F.lds + PEER_E_LDS + F.wave * 8192;
                float rs[32];
#pragma unroll
                for (int n = 0; n < 32; ++n) rs[n] = hn[n] * rstd;
#pragma unroll
                for (int tm = 0; tm < 4; ++tm) { const float up = tm == 0 ? 0.5f : (tm == 1 ? 4.0f : (tm == 2 ? 32.0f : 256.0f)), dn = 1.0f / up; unsigned q[4];
#pragma unroll
                    for (int d = 0; d < 4; ++d) { unsigned w = 0u;
#define UMF_PK(b_) w = __builtin_amdgcn_cvt_scalef32_pk_fp4_f32(w, rs[8 * d + 2 * (b_)] * up, rs[8 * d + 2 * (b_) + 1] * up, 1.0f, b_)
                        UMF_PK(0); UMF_PK(1); UMF_PK(2); UMF_PK(3);
#undef UMF_PK
                        q[d] = w;
                        if (tm < 3) {
#define UMF_UP(b_) do { const f32x2 f = __builtin_amdgcn_cvt_scalef32_pk_f32_fp4(w, 1.0f, b_); rs[8 * d + 2 * (b_)] -= f.x * dn; rs[8 * d + 2 * (b_) + 1] -= f.y * dn; } while (0)
                            UMF_UP(0); UMF_UP(1); UMF_UP(2); UMF_UP(3);
#undef UMF_UP
                        } }
                    *(LAS u32x4*)(wl + 1024 * tm + lane * 16) = (u32x4){q[0], q[1], q[2], q[3]}; } } }
        int i0 = EIDX[(size_t)t * 128 + lane], i1 = EIDX[(size_t)t * 128 + 64 + lane]; if (DIAG == 2) { i0 &= 255; i1 &= 255; }
        float g0 = EGATE[(size_t)t * 128 + lane] * rstd, g1 = EGATE[(size_t)t * 128 + 64 + lane] * rstd;
        {   const float m0 = row16_max(g0), m1 = row16_max(g1); const float e0 = __expf(g0 - m0), e1 = __expf(g1 - m1); g0 = e0 / row16_sum(e0); g1 = e1 / row16_sum(e1); }
        float a0 = 0.f, a1 = 0.f;
        const float sc0 = SCU[i0] * rstd, sc1 = SCU[i1] * rstd;
        if (UMF) {
            LAS unsigned char* wl = F.lds + PEER_E_LDS + F.wave * 8192; const int mi = lane & 15, mg = lane >> 4;
            const LAS unsigned char* bb = wl + (mi < 4 ? 1024 * mi : 4096) + 32 * mg;
            const float cw = mi == 0 ? 2.0f : (mi == 1 ? 0.25f : (mi == 2 ? 0.03125f : (mi == 3 ? 0.00390625f : 0.f)));
            const unsigned char* rbase[8];
#pragma unroll
            for (int rb = 0; rb < 8; ++rb) { const int eid = __shfl(rb < 4 ? i0 : i1, (16 * rb + mi) & 63); rbase[rb] = UT + (size_t)eid * 1024 + 32 * mg; }
            f32x4 acc[8];
#pragma unroll
            for (int rb = 0; rb < 8; ++rb) acc[rb] = (f32x4){0.f, 0.f, 0.f, 0.f};
            u32x4 av0[4][2], av1[4][2];
#define PEER_UA_LOAD(buf, h4, mm) do { _Pragma("unroll") for (int q_ = 0; q_ < 4; ++q_) _Pragma("unroll") for (int e_ = 0; e_ < 2; ++e_) buf[q_][e_] = *(const u32x4*)(rbase[(h4) + q_] + 128 * (mm) + 16 * e_); } while (0)
#define PEER_UA_MMA(buf, h4) do { _Pragma("unroll") for (int q_ = 0; q_ < 4; ++q_) _Pragma("unroll") for (int e_ = 0; e_ < 2; ++e_) \
                acc[(h4) + q_] = __builtin_amdgcn_mfma_scale_f32_16x16x128_f8f6f4((v8i_t){(int)buf[q_][e_].x, (int)buf[q_][e_].y, (int)buf[q_][e_].z, (int)buf[q_][e_].w, 0, 0, 0, 0}, bv[e_], acc[(h4) + q_], 4, 4, 0, 0x7f7f7f7f, 0, 0x7f7f7f7f); } while (0)
            PEER_UA_LOAD(av0, 0, 0); PEER_UA_LOAD(av1, 4, 0);
#pragma unroll 1
            for (int m = 0; m < 8; ++m) {
                v8i_t bv[2];
#pragma unroll
                for (int e = 0; e < 2; ++e) { const u32x4 q0 = *(const LAS u32x4*)(bb + 128 * m + 16 * e);
                    bv[e] = (v8i_t){(int)q0.x, (int)q0.y, (int)q0.z, (int)q0.w, 0, 0, 0, 0}; }
                const int mn = m < 7 ? m + 1 : 7;
                PEER_UA_MMA(av0, 0); PEER_UA_LOAD(av0, 0, mn);
                PEER_UA_MMA(av1, 4); PEER_UA_LOAD(av1, 4, mn);
            }
#undef PEER_UA_LOAD
#undef PEER_UA_MMA
#pragma unroll
            for (int rb = 0; rb < 8; ++rb) { f32x4 y; y.x = quad_sum(acc[rb].x * cw); y.y = quad_sum(acc[rb].y * cw); y.z = quad_sum(acc[rb].z * cw); y.w = quad_sum(acc[rb].w * cw);
                if (mi == 0) *(LAS f32x4*)(wl + 6144 + (16 * rb + 4 * mg) * 4) = y; }
            const float pv0 = *(const LAS float*)(wl + 6144 + lane * 4), pv1 = *(const LAS float*)(wl + 6144 + 256 + lane * 4);
            a0 = gelu1(pv0 * SCU[i0]) * g0; a1 = gelu1(pv1 * SCU[i1]) * g1;
        } else
#pragma unroll
        for (int half = 0; half < 2; ++half) {
            const int iv = half ? i1 : i0;
            for (int e8 = 0; e8 < 64; e8 += 8) {
                RowQ<FMT> ld[8];
#pragma unroll
                for (int x = 0; x < 8; ++x) { const int eid = __builtin_amdgcn_readlane(iv, e8 + x); rowq_load<FMT>(ld[x], UT, eid, lane); }
                float pv = 0.f;
#pragma unroll
                for (int x = 0; x < 8; ++x) { if (DIAG == 3) { pv += __uint_as_float((ld[x].a[0] ^ ld[x].a[1] ^ ld[x].a[2] ^ ld[x].a[3]) & 0x3fffffu) * hx[x].x; continue; }
                    f32x2 r[16]; rowq_deq<FMT>(ld[x], r); f32x2 s2 = r[0] * hx[0];
#pragma unroll
                    for (int k = 1; k < 16; ++k) s2 = r[k] * hx[k] + s2;
                    const float r16 = row16_sum(s2.x + s2.y); pv = ((lane & 15) == ((e8 + x) & 15)) ? r16 : pv; }
                pv += __shfl_xor(pv, 16); pv += __shfl_xor(pv, 32);
                const float act = gelu1(pv * (half ? sc1 : sc0)) * (half ? g1 : g0);
                if (lane >= e8 && lane < e8 + 8) { if (half) a1 = act; else a0 = act; }
            }
        }
        f32x2 out2[16];
#pragma unroll
        for (int k = 0; k < 16; ++k) out2[k] = (f32x2){0.f, 0.f};
#pragma unroll
        for (int half = 0; half < 2; ++half) {
            const int iv = half ? i1 : i0; const float av = half ? a1 * SCV[i1] : a0 * SCV[i0];
            for (int e8 = 0; e8 < 64; e8 += 8) {
                RowQ<FMT> ld[8]; float ac[8];
#pragma unroll
                for (int x = 0; x < 8; ++x) { const int eid = __builtin_amdgcn_readlane(iv, e8 + x); rowq_load<FMT>(ld[x], VT, eid, lane);
                    ac[x] = __int_as_float(__builtin_amdgcn_readlane(__float_as_int(av), e8 + x)); }
#pragma unroll
                for (int x = 0; x < 8; ++x) { if (DIAG == 3) { out2[x].x += __uint_as_float((ld[x].a[0] ^ ld[x].a[1] ^ ld[x].a[2] ^ ld[x].a[3]) & 0x3fffffu) * ac[x]; continue; }
                    f32x2 r[16]; rowq_deq<FMT>(ld[x], r); const f32x2 a2 = (f32x2){ac[x], ac[x]};
#pragma unroll
                    for (int k = 0; k < 16; ++k) out2[k] = a2 * r[k] + out2[k]; }
            }
        }
        float out[32];
#pragma unroll
        for (int k = 0; k < 16; ++k) { out[rowq_elem<FMT>(2 * k)] = out2[k].x; out[rowq_elem<FMT>(2 * k + 1)] = out2[k].y; }
        float ss = 0.f;
#pragma unroll
        for (int k = 0; k < 8; ++k) { const u32x2 xw = xw8[k]; f32x4 a = (f32x4){bf_lo(xw.x), bf_hi(xw.x), bf_lo(xw.y), bf_hi(xw.y)};
            a.x += out[4 * k + 0]; a.y += out[4 * k + 1]; a.z += out[4 * k + 2]; a.w += out[4 * k + 3];
            if (FINAL) *(f32x4*)((float*)Xo + (size_t)t * DM + 4 * lane + 256 * k) = a;
            else *(u32x2*)((bf16_t*)Xo + (size_t)t * DM + 4 * lane + 256 * k) = (u32x2){pkbf(a.x, a.y), pkbf(a.z, a.w)};
            out[4 * k + 0] = a.x; out[4 * k + 1] = a.y; out[4 * k + 2] = a.z; out[4 * k + 3] = a.w;
            ss += (a.x * a.x + a.y * a.y) + (a.z * a.z + a.w * a.w); }
        if (gnext) { const float rstd2 = rsqrtf(wave_sum(ss) * (1.0f / DM) + 1e-6f);
#pragma unroll
            for (int k = 0; k < 8; ++k) { const f32x4 g4 = *(const f32x4*)(gnext + 256 * k + 4 * lane);
                *(u32x2*)(XNo + (size_t)t * DM + 256 * k + 4 * lane) = (u32x2){pkbf(out[4 * k] * rstd2 * g4.x, out[4 * k + 1] * rstd2 * g4.y), pkbf(out[4 * k + 2] * rstd2 * g4.z, out[4 * k + 3] * rstd2 * g4.w)}; } }
    }
}

__device__ __forceinline__ void phase_qknorm(const Frame& F, CP P) {
    bf16_t* QKV = (bf16_t*)(P->ws + WS_QKV); const f32x2* rope = (const f32x2*)(P->ws + WS_ROPE);
    const float* qn = P->in[21]; const float* kn = P->in[22]; const int lane = F.lane, d0 = 8 * (lane & 7), sub = lane & 7;
    for (int t = F.gw; t < M_TOK; t += F.NGW) {
        const int pos = t & (SEQ - 1);
#pragma unroll
        for (int j = 0; j < 8; ++j) {
            bf16_t* p = QKV + (size_t)t * C_COLS + 512 * j + 8 * lane; float v[8]; unpack8(*(const u32x4*)p, v);
            float ss = 0.f;
#pragma unroll
            for (int i = 0; i < 8; ++i) ss += v[i] * v[i];
            ss = oct_sum(ss); const float rstd = rsqrtf(ss * (1.0f / 64.0f) + 1e-6f);
            const float* wn = (j < 4) ? qn : kn; const f32x4 w0 = *(const f32x4*)(wn + d0), w1 = *(const f32x4*)(wn + d0 + 4);
            const float ww[8] = {w0.x, w0.y, w0.z, w0.w, w1.x, w1.y, w1.z, w1.w};
#pragma unroll
            for (int i = 0; i < 8; ++i) v[i] = v[i] * rstd * ww[i];
            float o[8];
#pragma unroll
            for (int i = 0; i < 8; ++i) { const float pr = dpp_mov<0xB1>(v[i]); const f32x2 cs = rope[pos * 8 + i];
                const float rot = (sub == 0) ? (v[i] * cs.x - pr * cs.y) : (v[i] * cs.x + pr * cs.y);
                o[i] = (sub < 2) ? rot : v[i]; }
            if (j < 4) {
#pragma unroll
                for (int i = 0; i < 8; ++i) o[i] *= QSCALE; }
            *(u32x4*)p = pack8(o);
        }
    }
}

constexpr int AT_KB = 9216, AT_BUF = 38912;
__device__ __forceinline__ float max3f(float a, float b, float c) { return __builtin_fmaxf(__builtin_fmaxf(a, b), c); }
template <int VAR>
__device__ __forceinline__ void attn_tile(LAS unsigned char* buf, int kv0, int q0w, int map, int lane, int q31, int hh, int qpos, bool first, const bf16x8 (&qf)[4],
                                          f32x16 (&O)[4], f32x16& negm, float& mref, float& lsum, LAS float* wsc) {
    LAS unsigned char* Kb = buf + map * AT_KB;
    f32x16 p0 = negm, p1 = negm;
#pragma unroll
    for (int ks = 0; ks < 4; ++ks) {
        const bf16x8 a0 = *(LAS bf16x8*)(Kb + q31 * 144 + ks * 32 + hh * 16);
        const bf16x8 a1 = *(LAS bf16x8*)(Kb + (32 + q31) * 144 + ks * 32 + hh * 16);
        if (VAR != 3) { p0 = __builtin_amdgcn_mfma_f32_32x32x16_bf16(a0, qf[ks], p0, 0, 0, 0);
        p1 = __builtin_amdgcn_mfma_f32_32x32x16_bf16(a1, qf[ks], p1, 0, 0, 0); } else { p0[ks] += __builtin_bit_cast(float, (int)a0[0]) ; p1[ks] += __builtin_bit_cast(float, (int)a1[1]); }
    }
    if (kv0 + 63 > q0w) {
#pragma unroll
        for (int r = 0; r < 16; ++r) { const int kv = kv0 + crow(r, hh); if (kv > qpos) p0[r] = -1.0e30f; if (kv + 32 > qpos) p1[r] = -1.0e30f; } }
    if (VAR != 2) {
    float ma = max3f(p0[0], p0[1], p1[0]), mb = max3f(p0[2], p0[3], p1[1]); ma = max3f(ma, p1[2], p1[3]);
#pragma unroll
    for (int r = 4; r < 16; r += 4) { ma = max3f(ma, p0[r], p0[r + 1]); mb = max3f(mb, p0[r + 2], p0[r + 3]); ma = max3f(ma, p1[r], p1[r + 1]); mb = max3f(mb, p1[r + 2], p1[r + 3]); }
    float mx = __builtin_fmaxf(ma, mb);
    {   const auto rr = __builtin_amdgcn_permlane32_swap(__float_as_uint(mx), __float_as_uint(mx), false, false); mx = __builtin_fmaxf(__uint_as_float(rr[0]), __uint_as_float(rr[1])); }
    if (first || __any(mx > 0.f)) {
        const float dl = first ? mx : __builtin_fmaxf(mx, 0.f); mref += dl;
#pragma unroll
        for (int r = 0; r < 16; ++r) { p0[r] -= dl; p1[r] -= dl; negm[r] = -mref; }
        if (first) lsum = 0.f;
        else { const float alpha = __builtin_amdgcn_exp2f(-dl); lsum *= alpha;
            if (hh == 0) wsc[q31] = alpha;
#pragma unroll
            for (int g = 0; g < 4; ++g) { const f32x4 al = *(LAS f32x4*)(wsc + 8 * g + 4 * hh);
#pragma unroll
                for (int d = 0; d < 4; ++d) { O[d][4 * g + 0] *= al.x; O[d][4 * g + 1] *= al.y; O[d][4 * g + 2] *= al.z; O[d][4 * g + 3] *= al.w; } } }
    }
    float ps0 = 0.f, ps1 = 0.f;
#pragma unroll
    for (int r = 0; r < 16; ++r) { p0[r] = __builtin_amdgcn_exp2f(p0[r]); p1[r] = __builtin_amdgcn_exp2f(p1[r]); ps0 += p0[r]; ps1 += p1[r]; }
    lsum += ps0 + ps1;
    }
    bf16x8 pa[4];
#pragma unroll
    for (int s = 0; s < 2; ++s) {
        u32x4 w0, w1;
        w0.x = pkbf(p0[8 * s + 0], p0[8 * s + 1]); w0.y = pkbf(p0[8 * s + 2], p0[8 * s + 3]); w0.z = pkbf(p0[8 * s + 4], p0[8 * s + 5]); w0.w = pkbf(p0[8 * s + 6], p0[8 * s + 7]);
        w1.x = pkbf(p1[8 * s + 0], p1[8 * s + 1]); w1.y = pkbf(p1[8 * s + 2], p1[8 * s + 3]); w1.z = pkbf(p1[8 * s + 4], p1[8 * s + 5]); w1.w = pkbf(p1[8 * s + 6], p1[8 * s + 7]);
        pa[s] = __builtin_bit_cast(bf16x8, w0); pa[2 + s] = __builtin_bit_cast(bf16x8, w1); }
    LAS unsigned char* Vb = buf + 2 * AT_KB + (4 * hh + ((lane >> 2) & 3)) * 320 + (16 * ((lane >> 4) & 1) + 4 * (lane & 3)) * 2;
#pragma unroll
    for (int kst = 0; kst < 4; ++kst)
#pragma unroll
        for (int d = 0; d < 4; ++d) {
            if (VAR == 1) { O[d][kst] += __builtin_bit_cast(float, (int)pa[kst][d]); continue; }
            const s16x4 lo = vtr(Vb + (16 * kst) * 320 + d * 64), hi = vtr(Vb + (16 * kst + 8) * 320 + d * 64);
            const bf16x8 vf = (bf16x8){lo[0], lo[1], lo[2], lo[3], hi[0], hi[1], hi[2], hi[3]};
            O[d] = __builtin_amdgcn_mfma_f32_32x32x16_bf16(pa[kst], vf, O[d], 0, 0, 0);
        }
}
template <int VAR = 0>
__device__ __forceinline__ void attn_unit(const Frame& F, CP P, int bh, int qb, float lam) {
    const int tid = F.tid, wave = F.wave, lane = F.lane, map = wave >> 2, wq = wave & 3, q31 = lane & 31, hh = lane >> 5;
    const int b = bh >> 4, h = bh & 15, q0 = qb * 128;
    const bf16_t* QKV = (const bf16_t*)(P->ws + WS_QKV) + (size_t)b * SEQ * C_COLS; bf16_t* OB = (bf16_t*)(P->ws + (VAR ? WS_PA : WS_OB));
    const float* subln = P->in[27];
    LAS unsigned char* lds = F.lds; LAS float* wsc = (LAS float*)(lds + 2 * AT_BUF) + wave * 32;
    bf16x8 qf[4];
    {   const bf16_t* qp = QKV + (size_t)(q0 + 32 * wq + q31) * C_COLS + h * 128 + map * 64 + 8 * hh;
#pragma unroll
        for (int ks = 0; ks < 4; ++ks) qf[ks] = *(const bf16x8*)(qp + 16 * ks); }
    const int NT = 2 * qb + 2;
    const int krow = tid >> 3, kc8 = tid & 7;
    const unsigned koff = (unsigned)((krow * C_COLS + 2048 + h * 128 + kc8 * 8) * 2), voff = (unsigned)(((tid >> 4) * C_COLS + 4096 + h * 128 + (tid & 15) * 8) * 2);
    const unsigned char* qkvb = (const unsigned char*)QKV;
    const int kdst = krow * 144 + kc8 * 16, vdst = 2 * AT_KB + (tid >> 4) * 320 + (tid & 15) * 16;
    u32x4 pfA[4], pfB[4];
#define AT_LOAD(pf, tt) do { const unsigned char* tb = qkvb + (size_t)(tt) * (64 * C_COLS * 2); pf[0] = *(const u32x4*)(tb + koff); pf[1] = *(const u32x4*)(tb + koff + 128); \
        pf[2] = *(const u32x4*)(tb + voff); pf[3] = *(const u32x4*)(tb + voff + 32 * C_COLS * 2); } while (0)
#define AT_STORE(pf, bufp) do { *(LAS u32x4*)((bufp) + kdst) = pf[0]; *(LAS u32x4*)((bufp) + AT_KB + kdst) = pf[1]; *(LAS u32x4*)((bufp) + vdst) = pf[2]; *(LAS u32x4*)((bufp) + vdst + 32 * 320) = pf[3]; } while (0)
    AT_LOAD(pfA, 0); AT_LOAD(pfB, 1); AT_STORE(pfA, lds); __syncthreads();
    asm volatile("" :: "v"(qf[0]), "v"(qf[1]), "v"(qf[2]), "v"(qf[3]));
    f32x16 O[4];
#pragma unroll
    for (int d = 0; d < 4; ++d)
#pragma unroll
        for (int r = 0; r < 16; ++r) O[d][r] = 0.f;
    float mrow = 0.f, lsum = 0.f; f32x16 negm;
#pragma unroll
    for (int r = 0; r < 16; ++r) negm[r] = 0.f;
    const int qpos = q0 + 32 * wq + q31, q0w = q0 + 32 * wq;
    for (int tt = 0; tt < NT; tt += 2) {
        if (VAR != 4 && tt + 2 < NT) AT_LOAD(pfA, tt + 2);
        if (tt * 64 <= q0w + 31) attn_tile<VAR>(lds, tt * 64, q0w, map, lane, q31, hh, qpos, tt == 0, qf, O, negm, mrow, lsum, wsc);
        if (VAR != 4) AT_STORE(pfB, lds + AT_BUF);
        __syncthreads();
        if (VAR != 4 && tt + 3 < NT) AT_LOAD(pfB, tt + 3);
        if ((tt + 1) * 64 <= q0w + 31) attn_tile<VAR>(lds + AT_BUF, (tt + 1) * 64, q0w, map, lane, q31, hh, qpos, false, qf, O, negm, mrow, lsum, wsc);
        if (VAR != 4 && tt + 2 < NT) AT_STORE(pfA, lds);
        __syncthreads();
    }
#undef AT_LOAD
#undef AT_STORE
    {   const float lt = lsum + __shfl_xor(lsum, 32); if (hh == 0) wsc[q31] = 1.0f / lt;
#pragma unroll
        for (int g = 0; g < 4; ++g) { const f32x4 al = *(LAS f32x4*)(wsc + 8 * g + 4 * hh);
#pragma unroll
            for (int d = 0; d < 4; ++d) { O[d][4 * g + 0] *= al.x; O[d][4 * g + 1] *= al.y; O[d][4 * g + 2] *= al.z; O[d][4 * g + 3] *= al.w; } } }
    LAS float* xch = (LAS float*)lds;
    if (map == 1) {
#pragma unroll
        for (int d = 0; d < 4; ++d)
#pragma unroll
            for (int r = 0; r < 16; ++r) xch[(wq * 64 + d * 16 + r) * 64 + lane] = O[d][r]; }
    __syncthreads();
    if (map == 0) {
        float ss[16];
#pragma unroll
        for (int r = 0; r < 16; ++r) ss[r] = 0.f;
#pragma unroll
        for (int d = 0; d < 4; ++d)
#pragma unroll
            for (int r = 0; r < 16; ++r) { const float o = O[d][r] - lam * xch[(wq * 64 + d * 16 + r) * 64 + lane]; O[d][r] = o; ss[r] += o * o; }
        float sl[4];
#pragma unroll
        for (int d = 0; d < 4; ++d) sl[d] = subln[d * 32 + q31];
#pragma unroll
        for (int r = 0; r < 16; ++r) { float s = row16_sum(ss[r]); s += __shfl_xor(s, 16); const float rs = rsqrtf(s * (1.0f / 128.0f) + 1e-5f) * (1.0f - LAMBDA_INIT);
            const size_t tok = (size_t)b * SEQ + q0 + 32 * wq + crow(r, hh);
#pragma unroll
            for (int d = 0; d < 4; ++d) OB[tok * DM + h * 128 + d * 32 + q31] = (bf16_t)(pkbf(O[d][r] * rs * sl[d], 0.f) & 0xffffu); }
    }
    __syncthreads();
}

constexpr int CK_C = 32;
constexpr size_t WS_PHI = 132 * MiB  , WS_RP = 260 * MiB  , WS_Y0T = 292 * MiB  , WS_PSI = 676 * MiB  ;
constexpr int CP_SZ = 67584;
constexpr int CP_RT = 0, CP_AT = 4608, CP_BT = 9216, CP_KT = 13824, CP_WTT = 4608  , CP_U0T = 9728  ;
constexpr int CP_ATT = 18432, CP_BHT = 23552, CP_KHT = 28672, CP_VT = 33792, CP_AKVT = 38912;
constexpr int CP_PW = 44032  , CP_X = 54272  , CP_AAK = 59392, CP_ARB = 61952, CP_ARK = 64512, CP_D = 44032  , CP_GC = 67072  ;
__device__ __forceinline__ int ck_pos(int j) { return (j >> 5) * 32 + ((j >> 2) & 3) * 8 + ((j >> 4) & 1) * 4 + (j & 3); }
__device__ __forceinline__ f32x16 ck_mm(f32x16 acc, const LAS unsigned char* A, int pa, const LAS unsigned char* Bt, int pb, int nks, int lane) {
    const LAS unsigned char* ap = A + (lane & 31) * pa + (lane >> 5) * 16; const LAS unsigned char* bp = Bt + (lane & 31) * pb + (lane >> 5) * 16;
    for (int ks = 0; ks < nks; ++ks) acc = __builtin_amdgcn_mfma_f32_32x32x16_bf16(*(const LAS bf16x8*)(ap + ks * 32), *(const LAS bf16x8*)(bp + ks * 32), acc, 0, 0, 0);
    return acc;
}
__device__ __forceinline__ f32x16 ck_zero() { f32x16 z; for (int r = 0; r < 16; ++r) z[r] = 0.f; return z; }
__device__ __forceinline__ void ck_st(LAS unsigned char* dst, int pitch, const f32x16& a, int lane) {
    const int col = lane & 31, hh = lane >> 5;
#pragma unroll
    for (int r = 0; r < 16; ++r) *(LAS bf16_t*)(dst + crow(r, hh) * pitch + col * 2) = (bf16_t)(pkbf_c(a[r], 0.f) & 0xffffu);
}
__device__ __forceinline__ void ck_stT(LAS unsigned char* dst, int pitch, const f32x16& a, int lane) {
    const int col = lane & 31, hh = lane >> 5;
#pragma unroll
    for (int g = 0; g < 4; ++g) *(LAS u32x2*)(dst + col * pitch + (8 * g + 4 * hh) * 2) = (u32x2){pkbf_c(a[4 * g], a[4 * g + 1]), pkbf_c(a[4 * g + 2], a[4 * g + 3])};
}
__device__ __forceinline__ void ck_bar() { asm volatile("s_waitcnt lgkmcnt(0)" ::: "memory"); __syncthreads(); }

__device__ __forceinline__ void chunk_prep_fetch(CP P, int pair, int wave, int tid, u32x4 (&raw)[8]) {
    const int hf = wave >> 2, htid = tid & 255, item = 2 * pair + hf, bh = item >> 7, cc = item & 127, t = htid >> 3, j8 = (htid & 7) * 8, tt = cc * 32 + t, hc = (bh & 15) * 64 + j8;
    const size_t tg = (size_t)(bh >> 4) * SEQ + tt; const bf16_t* row = (const bf16_t*)(P->ws + WS_PA) + tg * A_COLS + hc; const u32x4 z4 = (u32x4){0u, 0u, 0u, 0u};
    raw[0] = *(const u32x4*)row; raw[1] = *(const u32x4*)(row + 1024); raw[2] = *(const u32x4*)(row + 2048);
    raw[3] = tt ? *(const u32x4*)(row - A_COLS) : z4; raw[4] = tt ? *(const u32x4*)(row - A_COLS + 1024) : z4; raw[5] = tt ? *(const u32x4*)(row - A_COLS + 2048) : z4;
    raw[6] = *(const u32x4*)((const bf16_t*)(P->ws + WS_ICLR) + tg * 1024 + hc); raw[7] = *(const u32x4*)((const bf16_t*)(P->ws + WS_DLOG) + tg * 1024 + hc);
}
constexpr int CP_PAR = 2 * CP_SZ;
template <int ABL = 0>
__device__ __forceinline__ void chunk_prep_pair(const Frame& F, CP P, int pair, int next_pair, u32x4 (&raw)[8], int qrA, int qrB) {
    const int hf = F.wave >> 2, hw = F.wave & 3, htid = F.tid & 255, lane = F.lane; const int item = 2 * pair + hf;
    f32x4 qrow[8]; if (qrA >= 0 && ABL != 3 && ABL != 5 && ABL != 7) quant_load(P, qrA, lane, qrow);
    LAS unsigned char* L = F.lds + hf * CP_SZ;
    const int bh = item >> 7, cc = item & 127, bb_ = bh >> 4, hd = bh & 15;
    bf16_t* PHI = (bf16_t*)(P->ws + WS_PHI) + (size_t)item * 4096; bf16_t* RPo = (bf16_t*)(P->ws + WS_RP) + (size_t)item * 2048;
    bf16_t* Y0T = (bf16_t*)(P->ws + WS_Y0T) + (size_t)item * 2048; bf16_t* PSI = (bf16_t*)(P->ws + WS_PSI) + (size_t)item * 4096;
    if (ABL != 4) {   const int t = htid >> 3, j8 = (htid & 7) * 8, tt = cc * 32 + t; const size_t tg = (size_t)bb_ * SEQ + tt;
        float rr[8], dd[8], kf[8], vv[8], kq[8], bb[8], tp[8];
        const LAS float* par = (const LAS float*)(F.lds + CP_PAR) + j8; float pp[8];
#define CK_PAR(a_) do { const f32x4 x_ = *(const LAS f32x4*)(par + (a_) * 64), y_ = *(const LAS f32x4*)(par + (a_) * 64 + 4); pp[0] = x_.x; pp[1] = x_.y; pp[2] = x_.z; pp[3] = x_.w; pp[4] = y_.x; pp[5] = y_.y; pp[6] = y_.z; pp[7] = y_.w; } while (0)
#define CK_SHIFT(x, ri) do { unpack8(raw[ri], x); unpack8(raw[(ri) + 3], tp); CK_PAR(ri); _Pragma("unroll") for (int i = 0; i < 8; ++i) x[i] += (tp[i] - x[i]) * pp[i]; } while (0)
        CK_SHIFT(rr, 0); CK_SHIFT(kf, 1); CK_SHIFT(vv, 2);
        float ic[8]; unpack8(raw[6], ic); unpack8(raw[7], dd);
        if (next_pair >= 0) chunk_prep_fetch(P, next_pair, F.wave, F.tid, raw);
        float ss_ = 0.f;
        CK_PAR(3);
#pragma unroll
        for (int i = 0; i < 8; ++i) { kq[i] = kf[i] * pp[i]; ss_ += kq[i] * kq[i]; }
        ss_ = oct_sum(ss_); const float rn_ = rsqrtf(fmaxf(ss_, 1e-12f));
        CK_PAR(4);
#pragma unroll
        for (int i = 0; i < 8; ++i) { kq[i] *= rn_; kf[i] = kf[i] * (1.0f + (ic[i] - 1.0f) * pp[i]); bb[i] = kq[i] * ic[i]; }
        float bs_ = 0.f;
        CK_PAR(5);
#pragma unroll
        for (int i = 0; i < 8; ++i) bs_ += rr[i] * kf[i] * pp[i];
        bs_ = oct_sum(bs_);
        if ((htid & 7) == 0) ((float*)(P->ws + WS_BONUS))[tg * 16 + hd] = bs_;
#undef CK_SHIFT
#undef CK_PAR
        float inc[8], Dm1[8], Dt[8], DC[8];
#pragma unroll
        for (int q = 0; q < 8; ++q) inc[q] = dd[q];
#pragma unroll
        for (int sh = 8; sh < 64; sh *= 2) {
#pragma unroll
            for (int q = 0; q < 8; ++q) { const float y = __shfl_up(inc[q], sh); inc[q] += (lane >= sh) ? y : 0.f; } }
        if ((lane >> 3) == 7) { *(LAS f32x4*)(L + CP_D + hw * 256 + j8 * 4) = (f32x4){inc[0], inc[1], inc[2], inc[3]}; *(LAS f32x4*)(L + CP_D + hw * 256 + j8 * 4 + 16) = (f32x4){inc[4], inc[5], inc[6], inc[7]}; }
        ck_bar();
#pragma unroll
        for (int q = 0; q < 8; ++q) { DC[q] = 0.f; Dt[q] = inc[q]; }
#pragma unroll
        for (int w = 0; w < 4; ++w) { const f32x4 x0 = *(const LAS f32x4*)(L + CP_D + w * 256 + j8 * 4), x1 = *(const LAS f32x4*)(L + CP_D + w * 256 + j8 * 4 + 16);
            const float tw[8] = {x0.x, x0.y, x0.z, x0.w, x1.x, x1.y, x1.z, x1.w};
#pragma unroll
            for (int q = 0; q < 8; ++q) { DC[q] += tw[q]; if (w < hw) Dt[q] += tw[q]; } }
#pragma unroll
        for (int q = 0; q < 8; ++q) Dm1[q] = Dt[q] - dd[q];
        float at[8], rt[8], bt[8], kt[8], bh[8], kh[8];
#pragma unroll
        for (int q = 0; q < 8; ++q) { const float em1 = __expf(-Dm1[q]), e0 = __expf(-Dt[q]), ep = __expf(Dt[q]), ec = __expf(Dt[q] - DC[q]);
            at[q] = -kq[q] * em1; rt[q] = rr[q] * e0; bt[q] = bb[q] * ep; kt[q] = kf[q] * ep; bh[q] = bb[q] * ec; kh[q] = kf[q] * ec; }
        *(LAS u32x4*)(L + CP_AT + t * 144 + j8 * 2) = (u32x4){pkbf(at[0], at[1]), pkbf(at[2], at[3]), pkbf(at[4], at[5]), pkbf(at[6], at[7])};
        *(LAS u32x4*)(L + CP_RT + t * 144 + j8 * 2) = (u32x4){pkbf(rt[0], rt[1]), pkbf(rt[2], rt[3]), pkbf(rt[4], rt[5]), pkbf(rt[6], rt[7])};
        *(LAS u32x4*)(L + CP_BT + t * 144 + j8 * 2) = (u32x4){pkbf(bt[0], bt[1]), pkbf(bt[2], bt[3]), pkbf(bt[4], bt[5]), pkbf(bt[6], bt[7])};
        *(LAS u32x4*)(L + CP_KT + t * 144 + j8 * 2) = (u32x4){pkbf(kt[0], kt[1]), pkbf(kt[2], kt[3]), pkbf(kt[4], kt[5]), pkbf(kt[6], kt[7])};
#pragma unroll
        for (int q = 0; q < 8; ++q) { const int o = (j8 + q) * 80 + t * 2;
            *(LAS bf16_t*)(L + CP_ATT + o) = (bf16_t)(pkbf(at[q], 0.f) & 0xffffu); *(LAS bf16_t*)(L + CP_BHT + o) = (bf16_t)(pkbf(bh[q], 0.f) & 0xffffu);
            *(LAS bf16_t*)(L + CP_KHT + o) = (bf16_t)(pkbf(kh[q], 0.f) & 0xffffu); *(LAS bf16_t*)(L + CP_VT + o) = (bf16_t)(pkbf(vv[q], 0.f) & 0xffffu);
            if (t == CK_C - 1) *(LAS float*)(L + CP_GC + (j8 + q) * 4) = __expf(-DC[q]); }
    }
    ck_bar();
    if (ABL == 3) return;
    if (ABL == 2 || ABL == 4) { if (qrA >= 0) quant_finish(P, qrA, lane, qrow); return; }
    const int col = lane & 31, hh = lane >> 5;
    {   const int pi = hw >> 1, qi = hw & 1;
        f32x16 a = ck_mm(ck_zero(), L + (pi ? CP_RT : CP_AT), 144, L + (qi ? CP_KT : CP_BT), 144, 4, lane);
#pragma unroll
        for (int r = 0; r < 16; ++r) { const int t = crow(r, hh); if (pi == 0 ? (col >= t) : (col > t)) a[r] = 0.f; }
        if (hw == 0) { ck_st(L + CP_PW, 80, a, lane); ck_stT(L + CP_PW + 2560, 80, a, lane);
#pragma unroll
            for (int r = 0; r < 16; ++r) if (crow(r, hh) == col) a[r] += 1.0f;
            ck_st(L + CP_X, 80, a, lane);
            asm volatile("s_waitcnt lgkmcnt(0)" ::: "memory");
            const f32x16 q = ck_mm(ck_zero(), L + CP_PW, 80, L + CP_PW + 2560, 80, 2, lane); ck_st(L + CP_PW + 5120, 80, q, lane); ck_stT(L + CP_PW + 5120 + 2560, 80, q, lane); }
        else ck_st(L + (hw == 1 ? CP_AAK : (hw == 2 ? CP_ARB : CP_ARK)), 80, a, lane);
    }
    if (qrA >= 0 && ABL != 5 && ABL != 7) quant_finish(P, qrA, lane, qrow); if (qrB >= 0 && ABL != 5 && ABL != 6) quant_load(P, qrB, lane, qrow);
    ck_bar();
    for (int r = 2; r <= (ABL == 1 ? 2 : 5); ++r) {
        const LAS unsigned char* pc = L + CP_PW + ((r - 1) & 1) * 5120; LAS unsigned char* pn = L + CP_PW + (r & 1) * 5120;
        if (hw == 0 && r <= 4) { const f32x16 a = ck_mm(ck_zero(), pc, 80, pc + 2560, 80, 2, lane); ck_st(pn, 80, a, lane); ck_stT(pn + 2560, 80, a, lane); }
        if (hw == 1 && r >= 2) {
            const LAS unsigned char* xc = L + CP_X + (r & 1) * 2560; LAS unsigned char* xn = L + CP_X + ((r + 1) & 1) * 2560;
            f32x16 a;
#pragma unroll
            for (int q = 0; q < 16; ++q) a[q] = bf_1(*(const LAS bf16_t*)(xc + crow(q, hh) * 80 + col * 2));
            a = ck_mm(a, xc, 80, pc + 2560, 80, 2, lane); ck_st(xn, 80, a, lane); }
        if (r == 2 && hw >= 2) { const int ih = hw - 2;
            const f32x16 a = ck_mm(ck_zero(), L + CP_AAK, 80, L + CP_VT + ih * 2560, 80, 2, lane); ck_stT(L + CP_AKVT + ih * 2560, 80, a, lane); }
        ck_bar();
    }
    const LAS unsigned char* Tn = L + CP_X;
    if (hw < 2) { const f32x16 a = ck_mm(ck_zero(), Tn, 80, L + CP_ATT + hw * 2560, 80, 2, lane); ck_stT(L + CP_WTT + hw * 2560, 80, a, lane); }
    else { const int ih = hw - 2; const f32x16 a = ck_mm(ck_zero(), Tn, 80, L + CP_AKVT + ih * 2560, 80, 2, lane); ck_stT(L + CP_U0T + ih * 2560, 80, a, lane); }
    ck_bar();
    {   const int jph = hw >> 1, jh = hw & 1;
        f32x16 a = ck_mm(ck_zero(), L + CP_BHT + jph * 2560, 80, L + CP_WTT + jh * 2560, 80, 2, lane);
        const int j = 32 * jh + col; const int pj = ck_pos(j);
#pragma unroll
        for (int r = 0; r < 16; ++r) { const int jp = 32 * jph + crow(r, hh); float x = a[r]; if (jp == j) x += *(const LAS float*)(L + CP_GC + j * 4);
            PHI[jp * 64 + pj] = (bf16_t)(pkbf_c(x, 0.f) & 0xffffu); } }
    {   const int jph = hw >> 1, ih = hw & 1;
        f32x16 a = ck_mm(ck_zero(), L + CP_BHT + jph * 2560, 80, L + CP_U0T + ih * 2560, 80, 2, lane);
        a = ck_mm(a, L + CP_KHT + jph * 2560, 80, L + CP_VT + ih * 2560, 80, 2, lane);
        const int i = 32 * ih + col;
#pragma unroll
        for (int g = 0; g < 4; ++g) *(u32x2*)(PSI + i * 64 + 32 * jph + 8 * g + 4 * hh) = (u32x2){pkbf_c(a[4 * g], a[4 * g + 1]), pkbf_c(a[4 * g + 2], a[4 * g + 3])}; }
    if (hw < 2) { const int jh = hw;
        f32x16 a;
        const int j = 32 * jh + col; const int pj = ck_pos(j);
#pragma unroll
        for (int r = 0; r < 16; ++r) a[r] = bf_1(*(const LAS bf16_t*)(L + CP_RT + crow(r, hh) * 144 + j * 2));
        a = ck_mm(a, L + CP_ARB, 80, L + CP_WTT + jh * 2560, 80, 2, lane);
#pragma unroll
        for (int r = 0; r < 16; ++r) RPo[crow(r, hh) * 64 + pj] = (bf16_t)(pkbf_c(a[r], 0.f) & 0xffffu);
    } else { const int ih = hw - 2;
        f32x16 a = ck_mm(ck_zero(), L + CP_ARB, 80, L + CP_U0T + ih * 2560, 80, 2, lane);
        a = ck_mm(a, L + CP_ARK, 80, L + CP_VT + ih * 2560, 80, 2, lane);
        const int i = 32 * ih + col;
#pragma unroll
        for (int g = 0; g < 4; ++g) *(u32x2*)(Y0T + i * 32 + 8 * g + 4 * hh) = (u32x2){pkbf_c(a[4 * g], a[4 * g + 1]), pkbf_c(a[4 * g + 2], a[4 * g + 3])};
    }
    if (qrB >= 0 && ABL != 5 && ABL != 6) quant_finish(P, qrB, lane, qrow);
    ck_bar();
}

typedef float f32x4v __attribute__((ext_vector_type(4)));
__device__ __forceinline__ void chunk_scan_unit4(const Frame& F, CP P, int u, LAS unsigned char* lsf, volatile LAS unsigned* cnt) {
    const int lane = F.lane, T = F.wave, bh = u >> 2, sl = u & 3, b = bh >> 4, h = bh & 15, li = lane & 15, g = lane >> 4;
    const bf16_t* PHI = (const bf16_t*)(P->ws + WS_PHI) + (size_t)bh * 128 * 4096 + (16 * T + li) * 64 + g * 8;
    const bf16_t* PSI = (const bf16_t*)(P->ws + WS_PSI) + (size_t)bh * 128 * 4096 + (16 * sl + li) * 64 + 16 * T + 4 * g;
    const bf16_t* RPi = (const bf16_t*)(P->ws + WS_RP) + (size_t)bh * 128 * 2048 + (16 * (T & 1) + li) * 64 + g * 8;
    const bf16_t* Y0T = (const bf16_t*)(P->ws + WS_Y0T) + (size_t)bh * 128 * 2048 + (16 * sl + li) * 32 + 16 * (T & 1) + 4 * g;
    float* Y = (float*)(P->ws + WS_Y) + (size_t)b * SEQ * 1024 + h * 64 + 16 * sl + li;
    const bool yw = T < 2;
    f32x4v S = (f32x4v){0.f, 0.f, 0.f, 0.f};
    bf16x8 phi[8][2], rp[8][2]; u32x2 psi[8], y0[8];
#define CS_LOAD(k, c) do { phi[k][0] = *(const bf16x8*)(PHI + (size_t)(c) * 4096); phi[k][1] = *(const bf16x8*)(PHI + (size_t)(c) * 4096 + 32); psi[k] = *(const u32x2*)(PSI + (size_t)(c) * 4096); \
        if (yw) { rp[k][0] = *(const bf16x8*)(RPi + (size_t)(c) * 2048); rp[k][1] = *(const bf16x8*)(RPi + (size_t)(c) * 2048 + 32); y0[k] = *(const u32x2*)(Y0T + (size_t)(c) * 2048); } } while (0)
#pragma unroll
    for (int k = 0; k < 8; ++k) CS_LOAD(k, k);
    LAS unsigned char* mine = lsf + (T >> 1) * 1024 + lane * 16 + (T & 1) * 8;
    for (int c0 = 0; c0 < 128; c0 += 8) {
#pragma unroll
        for (int k = 0; k < 8; ++k) { const int c = c0 + k; LAS unsigned char* img = lsf + (c & 1) * 2048;
            *(LAS u32x2*)(mine + (c & 1) * 2048) = (u32x2){pkbf_c(S[0], S[1]), pkbf_c(S[2], S[3])};
            if (lane == 0) __hip_atomic_fetch_add((LAS unsigned*)cnt, 1u, __ATOMIC_RELAXED, __HIP_MEMORY_SCOPE_WORKGROUP);
            const unsigned want = 4u * (unsigned)(c + 1);
            while (*cnt < want) { }
            const bf16x8 sf0 = *(const LAS bf16x8*)(img + lane * 16), sf1 = *(const LAS bf16x8*)(img + 1024 + lane * 16);
            if (yw) { f32x4v a = (f32x4v){bf_lo(y0[k].x), bf_hi(y0[k].x), bf_lo(y0[k].y), bf_hi(y0[k].y)};
                a = __builtin_amdgcn_mfma_f32_16x16x32_bf16(rp[k][0], sf0, a, 0, 0, 0); a = __builtin_amdgcn_mfma_f32_16x16x32_bf16(rp[k][1], sf1, a, 0, 0, 0);
#pragma unroll
                for (int r = 0; r < 4; ++r) Y[(size_t)(c * 32 + 16 * T + 4 * g + r) * 1024] = a[r]; }
            {   f32x4v a = (f32x4v){bf_lo(psi[k].x), bf_hi(psi[k].x), bf_lo(psi[k].y), bf_hi(psi[k].y)};
                a = __builtin_amdgcn_mfma_f32_16x16x32_bf16(phi[k][0], sf0, a, 0, 0, 0); a = __builtin_amdgcn_mfma_f32_16x16x32_bf16(phi[k][1], sf1, a, 0, 0, 0); S = a; }
            if (c + 8 < 128) CS_LOAD(k, c + 8);
        }
    }
#undef CS_LOAD
}
#define XB_TMO      128
#define XB_XCNT(j)  (256  + 64 * (j))
#define XB_XSUB(j)  (1280 + 64 * (j))
#define XB_XGEN(j)  (2304 + 64 * (j))
#define XB_TOP      3328
#define XB_TOPGEN   3392
#define XCD_BAR_WORDS 3456
#define XB_SPIN_CAP (1u << 18)

__device__ __forceinline__ unsigned xb_ld(unsigned* p)              { return __hip_atomic_load(p, __ATOMIC_RELAXED, __HIP_MEMORY_SCOPE_AGENT); }
__device__ __forceinline__ unsigned xb_add(unsigned* p, unsigned v) { return __hip_atomic_fetch_add(p, v, __ATOMIC_RELAXED, __HIP_MEMORY_SCOPE_AGENT); }
__device__ __forceinline__ unsigned xb_xcc_id() { return (unsigned)__builtin_amdgcn_s_getreg((3 << 11) | 20) & 0xFu; }
#define XB_SPIN(cond, bar) do { unsigned _sp = 0; while (cond) { __builtin_amdgcn_s_sleep(1); \
    if ((++_sp & 255u) == 0u) { if (xb_ld(&(bar)[XB_TMO])) break; if (_sp > XB_SPIN_CAP) { atomicAdd(&(bar)[XB_TMO], 1u); break; } } } } while (0)

struct XcdBarrier {
    unsigned* bar; unsigned x;
    volatile LAS unsigned* st;
};

__device__ __forceinline__ XcdBarrier xcd_barrier_post(unsigned* bar, volatile LAS unsigned* st) {
    XcdBarrier b; b.bar = bar; b.x = xb_xcc_id(); b.st = st;
    if (threadIdx.x == 0) (void)xb_add(&bar[XB_XCNT(b.x)], 1u);
    return b;
}
__device__ __forceinline__ void xcd_barrier_complete(unsigned* bar, unsigned x, unsigned& nloc, unsigned& nx) {
    const unsigned G = gridDim.x * gridDim.y * gridDim.z;
    unsigned sum, cnt, mine, sp = 0u;
    for (;;) {
        sum = 0u; cnt = 0u; mine = 0u;
#pragma unroll
        for (unsigned j = 0; j < 16; ++j) { const unsigned c = xb_ld(&bar[XB_XCNT(j)]); sum += c; cnt += (c > 0u) ? 1u : 0u; mine = (j == x) ? c : mine; }
        if (sum == G) break;
        __builtin_amdgcn_s_sleep(1);
        if ((++sp & 255u) == 0u) { if (xb_ld(&bar[XB_TMO])) break; if (sp > XB_SPIN_CAP) { atomicAdd(&bar[XB_TMO], 1u); break; } }
    }
    nloc = mine > 0u ? mine : 1u; nx = cnt > 0u ? cnt : 1u;
}

__device__ __forceinline__ void xcd_barrier(const XcdBarrier& b) {
    asm volatile("s_waitcnt vmcnt(0)" ::: "memory");
    __syncthreads();
    if (threadIdx.x == 0) {
        unsigned* bar = b.bar;
        __builtin_amdgcn_s_waitcnt(0);
        unsigned nloc = b.st[0], nx = b.st[1];
        if (nloc == 0u) { xcd_barrier_complete(bar, b.x, nloc, nx); b.st[0] = nloc; b.st[1] = nx; }
        const unsigned old = xb_add(&bar[XB_XSUB(b.x)], 1u);
        const unsigned gen = old / nloc;
        if (old + 1u == (gen + 1u) * nloc) {
            __builtin_amdgcn_fence(__ATOMIC_RELEASE, "agent");
            asm volatile("s_waitcnt vmcnt(0)" ::: "memory");
            const unsigned og = xb_add(&bar[XB_TOP], 1u);
            const unsigned tg = og / nx;
            if (og + 1u == (tg + 1u) * nx) xb_add(&bar[XB_TOPGEN], 1u);
            else XB_SPIN(xb_ld(&bar[XB_TOPGEN]) == tg, bar);
            __builtin_amdgcn_fence(__ATOMIC_ACQUIRE, "agent");
            xb_add(&bar[XB_XGEN(b.x)], 1u);
            asm volatile("s_waitcnt vmcnt(0)" ::: "memory");
        } else {
            XB_SPIN(xb_ld(&bar[XB_XGEN(b.x)]) == gen, bar);
            __builtin_amdgcn_fence(__ATOMIC_ACQUIRE, "agent");
            asm volatile("s_waitcnt vmcnt(0)" ::: "memory");
        }
    }
    __syncthreads();
}

#ifndef MK_ONE_LAUNCH
#define MK_ONE_LAUNCH 1
#endif
constexpr int N_PHASES = 20;
#ifndef PROBE_REP
#define PROBE_REP (-1)
#endif
#define REPS(k) for (int rep_ = 0; rep_ < ((PROBE_REP == (k)) ? 2 : 1); ++rep_)
__device__ __forceinline__ int opq(int n) { asm volatile("" : "+s"(n)); return n; }
#define GEMM_REP(k, BODY) do { if (PROBE_REP == (k)) { BODY(0) xcd_barrier(bar); } if (PROBE_REP == (k) + 70) { BODY(2) xcd_barrier(bar); } BODY(0) } while (0)
struct Args { Ptrs p; int ph_lo, ph_hi; };

#define STAGE_P(ABL_)         {   const int ppb = (4096 + F.G - 1) / F.G, p0 = F.bid * ppb, pend = (p0 + ppb < 4096) ? p0 + ppb : 4096; int cur_head = -1; \
            u32x4 raw[8]; if (p0 < pend) chunk_prep_fetch(P, p0, F.wave, F.tid, raw); \
            for (int pr = p0; pr < pend; ++pr) { \
                const int hd = (pr >> 6) & 15; \
                if (hd != cur_head) { __syncthreads(); cur_head = hd; \
                    if (F.tid < 384) { const int arr = F.tid >> 6, ch = F.tid & 63; const float* src = arr < 3 ? P->in[4] + arr * 1024 : P->in[7 + arr]; \
                        ((LAS float*)(F.lds + CP_PAR))[F.tid] = src[hd * 64 + ch]; } \
                    __syncthreads(); } \
                chunk_prep_pair<ABL_>(F, P, pr, pr + 1 < pend ? pr + 1 : -1, raw, F.G == 256 ? QS_P1ROWS + F.bid * QS_PROWS + (pr - p0) * 8 + F.wave : (pr * 8 + F.wave) * 2, F.G == 256 ? ((pr - p0) * 8 < QS_PROWS - 128 ? QS_P1ROWS + F.bid * QS_PROWS + 128 + (pr - p0) * 8 + F.wave : -1) : (pr * 8 + F.wave) * 2 + 1); \
            } }
__global__ void __launch_bounds__(NTHREADS, 2) fwd_kernel(Args args) {
    extern __shared__ __attribute__((aligned(16))) unsigned char lds_raw[];
    const int tid0 = threadIdx.x;
    const CP P0 = launder((CP)__builtin_amdgcn_kernarg_segment_ptr());
    const int lo = ((const __attribute__((address_space(4))) int*)P0)[70], hi = ((const __attribute__((address_space(4))) int*)P0)[71];
#define PH_BEGIN Frame F; { int t_ = tid0; asm volatile("" : "+v"(t_)); F.lds = (LAS unsigned char*)lds_raw; F.tid = t_; F.lane = t_ & 63; F.wave = __builtin_amdgcn_readfirstlane(t_ >> 6); \
        F.G = gridDim.x; F.bid = blockIdx.x; F.gw = F.bid * NWAVES + F.wave; F.NGW = F.G * NWAVES; } const CP P = launder(P0); unsigned char* const ws = P->ws; bf16_t* const XN = (bf16_t*)(ws + WS_XN); (void)XN;
    cg::grid_group grid = cg::this_grid();
    for (int u = tid0; u < 64; u += NTHREADS) ((LAS unsigned*)((LAS unsigned char*)lds_raw + LDS_BYTES - 256))[u] = 0u;
    __syncthreads();
    const XcdBarrier bar = xcd_barrier_post((unsigned*)(P0->ws + WS_CTL) + 4096, (volatile LAS unsigned*)((LAS unsigned char*)lds_raw + LDS_BYTES - 256) + 8);
#define IN(k) (lo <= (k) && (k) < hi)
#define SEAM(k) do { if (IN(k) && IN((k) + 1)) { if ((k) == 0) grid.sync(); else xcd_barrier(bar); } } while (0)

    if (IN(0)) { PH_BEGIN REPS(0) phase_prologue(F, P); } SEAM(0);
#define BODY_P1(NTC) { PH_BEGIN    \
          \
        const bool split_ = (F.G == 256); \
        if (split_ && F.bid >= 224) { const int sw = (F.bid - 224) * 8 + F.wave; quant_stream<2>(P, F.lds + F.wave * 16384, sw, 256, QS_P1ROWS / 256, F.lane); } \
        else { pg8::Gemm g{XN, (const bf16_t*)(ws + WS_WT_AB), M_TOK, AB_COLS, DM, (NTC) ? opq(NTC) : 0}; pg8::StaticOrder S; S.init(M_TOK, AB_COLS, split_ ? 224 : F.G, F.bid); \
            EpiAB E{(bf16_t*)(ws + WS_PA), (bf16_t*)(ws + WS_Z)}; \
            pg8::gemm_phase<EpiAB, pg8::StaticOrder, true, true>(F.lds, g, S, E); } }
    if (IN(1)) GEMM_REP(1, BODY_P1); SEAM(1);
    if (IN(2)) { PH_BEGIN phase_row_a(F, P); } SEAM(2);
    if (IN(3)) { PH_BEGIN
        int kl = 256; asm volatile("" : "+s"(kl));
        pg8::Gemm g{(const bf16_t*)(ws + WS_ALORA), (const bf16_t*)(ws + WS_BT_LORA), M_TOK, 3072, kl}; pg8::StaticOrder S; S.init(M_TOK, 3072, F.G, F.bid);
        EpiLora E{(bf16_t*)(ws + WS_DLOG), P->in[5], P->in[7]};
        REPS(3) pg8::gemm_phase<EpiLora, pg8::StaticOrder, true, true>(F.lds, g, S, E);
    } SEAM(3);
    if (IN(5)) { PH_BEGIN
        if (PROBE_REP == 35) { STAGE_P(0) __syncthreads(); } if (PROBE_REP == 36) { STAGE_P(2) __syncthreads(); } if (PROBE_REP == 37) { STAGE_P(1) __syncthreads(); } if (PROBE_REP == 38) { STAGE_P(3) __syncthreads(); } if (PROBE_REP == 39) { STAGE_P(4) __syncthreads(); } if (PROBE_REP == 40) { STAGE_P(5) __syncthreads(); } if (PROBE_REP == 41) { STAGE_P(6) __syncthreads(); } if (PROBE_REP == 42) { STAGE_P(7) __syncthreads(); }
        STAGE_P(0)
        REPS(25) for (int t = F.bid; t < 1024; t += F.G) sgu_tile(F, P, t);
        xcd_barrier(bar);
        {   volatile LAS unsigned* cnt = (volatile LAS unsigned*)(F.lds + 4096);
            REPS(55) for (int u = F.bid; u < 256; u += F.G) {
                if (F.tid == 0) *cnt = 0u;
                __syncthreads();
                if (F.wave < 4) chunk_scan_unit4(F, P, u, F.lds, cnt);
                else if (u == F.bid) { const int hw = F.bid * 4 + (F.wave - 4), NHW = F.G * 4;
                    for (int it = hw; it < 14336; it += NHW) late_transpose_item(P, it, (LAS float*)(F.lds + 8192 + (F.wave - 4) * 8448), F.lane); }
                __syncthreads();
            } }
    } SEAM(5);
    if (IN(6)) { PH_BEGIN REPS(6) phase_gn(F, P); } SEAM(6);
#define BODY_P7(NTC) { PH_BEGIN    \
        pg8::Gemm g{(const bf16_t*)(ws + WS_YAB), (const bf16_t*)(ws + WS_WT_ABO), M_TOK, DM, DM, (NTC) ? opq(NTC) : 0}; pg8::StaticOrder S; S.init(M_TOK, DM, F.G, F.bid); \
        EpiRes<true> E{P->in[0], (bf16_t*)(ws + WS_XB)}; \
        pg8::gemm_phase<EpiRes<true>, pg8::StaticOrder, true, true>(F.lds, g, S, E); }
    if (IN(7)) GEMM_REP(7, BODY_P7); SEAM(7);
#define BODY_Q(layer, NTC) { PH_BEGIN \
        pg8::Gemm g{(const bf16_t*)(ws + WS_XB), (const bf16_t*)(ws + WS_WT_Q + (size_t)(layer) * 8 * MiB), M_TOK, DM, DM, (NTC) ? opq(NTC) : 0}; pg8::StaticOrder S; S.init(M_TOK, DM, F.G, F.bid); \
        pg8::EpiBf16<0> E{(bf16_t*)(ws + WS_QP), DM, nullptr, 0, 0, 1.f}; \
        pg8::gemm_phase<pg8::EpiBf16<0>, pg8::StaticOrder, true, true>(F.lds, g, S, E); }
#ifndef PEER_NB
#define PEER_NB 24
#endif
#define PEER_BLOCK(layer, pb) \
    if (IN((pb) + 1)) { if (PROBE_REP == (pb) + 1) { BODY_Q(layer, 0) xcd_barrier(bar); } if (PROBE_REP == (pb) + 71) { BODY_Q(layer, 2) xcd_barrier(bar); } BODY_Q(layer, 0) } SEAM((pb) + 1); \
    if (IN((pb) + 2)) { PH_BEGIN const bf16_t* XBp = (const bf16_t*)(ws + WS_XB); \
          \
          \
        for (int blk = F.bid; blk < M_TOK / 64; blk += F.G) { const int tb0 = blk * 64; \
            _Pragma("unroll 1") for (int step = 0; step < 3; ++step) { \
                const bool doT = step == 0 || (step == 1 && F.wave < 4), doE = step == 2 || (step == 1 && F.wave >= 4); \
                if (doT) { const int nT = step == 0 ? 1 : 2; _Pragma("unroll 1") for (int k = 0; k < nT; ++k) peer_topk_wave(F, P, (layer), F.wave + 4 * k, tb0 + (step ? 32 : 0)); } \
                if (doE) { const int e0 = step == 1 ? tb0 + F.wave - 4 : tb0 + PEER_NB + F.wave, e1 = step == 1 ? tb0 + PEER_NB : tb0 + 64, es = step == 1 ? 4 : 8;        \
                    if ((layer) == 0) phase_experts<L0_FMT, 0, false>(F, P, 0, P->in[1] + DM, XBp, ws + WS_XB, e0, e1, es); else phase_experts<4, 0, true>(F, P, 1, nullptr, XBp, P->out, e0, e1, es); } \
                __threadfence_block(); __syncthreads(); } } }
    PEER_BLOCK(0, 8) SEAM(11);
#define BODY_P12(NTC) { PH_BEGIN    \
        pg8::Gemm g{XN, (const bf16_t*)(ws + WS_WT_C), M_TOK, C_COLS, DM, (NTC) ? opq(NTC) : 0}; pg8::StaticOrder S; S.init(M_TOK, C_COLS, F.G, F.bid); \
        EpiQKV E{(bf16_t*)(ws + WS_QKV), P->in[21], P->in[22], (const f32x2*)(ws + WS_ROPE)}; \
        pg8::gemm_phase<EpiQKV, pg8::StaticOrder, true, true>(F.lds, g, S, E); }
    if (IN(12)) GEMM_REP(12, BODY_P12); SEAM(12);
    if (IN(14)) { PH_BEGIN
        float lam;
        {   const float a = (F.lane < 64) ? P->in[23][F.lane] * P->in[24][F.lane] : 0.f, b2 = P->in[25][F.lane] * P->in[26][F.lane];
            lam = __expf(wave_sum(a)) - __expf(wave_sum(b2)) + LAMBDA_INIT; }
#define ATT_PASS(V) for (int u = F.bid; u < 2048; u += F.G) { const int c = u & 255, i = u >> 8, s = c & 3; const int qb = (i & 1) ? (8 * (i >> 1) + 7 - s) : (8 * (i >> 1) + s); attn_unit<V>(F, P, c >> 2, qb, lam); }
        if (PROBE_REP == 14) { ATT_PASS(5) } if (PROBE_REP == 141) { ATT_PASS(1) } if (PROBE_REP == 142) { ATT_PASS(2) } if (PROBE_REP == 143) { ATT_PASS(3) } if (PROBE_REP == 144) { ATT_PASS(4) }
        ATT_PASS(0)
#undef ATT_PASS
    } SEAM(14);
    if (IN(15)) { PH_BEGIN
        pg8::Gemm g{(const bf16_t*)(ws + WS_OB), (const bf16_t*)(ws + WS_WT_CO), M_TOK, DM, DM}; pg8::StaticOrder S; S.init(M_TOK, DM, F.G, F.bid);
        EpiRes<false> E{ws + WS_XB, (bf16_t*)(ws + WS_XB)};
        pg8::gemm_phase<EpiRes<false>, pg8::StaticOrder, true, true>(F.lds, g, S, E);
    } SEAM(15);
    PEER_BLOCK(1, 16)
#undef PEER_BLOCK
#undef IN
#undef SEAM
}

extern "C" void kernel_launch(void* const* d_in, const int* in_sizes, int n_in, void* d_out, int out_size, void* d_ws, size_t ws_size, hipStream_t stream) {
    static int grid = 0;
    if (grid == 0) {
        if (n_in != 33 || out_size != M_TOK * DM || ws_size < WS_END) { fprintf(stderr, "kernel_launch: unexpected problem (n_in %d out %d ws %zu)\n", n_in, out_size, ws_size); grid = -1; return; }
        int dev = 0, cus = 0, per_cu = 0;
        hipGetDevice(&dev); hipDeviceGetAttribute(&cus, hipDeviceAttributeMultiprocessorCount, dev);
        if (hipFuncSetAttribute((const void*)fwd_kernel, hipFuncAttributeMaxDynamicSharedMemorySize, LDS_BYTES) != hipSuccess) { fprintf(stderr, "kernel_launch: hipFuncSetAttribute failed\n"); grid = -1; return; }
        if (hipOccupancyMaxActiveBlocksPerMultiprocessor(&per_cu, (const void*)fwd_kernel, NTHREADS, LDS_BYTES) != hipSuccess || per_cu < 1) { fprintf(stderr, "kernel_launch: occupancy query says %d\n", per_cu); per_cu = 1; }
        (void)hipGetLastError();
        grid = cus * 1;
        fprintf(stderr, "kernel_launch: grid %d (cus %d, per_cu %d)\n", grid, cus, per_cu);
    }
    if (grid < 0) return;
    if (hipMemsetAsync((char*)d_ws + WS_CTL, 0, 65536, stream) != hipSuccess) { fprintf(stderr, "kernel_launch: memset failed\n"); return; }
    Args a{};
    for (int i = 0; i < 33; ++i) a.p.in[i] = (const float*)d_in[i];
    a.p.out = (float*)d_out; a.p.ws = (unsigned char*)d_ws;
#if MK_ONE_LAUNCH
    a.ph_lo = 0; a.ph_hi = N_PHASES;
    void* kargs[] = {&a};
    hipError_t e = hipLaunchCooperativeKernel((const void*)fwd_kernel, dim3(grid), dim3(NTHREADS), kargs, LDS_BYTES, stream);
    if (e != hipSuccess) fprintf(stderr, "kernel_launch: cooperative launch failed: %s\n", hipGetErrorString(e));
#else
    for (int ph = 0; ph < N_PHASES; ++ph) {
        a.ph_lo = ph; a.ph_hi = ph + 1;
        hipLaunchKernelGGL(fwd_kernel, dim3(grid), dim3(NTHREADS), LDS_BYTES, stream, a);
    }
#endif
}
```
